# Optimizing an MI355X kernel written in HIP

```python
import math
import jax, jax.numpy as jnp
from jax import lax
import numpy as np

D_MODEL = 4096
BATCH = 32
SEQ = 256
DEPTH = 1
DEC_BATCH = 4
DEC_SEQ = 4096
PAST_LEN = 512

GRID_W = 64
N_HEADS = 32
QK_NOPE = 128
QK_ROPE = 64
QK_HEAD = QK_NOPE + QK_ROPE
V_HEAD = 128
Q_LORA = 1024
KV_LORA = 512
S5_WIDTH = 2048
S5_GROUP = 16
S5_GROUPS = S5_WIDTH // S5_GROUP
S5_STATE = 64
D_FF = 4 * D_MODEL
ROPE_THETA = 10000.0
EPS = 1e-6
Q_BLOCK = 128
N_MOD = 6
IN_COLS = Q_LORA + KV_LORA + QK_ROPE + S5_WIDTH + 2 * D_MODEL
IN_SPLITS = (Q_LORA, Q_LORA + KV_LORA, Q_LORA + KV_LORA + QK_ROPE,
             Q_LORA + KV_LORA + QK_ROPE + S5_WIDTH,
             Q_LORA + KV_LORA + QK_ROPE + S5_WIDTH + D_MODEL)

kernel_name = 'hybrid_mla_s5_diffusion_step'


def rms_norm(x, g):
    xf = x.astype(jnp.float32)
    y = xf * lax.rsqrt(jnp.mean(jnp.square(xf), axis=-1, keepdims=True) + EPS)
    return (y * g.astype(jnp.float32)).astype(x.dtype)


def axial_rope(n_tokens):
    rows = n_tokens // GRID_W
    row = jnp.repeat(jnp.arange(rows, dtype=jnp.float32), GRID_W)
    col = jnp.tile(jnp.arange(GRID_W, dtype=jnp.float32), rows)
    n_freq = QK_ROPE // 4
    inv_freq = ROPE_THETA ** (-jnp.arange(n_freq, dtype=jnp.float32) / n_freq)
    ang = jnp.concatenate([row[:, None] * inv_freq, col[:, None] * inv_freq], axis=-1)
    ang = jnp.concatenate([ang, ang], axis=-1)
    return jnp.cos(ang), jnp.sin(ang)


def apply_rope(x, cos, sin):
    xf = x.astype(jnp.float32)
    x1, x2 = jnp.split(xf, 2, axis=-1)
    rot = jnp.concatenate([-x2, x1], axis=-1)
    return (xf * cos + rot * sin).astype(x.dtype)


def adaln(cond, w_mod, b_mod):
    m = jax.nn.silu(cond) @ w_mod + b_mod
    return m.reshape(cond.shape[0], 1, N_MOD, D_MODEL)


def modulated_norm(x, g, shift, scale):
    return rms_norm(x, g) * (1 + scale) + shift


def block_attention(q, k, v):
    b, l, h, dqk = q.shape
    nb = l // Q_BLOCK
    qb = q.reshape(b, nb, Q_BLOCK, h, dqk).transpose(1, 0, 2, 3, 4)
    scale = dqk ** -0.5

    def one_block(q_blk):
        s = jnp.einsum('bqhd,bkhd->bhqk', q_blk, k).astype(jnp.float32) * scale
        p = jax.nn.softmax(s, axis=-1).astype(v.dtype)
        return jnp.einsum('bhqk,bkhd->bqhd', p, v)

    o = lax.map(one_block, qb)
    return o.transpose(1, 0, 2, 3, 4).reshape(b, l, h * V_HEAD)


def mla_queries(q_lat, lp):
    q = rms_norm(q_lat, lp['g_q_lat']) @ lp['w_uq']
    return q.reshape(q.shape[0], q.shape[1], N_HEADS, QK_HEAD)


def decompress_kv(ckv_n, k_rope, lp):
    b, lk, _ = ckv_n.shape
    kv = (ckv_n @ lp['w_ukv']).reshape(b, lk, N_HEADS, QK_NOPE + V_HEAD)
    k_nope, v = kv[..., :QK_NOPE], kv[..., QK_NOPE:]
    k_r = jnp.broadcast_to(k_rope[:, :, None, :], (b, lk, N_HEADS, QK_ROPE))
    return jnp.concatenate([k_nope, k_r], axis=-1), v


def diag_scan(a_bar, bu, h0, reverse):
    if reverse:
        bu = jnp.flip(bu, axis=1)
    bu = bu.at[:, 0].add(a_bar * h0)
    a = jnp.broadcast_to(a_bar, (1,) + bu.shape[1:])

    def combine(e1, e2):
        a1, b1 = e1
        a2, b2 = e2
        return a1 * a2, a2 * b1 + b2

    _, h = lax.associative_scan(combine, (a, bu), axis=1)
    h_last = h[:, -1]
    if reverse:
        h = jnp.flip(h, axis=1)
    return h, h_last


def s5_branch(u, h0, lp):
    b, l, _ = u.shape
    f32 = jnp.float32
    uf = u.astype(f32)
    uc = uf.reshape(b, l, S5_GROUPS, S5_GROUP).astype(jnp.complex64)
    y = uf * lp['s5_d'].astype(f32)
    finals = []
    for d, reverse in ((0, False), (1, True)):
        lam = lax.complex(lp['s5_lam_re'][d].astype(f32), lp['s5_lam_im'][d].astype(f32))
        dt = jnp.exp(lp['s5_log_dt'][d].astype(f32))[:, None]
        a_bar = jnp.exp(lam * dt)
        b_mat = lax.complex(lp['s5_b_re'][d].astype(f32), lp['s5_b_im'][d].astype(f32))
        b_bar = ((a_bar - 1.0) / lam)[..., None] * b_mat
        c_mat = lax.complex(lp['s5_c_re'][d].astype(f32), lp['s5_c_im'][d].astype(f32))
        bu = jnp.einsum('blgj,gpj->blgp', uc, b_bar)
        h, h_last = diag_scan(a_bar, bu, h0[:, d], reverse)
        y = y + jnp.einsum('blgp,gjp->blgj', h, c_mat).real.reshape(b, l, S5_WIDTH)
        finals.append(h_last)
    z = jax.nn.gelu(y).astype(u.dtype) @ lp['w_glu']
    za, zb = jnp.split(z, 2, axis=-1)
    return za * jax.nn.sigmoid(zb), jnp.stack(finals, axis=1)


def merge_branches(o_a, o_b, g_a, g_b, lp):
    m = jax.nn.sigmoid(g_a) * o_a + jax.nn.sigmoid(g_b) * o_b
    return m @ lp['w_out']


def context_mixer(h, lp):
    b = h.shape[0]
    q_lat, ckv, k_rope, u, g_a, g_b = jnp.split(h @ lp['w_in'], IN_SPLITS, axis=-1)
    q = mla_queries(q_lat, lp)
    ckv_n = rms_norm(ckv, lp['g_kv_lat'])
    k, v = decompress_kv(ckv_n, k_rope, lp)
    o_a = block_attention(q, k, v)
    h0 = jnp.zeros((b, 2, S5_GROUPS, S5_STATE), jnp.complex64)
    o_b, s5_last = s5_branch(u, h0, lp)
    return merge_branches(o_a, o_b, g_a, g_b, lp), ckv_n, k_rope, s5_last


def latent_mixer(h, ctx_ckv, ctx_krope, ctx_s5, cos, sin, lp):
    q_lat, ckv, k_rope, u, g_a, g_b = jnp.split(h @ lp['w_in'], IN_SPLITS, axis=-1)
    q = mla_queries(q_lat, lp)
    q = jnp.concatenate([q[..., :QK_NOPE], apply_rope(q[..., QK_NOPE:], cos[:, None], sin[:, None])], axis=-1)
    k_rope = apply_rope(k_rope, cos, sin)
    ckv_all = jnp.concatenate([ctx_ckv.astype(h.dtype), rms_norm(ckv, lp['g_kv_lat'])], axis=1)
    krope_all = jnp.concatenate([ctx_krope.astype(h.dtype), k_rope], axis=1)
    k, v = decompress_kv(ckv_all, krope_all, lp)
    o_a = block_attention(q, k, v)
    o_b, _ = s5_branch(u, ctx_s5, lp)
    return merge_branches(o_a, o_b, g_a, g_b, lp)


def mixer_input(x, mod, lp):
    return modulated_norm(x, lp['g_pre_mix'], mod[:, :, 0], mod[:, :, 1])


def add_mixer(x, out, mod, lp):
    return x + mod[:, :, 2] * rms_norm(out, lp['g_post_mix'])


def add_ffn(x, mod, lp):
    h = modulated_norm(x, lp['g_pre_mlp'], mod[:, :, 3], mod[:, :, 4])
    a = jnp.square(jax.nn.relu(h @ lp['w_ff1'])) @ lp['w_ff2']
    return x + mod[:, :, 5] * rms_norm(a, lp['g_post_mlp'])


def setup_inputs(seed: int = 0) -> dict:
    key = jax.random.key(seed)
    ks = jax.random.split(key, 32)
    f32 = jnp.float32

    def nrm(k, shape, scale=1.0):
        return jax.random.normal(k, shape, f32) * scale

    def gain(k, shape):
        return 1.0 + 0.05 * jax.random.normal(k, shape, f32)

    G, P, J = S5_GROUPS, S5_STATE, S5_GROUP
    n_idx = jnp.arange(P, dtype=f32)
    return {
        'x_prompt': nrm(ks[0], (BATCH, SEQ, D_MODEL)),
        'x_sample': nrm(ks[1], (DEC_BATCH, DEC_SEQ, D_MODEL)),
        'c': nrm(ks[2], (DEC_BATCH, D_MODEL)),
        'cache_ckv': nrm(ks[3], (DEC_BATCH, DEPTH, PAST_LEN, KV_LORA)),
        'cache_krope': nrm(ks[4], (DEC_BATCH, DEPTH, PAST_LEN, QK_ROPE)),
        'state_s5': nrm(ks[5], (DEC_BATCH, DEPTH, 2, 2, G, P), 0.1),
        'c_ctx': nrm(ks[6], (D_MODEL,)),
        'w_mod': nrm(ks[7], (DEPTH, D_MODEL, N_MOD * D_MODEL), 0.5 * D_MODEL ** -0.5),
        'b_mod': nrm(ks[8], (DEPTH, N_MOD * D_MODEL), 0.01),
        'g_pre_mix': gain(ks[9], (DEPTH, D_MODEL)),
        'w_in': nrm(ks[10], (DEPTH, D_MODEL, IN_COLS), D_MODEL ** -0.5),
        'g_q_lat': gain(ks[11], (DEPTH, Q_LORA)),
        'g_kv_lat': gain(ks[12], (DEPTH, KV_LORA)),
        'w_uq': nrm(ks[13], (DEPTH, Q_LORA, N_HEADS * QK_HEAD), Q_LORA ** -0.5),
        'w_ukv': nrm(ks[14], (DEPTH, KV_LORA, N_HEADS * (QK_NOPE + V_HEAD)), KV_LORA ** -0.5),
        's5_lam_re': -0.5 + 0.02 * nrm(ks[15], (DEPTH, 2, G, P)),
        's5_lam_im': math.pi * n_idx + 0.01 * nrm(ks[16], (DEPTH, 2, G, P)),
        's5_log_dt': jax.random.uniform(ks[17], (DEPTH, 2, G), f32, math.log(1e-3), math.log(1e-1)),
        's5_b_re': nrm(ks[18], (DEPTH, 2, G, P, J), (2 * J) ** -0.5),
        's5_b_im': nrm(ks[19], (DEPTH, 2, G, P, J), (2 * J) ** -0.5),
        's5_c_re': nrm(ks[20], (DEPTH, 2, G, J, P), (2 * P) ** -0.5),
        's5_c_im': nrm(ks[21], (DEPTH, 2, G, J, P), (2 * P) ** -0.5),
        's5_d': nrm(ks[22], (DEPTH, S5_WIDTH)),
        'w_glu': nrm(ks[23], (DEPTH, S5_WIDTH, 2 * D_MODEL), S5_WIDTH ** -0.5),
        'w_out': nrm(ks[24], (DEPTH, D_MODEL, D_MODEL), D_MODEL ** -0.5),
        'g_post_mix': gain(ks[25], (DEPTH, D_MODEL)),
        'g_pre_mlp': gain(ks[26], (DEPTH, D_MODEL)),
        'w_ff1': nrm(ks[27], (DEPTH, D_MODEL, D_FF), D_MODEL ** -0.5),
        'w_ff2': nrm(ks[28], (DEPTH, D_FF, D_MODEL), D_FF ** -0.5),
        'g_post_mlp': gain(ks[29], (DEPTH, D_MODEL)),
    }


def reference(x_prompt, x_sample, c, cache_ckv, cache_krope, state_s5, c_ctx, w_mod, b_mod,
              g_pre_mix, w_in, g_q_lat, g_kv_lat, w_uq, w_ukv, s5_lam_re, s5_lam_im, s5_log_dt,
              s5_b_re, s5_b_im, s5_c_re, s5_c_im, s5_d, w_glu, w_out, g_post_mix, g_pre_mlp,
              w_ff1, w_ff2, g_post_mlp):
    f32 = jnp.float32
    cos, sin = axial_rope(x_sample.shape[1])
    xp, xs = x_prompt, x_sample
    new_ckv, new_krope, new_s5 = [], [], []
    for l in range(DEPTH):
        lp = {
            'g_pre_mix': g_pre_mix[l], 'w_in': w_in[l], 'g_q_lat': g_q_lat[l], 'g_kv_lat': g_kv_lat[l],
            'w_uq': w_uq[l], 'w_ukv': w_ukv[l], 's5_lam_re': s5_lam_re[l], 's5_lam_im': s5_lam_im[l],
            's5_log_dt': s5_log_dt[l], 's5_b_re': s5_b_re[l], 's5_b_im': s5_b_im[l],
            's5_c_re': s5_c_re[l], 's5_c_im': s5_c_im[l], 's5_d': s5_d[l], 'w_glu': w_glu[l],
            'w_out': w_out[l], 'g_post_mix': g_post_mix[l], 'g_pre_mlp': g_pre_mlp[l],
            'w_ff1': w_ff1[l], 'w_ff2': w_ff2[l], 'g_post_mlp': g_post_mlp[l],
        }
        mod_p = adaln(c_ctx[None, :], w_mod[l], b_mod[l])
        out_p, ckv_n, k_rope_p, s5_last = context_mixer(mixer_input(xp, mod_p, lp), lp)
        xp = add_ffn(add_mixer(xp, out_p, mod_p, lp), mod_p, lp)
        new_ckv.append(ckv_n)
        new_krope.append(k_rope_p)
        new_s5.append(jnp.stack([s5_last.real, s5_last.imag], axis=2))
        mod_s = adaln(c, w_mod[l], b_mod[l])
        ctx_s5 = lax.complex(state_s5[:, l, :, 0].astype(f32), state_s5[:, l, :, 1].astype(f32))
        out_s = latent_mixer(mixer_input(xs, mod_s, lp), cache_ckv[:, l], cache_krope[:, l], ctx_s5, cos, sin, lp)
        xs = add_ffn(add_mixer(xs, out_s, mod_s, lp), mod_s, lp)
    new_cache_ckv = jnp.stack(new_ckv, axis=1)
    new_cache_krope = jnp.stack(new_krope, axis=1)
    new_state_s5 = jnp.stack(new_s5, axis=1).astype(x_prompt.dtype)
    return (xp, xs, new_cache_ckv, new_cache_krope, new_state_s5)
```

```cpp
#include <hip/hip_runtime.h>
#include <cstdio>
#include <cstdint>
namespace pg8 {
#define PG8_LAS __attribute__((address_space(3)))
typedef unsigned short bf16_t;
typedef short bf16x8 __attribute__((ext_vector_type(8)));
typedef float f32x4 __attribute__((ext_vector_type(4)));
typedef unsigned u32x4 __attribute__((ext_vector_type(4)));
constexpr int BM = 256, BK = 64, HALF = 128, HTB = HALF * BK * 2  , STAGE_BYTES = 8 * HTB, NXCD = 8, WGM = 8;

__host__ __device__ __forceinline__ int lds_byte(int r, int c) { const int st = (r >> 4) * 2 + (c >> 5), rr = r & 15, cc = c & 31, ob = rr * 64 + cc * 2; return st * 1024 + (ob ^ (((ob >> 9) & 1) << 5)); }
__host__ __device__ __forceinline__ void stage_rc(int b, int& R, int& C) { const int st = b / 1024, sb = b % 1024, swz = sb ^ (((sb >> 9) & 1) << 5); R = (st >> 1) * 16 + swz / 64; C = (st & 1) * 32 + (swz % 64) / 2; }
__host__ __device__ __forceinline__ int perm32(int rho) { const int n = rho >> 4, i = rho & 15; return 8 * (i >> 2) + 4 * n + (i & 3); }

struct Unit { int pm, pn; };
struct Gemm { const bf16_t* A; const bf16_t* Bt; int lda, ldb, K; };

struct StaticOrder {
    int nM, nN, nwg, G, c;
    __host__ __device__ void init(int M, int N, int G_, int c_) { nM = M / BM; nN = N / BM; nwg = nM * nN; G = G_; c = c_; }
    __host__ __device__ bool next(int i, Unit& u) const {
        const long L = (long)i * G + c; if (L >= nwg) return false;
        int wgid = (int)L; { const int q = nwg / NXCD, r = nwg % NXCD, xcd = wgid % NXCD, off = wgid / NXCD; wgid = (xcd < r ? xcd * (q + 1) : r * (q + 1) + (xcd - r) * q) + off; }
        const int nig = WGM * nN, gid = wgid / nig, fm = gid * WGM, gsz = (nM - fm) < WGM ? (nM - fm) : WGM;
        u.pm = fm + ((wgid % nig) % gsz); u.pn = (wgid % nig) / gsz; return true;
    }
    __device__ __forceinline__ void a_ready(const Unit&) const {}
    __device__ __forceinline__ void done(const Unit&) const {}
};
struct GroupOrder {
    int nunits, per, G, c;
    __device__ bool next(int i, Unit& u) const { const int L = i * G + c; if (L >= nunits) return false; u.pm = L; u.pn = L / per; return true; }
    __device__ __forceinline__ void a_ready(const Unit&) const {}
    __device__ __forceinline__ void done(const Unit&) const {}
};

__device__ __forceinline__ unsigned cvt_pk_bf16(float lo, float hi) { unsigned r; asm volatile("v_cvt_pk_bf16_f32 %0, %1, %2" : "=v"(r) : "v"(lo), "v"(hi)); return r; }
__device__ __forceinline__ u32x4 pack8(const f32x4 a, const f32x4 b) { u32x4 w; w.x = cvt_pk_bf16(a[0], a[1]); w.y = cvt_pk_bf16(a[2], a[3]); w.z = cvt_pk_bf16(b[0], b[1]); w.w = cvt_pk_bf16(b[2], b[3]); return w; }
__device__ __forceinline__ float bflo(unsigned w) { return __uint_as_float(w << 16); }
__device__ __forceinline__ float bfhi(unsigned w) { return __uint_as_float(w & 0xffff0000u); }
__device__ __forceinline__ float sigm(float x) { return __builtin_amdgcn_rcpf(1.0f + __builtin_amdgcn_exp2f(-1.4426950408889634f * x)); }
__device__ __forceinline__ float gelu_tanh(float y) { return y * sigm(1.5957691216057308f * (y + 0.044715f * y * y * y)); }
__device__ __forceinline__ float sumsq8(const f32x4 a, const f32x4 b) { return (a[0] * a[0] + a[1] * a[1]) + (a[2] * a[2] + a[3] * a[3]) + (b[0] * b[0] + b[1] * b[1]) + (b[2] * b[2] + b[3] * b[3]); }

struct EpiIn {
    static constexpr bool PERM = true, AFTER_DRAIN = false;
    bf16_t* qraw; float* ckvraw; float* krraw; bf16_t* UH; bf16_t* ga; bf16_t* gb; float* qstat; float* kvstat;
    __device__ __forceinline__ void operator()(const f32x4 (&acc)[2][2][4][2], const Unit& u, int wr, int wc, int fr, int fq) const {
        asm volatile("" : "+v"(fr), "+v"(fq));
        const int row0 = u.pm * BM + wr * 64 + fr, colL = wc * 32 + 8 * fq, pn = u.pn;
        if (pn < 4) {
#pragma unroll
            for (int ai = 0; ai < 2; ++ai)
#pragma unroll
                for (int m = 0; m < 4; ++m) { const int row = row0 + ai * HALF + m * 16; float ss = 0.f;
#pragma unroll
                    for (int bj = 0; bj < 2; ++bj) { const f32x4 a = acc[ai][bj][m][0], b = acc[ai][bj][m][1]; ss += sumsq8(a, b);
                        *(u32x4*)(qraw + (size_t)row * 1024 + pn * 256 + bj * HALF + colL) = pack8(a, b); }
                    ss += __shfl_xor(ss, 16); ss += __shfl_xor(ss, 32);
                    if (fq == 0) qstat[row * 16 + pn * 4 + wc] = ss; }
        } else if (pn < 6) {
            const int t = pn - 4;
#pragma unroll
            for (int ai = 0; ai < 2; ++ai)
#pragma unroll
                for (int m = 0; m < 4; ++m) { const int row = row0 + ai * HALF + m * 16; float ss = 0.f;
#pragma unroll
                    for (int bj = 0; bj < 2; ++bj) { const f32x4 a = acc[ai][bj][m][0], b = acc[ai][bj][m][1]; ss += sumsq8(a, b);
                        float* p = ckvraw + (size_t)row * 512 + t * 256 + bj * HALF + colL; *(f32x4*)p = a; *(f32x4*)(p + 4) = b; }
                    ss += __shfl_xor(ss, 16); ss += __shfl_xor(ss, 32);
                    if (fq == 0) kvstat[row * 8 + t * 4 + wc] = ss; }
        } else if (pn < 14) {
            const int t = pn - 6;
#pragma unroll
            for (int ai = 0; ai < 2; ++ai)
#pragma unroll
                for (int m = 0; m < 4; ++m) { const int row = row0 + ai * HALF + m * 16;
#pragma unroll
                    for (int bj = 0; bj < 2; ++bj) { const int col = t * 256 + bj * HALF + colL, g = col >> 4, j0 = col & 15;
                        *(u32x4*)(UH + ((size_t)g * 1536 + (row >> 4)) * 512 + (row & 15) * 16 + j0) = pack8(acc[ai][bj][m][0], acc[ai][bj][m][1]); } }
        } else if (pn < 46) {
            bf16_t* dst = pn < 30 ? ga + (pn - 14) * 256 : gb + (pn - 30) * 256;
#pragma unroll
            for (int ai = 0; ai < 2; ++ai)
#pragma unroll
                for (int m = 0; m < 4; ++m) { const int row = row0 + ai * HALF + m * 16;
#pragma unroll
                    for (int bj = 0; bj < 2; ++bj) *(u32x4*)(dst + (size_t)row * 4096 + bj * HALF + colL) = pack8(acc[ai][bj][m][0], acc[ai][bj][m][1]); }
        } else {
            if (wc < 2) {
#pragma unroll
                for (int ai = 0; ai < 2; ++ai)
#pragma unroll
                    for (int m = 0; m < 4; ++m) { const int row = row0 + ai * HALF + m * 16; float* p = krraw + (size_t)row * 64 + colL;
                        *(f32x4*)p = acc[ai][0][m][0]; *(f32x4*)(p + 4) = acc[ai][0][m][1]; }
            }
        }
    }
};
struct EpiBf {
    static constexpr bool PERM = true, AFTER_DRAIN = false;
    bf16_t* O; int ldc;
    __device__ __forceinline__ void operator()(const f32x4 (&acc)[2][2][4][2], const Unit& u, int wr, int wc, int fr, int fq) const {
        asm volatile("" : "+v"(fr), "+v"(fq));
        const int row0 = u.pm * BM + wr * 64 + fr, col0 = u.pn * BM + wc * 32 + 8 * fq;
#pragma unroll
        for (int ai = 0; ai < 2; ++ai)
#pragma unroll
            for (int m = 0; m < 4; ++m) { bf16_t* rowp = O + (size_t)(row0 + ai * HALF + m * 16) * ldc + col0;
#pragma unroll
                for (int bj = 0; bj < 2; ++bj) *(u32x4*)(rowp + bj * HALF) = pack8(acc[ai][bj][m][0], acc[ai][bj][m][1]); }
    }
};
struct EpiQ {
    static constexpr bool PERM = true, AFTER_DRAIN = false;
    bf16_t* Q; const float* tab; float c2;
    __device__ __forceinline__ void operator()(const f32x4 (&acc)[2][2][4][2], const Unit& u, int wr, int wc, int fr, int fq) const {
        asm volatile("" : "+v"(fr), "+v"(fq));
        const int row0 = u.pm * BM + wr * 64 + fr, col0 = u.pn * BM + wc * 32 + 8 * fq;
        const bool rope = (u.pn >= 16) && (u.pm >= 32);
#pragma unroll
        for (int ai = 0; ai < 2; ++ai)
#pragma unroll
            for (int m = 0; m < 4; ++m) { const int row = row0 + ai * HALF + m * 16; bf16_t* rowp = Q + (size_t)row * 6144 + col0;
#pragma unroll
                for (int bj = 0; bj < 2; ++bj) { f32x4 a = acc[ai][bj][m][0], b = acc[ai][bj][m][1];
                    if (rope) { const int t = (row - 8192) & 4095, p0 = ((col0 + bj * HALF - 4096) & 63) >> 1;
                        const f32x4 cs0 = *(const f32x4*)(tab + ((size_t)t * 32 + p0) * 2), cs1 = *(const f32x4*)(tab + ((size_t)t * 32 + p0 + 2) * 2);
                        f32x4 ra, rb;
                        ra[0] = a[0] * cs0[0] - a[1] * cs0[1]; ra[1] = a[1] * cs0[0] + a[0] * cs0[1]; ra[2] = a[2] * cs0[2] - a[3] * cs0[3]; ra[3] = a[3] * cs0[2] + a[2] * cs0[3];
                        rb[0] = b[0] * cs1[0] - b[1] * cs1[1]; rb[1] = b[1] * cs1[0] + b[0] * cs1[1]; rb[2] = b[2] * cs1[2] - b[3] * cs1[3]; rb[3] = b[3] * cs1[2] + b[2] * cs1[3];
                        a = ra; b = rb; }
                    *(u32x4*)(rowp + bj * HALF) = pack8(a * c2, b * c2); } }
    }
};
struct EpiS {
    static constexpr bool PERM = false, AFTER_DRAIN = false;
    float* S;
    __device__ __forceinline__ void operator()(const f32x4 (&acc)[2][2][4][2], const Unit& u, int wr, int wc, int fr, int fq) const {
        asm volatile("" : "+v"(fr), "+v"(fq));
        const int row0 = u.pm * BM + wr * 64 + fr, col0 = wc * 32 + 4 * fq;
#pragma unroll
        for (int ai = 0; ai < 2; ++ai)
#pragma unroll
            for (int m = 0; m < 4; ++m) { float* rowp = S + (size_t)(row0 + ai * HALF + m * 16) * 256 + col0;
#pragma unroll
                for (int bj = 0; bj < 2; ++bj)
#pragma unroll
                    for (int n = 0; n < 2; ++n) *(f32x4*)(rowp + bj * HALF + n * 16) = acc[ai][bj][m][n]; }
    }
};
struct EpiY {
    static constexpr bool PERM = true, AFTER_DRAIN = false;
    bf16_t* Yg;
    __device__ __forceinline__ void operator()(const f32x4 (&acc)[2][2][4][2], const Unit& u, int wr, int wc, int fr, int fq) const {
        asm volatile("" : "+v"(fr), "+v"(fq));
        const int g = u.pn, c0 = (u.pm - 6 * g) * BM + wr * 64 + fr, n0 = wc * 32 + 8 * fq;
#pragma unroll
        for (int ai = 0; ai < 2; ++ai)
#pragma unroll
            for (int m = 0; m < 4; ++m) { const int c = c0 + ai * HALF + m * 16;
#pragma unroll
                for (int bj = 0; bj < 2; ++bj) { const int nn = bj * HALF + n0, tau = nn >> 4, j0 = nn & 15; f32x4 a = acc[ai][bj][m][0], b = acc[ai][bj][m][1];
#pragma unroll
                    for (int e = 0; e < 4; ++e) { a[e] = gelu_tanh(a[e]); b[e] = gelu_tanh(b[e]); }
                    *(u32x4*)(Yg + (size_t)(c * 16 + tau) * 2048 + g * 16 + j0) = pack8(a, b); } }
    }
};
struct EpiGlu {
    static constexpr bool PERM = true, AFTER_DRAIN = false;
    bf16_t* M; const bf16_t* gb;
    __device__ __forceinline__ void operator()(const f32x4 (&acc)[2][2][4][2], const Unit& u, int wr, int wc, int fr, int fq) const {
        asm volatile("" : "+v"(fr), "+v"(fq));
        const int row0 = u.pm * BM + wr * 64 + fr, col0 = u.pn * HALF + wc * 32 + 8 * fq;
#pragma unroll
        for (int ai = 0; ai < 2; ++ai)
#pragma unroll
            for (int m = 0; m < 4; ++m) { const size_t off = (size_t)(row0 + ai * HALF + m * 16) * 4096 + col0;
                const u32x4 gv = *(const u32x4*)(gb + off), mv = *(const u32x4*)(M + off); f32x4 o0, o1;
#pragma unroll
                for (int e = 0; e < 4; ++e) { const unsigned gw = gv[e >> 1], mw = mv[e >> 1];
                    const float g = (e & 1) ? bfhi(gw) : bflo(gw), ma = (e & 1) ? bfhi(mw) : bflo(mw);
                    o0[e] = sigm(g) * (acc[ai][0][m][0][e] * sigm(acc[ai][1][m][0][e])) + ma; }
#pragma unroll
                for (int e = 0; e < 4; ++e) { const unsigned gw = gv[2 + (e >> 1)], mw = mv[2 + (e >> 1)];
                    const float g = (e & 1) ? bfhi(gw) : bflo(gw), ma = (e & 1) ? bfhi(mw) : bflo(mw);
                    o1[e] = sigm(g) * (acc[ai][0][m][1][e] * sigm(acc[ai][1][m][1][e])) + ma; }
                *(u32x4*)(M + off) = pack8(o0, o1); }
    }
};
struct EpiStat {
    static constexpr bool PERM = true, AFTER_DRAIN = false;
    bf16_t* O; float* stat;
    __device__ __forceinline__ void operator()(const f32x4 (&acc)[2][2][4][2], const Unit& u, int wr, int wc, int fr, int fq) const {
        asm volatile("" : "+v"(fr), "+v"(fq));
        const int row0 = u.pm * BM + wr * 64 + fr, col0 = u.pn * BM + wc * 32 + 8 * fq;
#pragma unroll
        for (int ai = 0; ai < 2; ++ai)
#pragma unroll
            for (int m = 0; m < 4; ++m) { const int row = row0 + ai * HALF + m * 16; float ss = 0.f;
#pragma unroll
                for (int bj = 0; bj < 2; ++bj) { const f32x4 a = acc[ai][bj][m][0], b = acc[ai][bj][m][1]; ss += sumsq8(a, b);
                    *(u32x4*)(O + (size_t)row * 4096 + col0 + bj * HALF) = pack8(a, b); }
                ss += __shfl_xor(ss, 16); ss += __shfl_xor(ss, 32);
                if (fq == 0) stat[row * 64 + u.pn * 4 + wc] = ss; }
    }
};
struct EpiRelu2 {
    static constexpr bool PERM = true, AFTER_DRAIN = false;
    bf16_t* O;
    __device__ __forceinline__ void operator()(const f32x4 (&acc)[2][2][4][2], const Unit& u, int wr, int wc, int fr, int fq) const {
        asm volatile("" : "+v"(fr), "+v"(fq));
        const int row0 = u.pm * BM + wr * 64 + fr, col0 = u.pn * BM + wc * 32 + 8 * fq;
#pragma unroll
        for (int ai = 0; ai < 2; ++ai)
#pragma unroll
            for (int m = 0; m < 4; ++m) { bf16_t* rowp = O + (size_t)(row0 + ai * HALF + m * 16) * 16384 + col0;
#pragma unroll
                for (int bj = 0; bj < 2; ++bj) { f32x4 a = acc[ai][bj][m][0], b = acc[ai][bj][m][1];
#pragma unroll
                    for (int e = 0; e < 4; ++e) { const float x = fmaxf(a[e], 0.f), y = fmaxf(b[e], 0.f); a[e] = x * x; b[e] = y * y; }
                    *(u32x4*)(rowp + bj * HALF) = pack8(a, b); } }
    }
};

template <class Epi, class Sched, bool ALIGN_EPI = false, bool SP2 = false>
__device__ __forceinline__ void gemm_phase(PG8_LAS unsigned char* lds, const Gemm g, const Sched& S, const Epi& E) {
    int tid_ = threadIdx.x; asm volatile("" : "+v"(tid_));
    const int tid = tid_, wid = __builtin_amdgcn_readfirstlane(tid >> 6), lane = tid & 63, wr = wid >> 2, wc = wid & 3, fr = lane & 15, fq = lane >> 4;
    const int K = g.K, nt = K / BK, lda = g.lda, ldb = g.ldb;
    unsigned voffA[2], voffB[2];
#pragma unroll
    for (int i = 0; i < 2; ++i) { int R, C; stage_rc(tid * 16 + i * 8192, R, C); const int Rb = Epi::PERM ? ((R & ~31) + perm32(R & 31)) : R;
        voffA[i] = (unsigned)(R * lda + C) * 2u; voffB[i] = (unsigned)(Rb * ldb + C) * 2u; }
    const size_t kstep = (size_t)(BK * 2);
    const size_t hstepA = (size_t)HALF * lda * 2, hstepB = (size_t)HALF * ldb * 2;
    const size_t tstepA = 2 * hstepA, tstepB = 2 * hstepB;
    const unsigned ldsw = (unsigned)wid * 1024u;
    const int aoff = lds_byte(wr * 64 + fr, fq * 8), boff = lds_byte(wc * 32 + fr, fq * 8);
#define PG8_SA(b, h) (((b) * 2 + (h)) * HTB)
#define PG8_SB(b, h) ((4 + (b) * 2 + (h)) * HTB)
#define PG8_STAGE(bufoff, gbase, voff) do { _Pragma("unroll") for (int _i = 0; _i < 2; ++_i) \
        __builtin_amdgcn_global_load_lds((const unsigned*)((const char*)(gbase) + (voff)[_i]), (PG8_LAS unsigned*)(lds + (bufoff) + ldsw + _i * 8192), 16, 0, 0); } while (0)
#define PG8_LDA(dst, b, h) do { _Pragma("unroll") for (int m = 0; m < 4; ++m) _Pragma("unroll") for (int k = 0; k < 2; ++k) dst[m][k] = *(const PG8_LAS bf16x8*)(lds + PG8_SA(b, h) + aoff + m * 2048 + k * 1024); } while (0)
#define PG8_LDB(dst, b, h) do { _Pragma("unroll") for (int n = 0; n < 2; ++n) _Pragma("unroll") for (int k = 0; k < 2; ++k) dst[n][k] = *(const PG8_LAS bf16x8*)(lds + PG8_SB(b, h) + boff + n * 2048 + k * 1024); } while (0)
#define PG8_MMA(ai, bj, At, Bt) do { __builtin_amdgcn_s_setprio(1); _Pragma("unroll") for (int m = 0; m < 4; ++m) _Pragma("unroll") for (int n = 0; n < 2; ++n) _Pragma("unroll") for (int k = 0; k < 2; ++k) \
        acc[ai][bj][m][n] = __builtin_amdgcn_mfma_f32_16x16x32_bf16(Bt[n][k], At[m][k], acc[ai][bj][m][n], 0, 0, 0); __builtin_amdgcn_s_setprio(0); } while (0)
#define PG8_WAIT_V(n) asm volatile("s_waitcnt vmcnt(" #n ")" ::: "memory")
#define PG8_WAIT_L(n) asm volatile("s_waitcnt lgkmcnt(" #n ")" ::: "memory")
#define PG8_BAR __builtin_amdgcn_s_barrier()
#define PG8_SCHED __builtin_amdgcn_sched_barrier(0)
    Unit cur, nxt; int ui = 0;
    if (!S.next(0, cur)) return;
    f32x4 acc[2][2][4][2];
#pragma unroll
    for (int a = 0; a < 2; ++a)
#pragma unroll
        for (int b = 0; b < 2; ++b)
#pragma unroll
            for (int m = 0; m < 4; ++m)
#pragma unroll
                for (int n = 0; n < 2; ++n) acc[a][b][m][n] = (f32x4){0.f, 0.f, 0.f, 0.f};
    bf16x8 At[4][2], B0[2][2], B1[2][2];
    const char* cA = (const char*)g.A + (size_t)cur.pm * tstepA; const char* cB = (const char*)g.Bt + (size_t)cur.pn * tstepB;
    S.a_ready(cur);
    if constexpr (SP2) {
        PG8_STAGE(PG8_SB(0, 0), cB, voffB); PG8_STAGE(PG8_SB(0, 1), cB + hstepB, voffB); PG8_STAGE(PG8_SA(0, 0), cA, voffA); PG8_STAGE(PG8_SA(0, 1), cA + hstepA, voffA);
        if (wr == 1) PG8_BAR;
        PG8_WAIT_V(2); PG8_BAR;
        PG8_STAGE(PG8_SB(1, 0), cB + kstep, voffB); PG8_STAGE(PG8_SA(1, 0), cA + kstep, voffA); PG8_STAGE(PG8_SB(1, 1), cB + hstepB + kstep, voffB);
        PG8_WAIT_V(6); PG8_BAR;
    } else {
        PG8_STAGE(PG8_SB(0, 0), cB, voffB); PG8_STAGE(PG8_SA(0, 0), cA, voffA); PG8_STAGE(PG8_SB(0, 1), cB + hstepB, voffB); PG8_STAGE(PG8_SA(0, 1), cA + hstepA, voffA);
        if (wr == 1) PG8_BAR;
        PG8_WAIT_V(4); PG8_BAR;
        PG8_STAGE(PG8_SB(1, 0), cB + kstep, voffB); PG8_STAGE(PG8_SA(1, 0), cA + kstep, voffA); PG8_STAGE(PG8_SB(1, 1), cB + hstepB + kstep, voffB);
        PG8_WAIT_V(6); PG8_BAR;
    }
    for (;;) {
        const bool has_next = S.next(ui + 1, nxt);
        const char* nA = has_next ? (const char*)g.A + (size_t)nxt.pm * tstepA : cA; const char* nB = has_next ? (const char*)g.Bt + (size_t)nxt.pn * tstepB : cB;
        for (int t = 0; t < nt; t += 2) {
            const bool last = (t == nt - 2);
            const char* a1 = cA + (size_t)(t + 1) * kstep;
            const char* a2 = last ? nA : cA + (size_t)(t + 2) * kstep; const char* b2 = last ? nB : cB + (size_t)(t + 2) * kstep;
            const char* a3 = a2 + kstep; const char* b3 = b2 + kstep;
            if (last && has_next) S.a_ready(nxt);
            if constexpr (SP2) {
            PG8_LDB(B0, 0, 0); PG8_LDB(B1, 0, 1); PG8_SCHED; PG8_LDA(At, 0, 0); PG8_STAGE(PG8_SA(1, 1), a1 + hstepA, voffA);
            PG8_WAIT_V(8); PG8_WAIT_L(0); PG8_BAR; PG8_MMA(0, 0, At, B0); PG8_MMA(0, 1, At, B1); PG8_BAR; PG8_SCHED;
            PG8_LDA(At, 0, 1); PG8_STAGE(PG8_SB(0, 0), b2, voffB); PG8_STAGE(PG8_SB(0, 1), b2 + hstepB, voffB); PG8_STAGE(PG8_SA(0, 0), a2, voffA);
            PG8_WAIT_V(8); PG8_WAIT_L(0); PG8_BAR; PG8_MMA(1, 0, At, B0); PG8_MMA(1, 1, At, B1); PG8_BAR; PG8_SCHED;
            PG8_LDB(B0, 1, 0); PG8_LDB(B1, 1, 1); PG8_SCHED; PG8_LDA(At, 1, 0); PG8_STAGE(PG8_SA(0, 1), a2 + hstepA, voffA);
            PG8_WAIT_V(8); PG8_WAIT_L(0); PG8_BAR; PG8_MMA(0, 0, At, B0); PG8_MMA(0, 1, At, B1); PG8_BAR; PG8_SCHED;
            PG8_LDA(At, 1, 1); PG8_STAGE(PG8_SB(1, 0), b3, voffB); PG8_STAGE(PG8_SB(1, 1), b3 + hstepB, voffB); PG8_STAGE(PG8_SA(1, 0), a3, voffA);
            PG8_WAIT_V(8); PG8_WAIT_L(0); PG8_BAR; PG8_MMA(1, 0, At, B0); PG8_MMA(1, 1, At, B1); PG8_BAR; PG8_SCHED;
            } else {
            PG8_LDB(B0, 0, 0); PG8_SCHED; PG8_LDA(At, 0, 0); PG8_STAGE(PG8_SA(1, 1), a1 + hstepA, voffA);
            PG8_WAIT_L(8); PG8_BAR; PG8_WAIT_L(0); PG8_MMA(0, 0, At, B0); PG8_BAR; PG8_SCHED;
            PG8_LDB(B1, 0, 1); PG8_STAGE(PG8_SB(0, 0), b2, voffB);
            PG8_BAR; PG8_WAIT_L(0); PG8_MMA(0, 1, At, B1); PG8_BAR;
            PG8_LDA(At, 0, 1); PG8_STAGE(PG8_SA(0, 0), a2, voffA);
            PG8_BAR; PG8_WAIT_L(0); PG8_MMA(1, 0, At, B0); PG8_BAR; PG8_SCHED;
            PG8_STAGE(PG8_SB(0, 1), b2 + hstepB, voffB);
            PG8_WAIT_V(6); PG8_BAR; PG8_MMA(1, 1, At, B1); PG8_BAR;
            PG8_LDB(B0, 1, 0); PG8_SCHED; PG8_LDA(At, 1, 0); PG8_STAGE(PG8_SA(0, 1), a2 + hstepA, voffA);
            PG8_WAIT_L(8); PG8_BAR; PG8_WAIT_L(0); PG8_MMA(0, 0, At, B0); PG8_BAR; PG8_SCHED;
            PG8_LDB(B1, 1, 1); PG8_STAGE(PG8_SB(1, 0), b3, voffB);
            PG8_BAR; PG8_WAIT_L(0); PG8_MMA(0, 1, At, B1); PG8_BAR;
            PG8_LDA(At, 1, 1); PG8_STAGE(PG8_SA(1, 0), a3, voffA);
            PG8_BAR; PG8_WAIT_L(0); PG8_MMA(1, 0, At, B0); PG8_BAR; PG8_SCHED;
            PG8_STAGE(PG8_SB(1, 1), b3 + hstepB, voffB);
            PG8_WAIT_V(6); PG8_BAR; PG8_MMA(1, 1, At, B1); PG8_BAR;
            }
        }
        if constexpr (ALIGN_EPI) { if (wr == 0) PG8_BAR; }
        if constexpr (!Epi::AFTER_DRAIN) { E(acc, cur, wr, wc, fr, fq); S.done(cur); }
        if (!has_next) break;
#pragma unroll
        for (int a = 0; a < 2; ++a)
#pragma unroll
            for (int b = 0; b < 2; ++b)
#pragma unroll
                for (int m = 0; m < 4; ++m)
#pragma unroll
                    for (int n = 0; n < 2; ++n) acc[a][b][m][n] = (f32x4){0.f, 0.f, 0.f, 0.f};
        cur = nxt; cA = nA; cB = nB; ++ui;
        if constexpr (ALIGN_EPI) { if (wr == 1) PG8_BAR; }
    }
    PG8_WAIT_V(0);
    if constexpr (!ALIGN_EPI) { if (wr == 0) PG8_BAR; }
    PG8_BAR;
    if constexpr (Epi::AFTER_DRAIN) { E.fused(acc, cur, wr, wc, fr, fq, lds, wid, lane); S.done(cur); }
#undef PG8_SA
#undef PG8_SB
#undef PG8_STAGE
#undef PG8_LDA
#undef PG8_LDB
#undef PG8_MMA
#undef PG8_WAIT_V
#undef PG8_WAIT_L
#undef PG8_BAR
#undef PG8_SCHED
}
}

namespace att {
using bf16x8 = __attribute__((ext_vector_type(8))) short;
using s16x4  = __attribute__((ext_vector_type(4))) short;
using f32x16 = __attribute__((ext_vector_type(16))) float;
using u32x4  = __attribute__((ext_vector_type(4))) unsigned;
typedef unsigned short bf16;
#ifndef ATT_SDEPTH
#define ATT_SDEPTH 1
#endif
constexpr int NW = 8, QBLK = 32, KVBLK = 64;
constexpr int SHM_V = 16384, SHM_K = 16384, SHM_R = 8192;
constexpr int OFF_V = 0, OFF_K = 2 * SHM_V, OFF_R = OFF_K + 2 * SHM_K, OFF_WS = OFF_R + 2 * SHM_R, ATT_LDS = OFF_WS + NW * 256;
constexpr int LDQ = 6144, LDK = 8192, LDR = 64, LDO = 4096;
constexpr float THR_L2 = 11.5415603f;
#define KSWZ(row, colB) ((row) * 256 + ((colB) ^ (((row) & 7) << 4)))
#define RSWZ(row, colB) ((row) * 128 + ((colB) ^ ((((row) >> 1) & 7) << 4)))
#define SBAR() __builtin_amdgcn_sched_barrier(0)
__device__ __forceinline__ int crow(int r, int hi) { return (r & 3) + 8 * (r >> 2) + 4 * hi; }
__device__ __forceinline__ unsigned cvtpk(float lo, float hi) { unsigned r; asm volatile("v_cvt_pk_bf16_f32 %0, %1, %2" : "=v"(r) : "v"(lo), "v"(hi)); return r; }
__device__ __forceinline__ bf16x8 ld8(const bf16* p) { return *reinterpret_cast<const bf16x8*>(p); }

__device__ __forceinline__ void partialSM(f32x16& p0, f32x16& p1, float& m_reg, float& mn, float& alpha) {
  float pmax = p0[0];
#pragma unroll
  for (int r = 1; r < 16; ++r) pmax = fmaxf(pmax, p0[r]);
#pragma unroll
  for (int r = 0; r < 16; ++r) pmax = fmaxf(pmax, p1[r]);
  { auto rr = __builtin_amdgcn_permlane32_swap(__float_as_uint(pmax), __float_as_uint(pmax), false, false);
    pmax = fmaxf(__uint_as_float(rr[0]), __uint_as_float(rr[1])); }
  if (__builtin_expect(__all(pmax - m_reg <= THR_L2), 1)) { mn = m_reg; alpha = 1.f; }
  else { mn = fmaxf(m_reg, pmax); alpha = __builtin_amdgcn_exp2f(m_reg - mn); m_reg = mn; }
#pragma unroll
  for (int r = 0; r < 16; ++r) p0[r] = p0[r] - mn;
#pragma unroll
  for (int r = 0; r < 16; ++r) p1[r] = p1[r] - mn;
#pragma unroll
  for (int r = 0; r < 16; ++r) p0[r] = __builtin_amdgcn_exp2f(p0[r]);
}
__device__ __forceinline__ void finishSM(f32x16& p0, f32x16& p1, float alpha, float& l_reg, bf16x8& pa0, bf16x8& pa1, bf16x8& pa2, bf16x8& pa3) {
#pragma unroll
  for (int r = 0; r < 16; ++r) p1[r] = __builtin_amdgcn_exp2f(p1[r]);
  float ps = 0;
#pragma unroll
  for (int r = 0; r < 16; ++r) ps += p0[r];
#pragma unroll
  for (int r = 0; r < 16; ++r) ps += p1[r];
  { auto rr = __builtin_amdgcn_permlane32_swap(__float_as_uint(ps), __float_as_uint(ps), false, false);
    ps = __uint_as_float(rr[0]) + __uint_as_float(rr[1]); }
  l_reg = l_reg * alpha + ps;
#define PK4(P, BASE, OUT) do { unsigned a0 = cvtpk(P[BASE + 0], P[BASE + 1]), a1 = cvtpk(P[BASE + 2], P[BASE + 3]);   \
    unsigned b0 = cvtpk(P[BASE + 4], P[BASE + 5]), b1 = cvtpk(P[BASE + 6], P[BASE + 7]);                              \
    auto r0 = __builtin_amdgcn_permlane32_swap(a0, b0, false, false); auto r1 = __builtin_amdgcn_permlane32_swap(a1, b1, false, false); \
    u32x4 w = {r0[0], r1[0], r0[1], r1[1]}; OUT = *reinterpret_cast<bf16x8*>(&w); } while (0)
  PK4(p0, 0, pa0); PK4(p0, 8, pa1); PK4(p1, 0, pa2); PK4(p1, 8, pa3);
#undef PK4
}
__device__ __forceinline__ void qkt(f32x16& p0, f32x16& p1, const char* Ks, const char* Rs, const bf16x8* qn, const bf16x8* qr, int r32, int hi) {
  p0 = f32x16{}; p1 = f32x16{};
#pragma unroll
  for (int d0 = 0; d0 < 8; ++d0) { const int cb = (d0 * 16 + hi * 8) * 2;
    bf16x8 b0 = *reinterpret_cast<const bf16x8*>(Ks + KSWZ(r32, cb));
    bf16x8 b1 = *reinterpret_cast<const bf16x8*>(Ks + KSWZ(32 + r32, cb));
    p0 = __builtin_amdgcn_mfma_f32_32x32x16_bf16(b0, qn[d0], p0, 0, 0, 0);
    p1 = __builtin_amdgcn_mfma_f32_32x32x16_bf16(b1, qn[d0], p1, 0, 0, 0); }
#pragma unroll
  for (int d0 = 0; d0 < 4; ++d0) { const int cb = (d0 * 16 + hi * 8) * 2;
    bf16x8 b0 = *reinterpret_cast<const bf16x8*>(Rs + RSWZ(r32, cb));
    bf16x8 b1 = *reinterpret_cast<const bf16x8*>(Rs + RSWZ(32 + r32, cb));
    p0 = __builtin_amdgcn_mfma_f32_32x32x16_bf16(b0, qr[d0], p0, 0, 0, 0);
    p1 = __builtin_amdgcn_mfma_f32_32x32x16_bf16(b1, qr[d0], p1, 0, 0, 0); }
}
__device__ __forceinline__ int v_st(int k, int c) { const int kk = (k & ~0xC) | ((k & 4) << 1) | ((k & 8) >> 1); return ((kk >> 3) * 4 + (c >> 5)) * 512 + ((kk & 7) * 32 + (c & 31)) * 2; }
__device__ __forceinline__ int v_rd_base(int lane) { return ((lane & 3) << 3) | (((lane >> 2) & 3) << 6) | (((lane >> 4) & 1) << 5) | (((lane >> 5) & 1) << 8); }
constexpr int v_rd_off(int d0, int ks, int half) { return d0 * 512 + ks * 4096 + half * 2048; }
template <int OFF> __device__ __forceinline__ s16x4 tr_read(int vb) {
  s16x4 r; asm volatile("ds_read_b64_tr_b16 %0, %1 offset:%2" : "=&v"(r) : "v"(vb), "i"(OFF) : "memory"); return r;
}
template <int D0> __device__ __forceinline__ void pv_one(f32x16& od, int vb, bf16x8 pa0, bf16x8 pa1, bf16x8 pa2, bf16x8 pa3) {
  const s16x4 l0 = tr_read<v_rd_off(D0, 0, 0)>(vb), h0 = tr_read<v_rd_off(D0, 0, 1)>(vb), l1 = tr_read<v_rd_off(D0, 1, 0)>(vb), h1 = tr_read<v_rd_off(D0, 1, 1)>(vb);
  const s16x4 l2 = tr_read<v_rd_off(D0, 2, 0)>(vb), h2 = tr_read<v_rd_off(D0, 2, 1)>(vb), l3 = tr_read<v_rd_off(D0, 3, 0)>(vb), h3 = tr_read<v_rd_off(D0, 3, 1)>(vb);
  asm volatile("s_waitcnt lgkmcnt(0)" ::: "memory"); SBAR();
#define PK(L, H) (bf16x8){L[0], L[1], L[2], L[3], H[0], H[1], H[2], H[3]}
  od = __builtin_amdgcn_mfma_f32_32x32x16_bf16(pa0, PK(l0, h0), od, 0, 0, 0);
  od = __builtin_amdgcn_mfma_f32_32x32x16_bf16(pa1, PK(l1, h1), od, 0, 0, 0);
  od = __builtin_amdgcn_mfma_f32_32x32x16_bf16(pa2, PK(l2, h2), od, 0, 0, 0);
  od = __builtin_amdgcn_mfma_f32_32x32x16_bf16(pa3, PK(l3, h3), od, 0, 0, 0);
#undef PK
}
__device__ __forceinline__ void pv_d0(f32x16* o, int vb, bf16x8 pa0, bf16x8 pa1, bf16x8 pa2, bf16x8 pa3) {
  pv_one<0>(o[0], vb, pa0, pa1, pa2, pa3); pv_one<1>(o[1], vb, pa0, pa1, pa2, pa3); pv_one<2>(o[2], vb, pa0, pa1, pa2, pa3); pv_one<3>(o[3], vb, pa0, pa1, pa2, pa3);
}
__device__ __forceinline__ float sigm(float x) { return __builtin_amdgcn_rcpf(1.0f + __builtin_amdgcn_exp2f(-1.4426950408889634f * x)); }
__device__ __forceinline__ unsigned short f2bf(float f) { unsigned u = __float_as_uint(f); return (unsigned short)((u + 0x7fffu + ((u >> 16) & 1u)) >> 16); }

__device__ __forceinline__ void attn_unit(const bf16* __restrict__ Qn, const bf16* __restrict__ Qr, const bf16* __restrict__ Kh, const bf16* __restrict__ Vh,
                                          const bf16* __restrict__ Kr, const bf16* __restrict__ Ga, bf16* __restrict__ Mo, int seq, char* lds) {
  int tid_ = threadIdx.x; asm volatile("" : "+v"(tid_));
  const int tid = tid_, wid = tid >> 6, lane = tid & 63, r32 = lane & 31, hi = lane >> 5;
  char* V_lds = lds + OFF_V; char* K_lds = lds + OFF_K; char* R_lds = lds + OFF_R;
  float* ws = (float*)(lds + OFF_WS) + wid * 64; float* li_l = ws; float* al_l = ws + 32;
  float m_reg = -1e30f, l_reg = 0; f32x16 o[4] = {}; bf16x8 qn[8], qr[4];
  { const bf16* Qw = Qn + (long)(wid * QBLK + r32) * LDQ + hi * 8;
#pragma unroll
    for (int d0 = 0; d0 < 8; ++d0) qn[d0] = ld8(Qw + d0 * 16);
    const bf16* Rw = Qr + (long)(wid * QBLK + r32) * LDQ + hi * 8;
#pragma unroll
    for (int d0 = 0; d0 < 4; ++d0) qr[d0] = ld8(Rw + d0 * 16); }
  const int sr = tid >> 4, sc = (tid & 15) * 8, vst0 = v_st(sr, sc), vst1 = v_st(32 + sr, sc);
  const int rr_ = tid >> 3, rc_ = (tid & 7) * 8, rst = RSWZ(rr_, rc_ * 2);
  const int vb0 = (int)(unsigned)(uintptr_t)V_lds + v_rd_base(lane);
  constexpr int SDEPTH = ATT_SDEPTH;
  struct { bf16x8 vs0, vs1, ks0, ks1, rs; } sr_[SDEPTH];
#define SLOAD(i, k0) do { sr_[i].vs0 = ld8(&Vh[(long)((k0) + sr) * LDK + sc]); sr_[i].vs1 = ld8(&Vh[(long)((k0) + 32 + sr) * LDK + sc]); \
    sr_[i].ks0 = ld8(&Kh[(long)((k0) + sr) * LDK + sc]); sr_[i].ks1 = ld8(&Kh[(long)((k0) + 32 + sr) * LDK + sc]); \
    sr_[i].rs = ld8(&Kr[(long)((k0) + rr_) * LDR + rc_]); } while (0)
#define SWRITE(b, i) do { *(bf16x8*)(V_lds + (b) * SHM_V + vst0) = sr_[i].vs0;          \
    *(bf16x8*)(V_lds + (b) * SHM_V + vst1) = sr_[i].vs1; const int kc = sc * 2;               \
    *(bf16x8*)(K_lds + (b) * SHM_K + KSWZ(sr, kc)) = sr_[i].ks0;                       \
    *(bf16x8*)(K_lds + (b) * SHM_K + KSWZ(32 + sr, kc)) = sr_[i].ks1;                  \
    *(bf16x8*)(R_lds + (b) * SHM_R + rst) = sr_[i].rs; } while (0)
#define SWAIT() do { if constexpr (SDEPTH == 2) asm volatile("s_waitcnt vmcnt(5)" ::: "memory"); else asm volatile("s_waitcnt vmcnt(0)" ::: "memory"); } while (0)
#define RESC(a) do { if (__any((a) < 1.f)) { if (hi == 0) al_l[r32] = (a); asm volatile("s_waitcnt lgkmcnt(0)" ::: "memory"); \
    _Pragma("unroll") for (int d = 0; d < 4; ++d) _Pragma("unroll") for (int r = 0; r < 16; ++r) o[d][r] *= al_l[crow(r, hi)]; } } while (0)
  f32x16 pA0, pA1, pB0, pB1; float mnA, mnB, alA, alB; bf16x8 pa0, pa1, pa2, pa3; const int NT = seq / KVBLK;
  constexpr int SE = 0, SO = SDEPTH - 1;
  SLOAD(SE, 0); asm volatile("s_waitcnt vmcnt(0)" ::: "memory"); SWRITE(0, SE); __syncthreads();
  qkt(pA0, pA1, K_lds, R_lds, qn, qr, r32, hi); partialSM(pA0, pA1, m_reg, mnA, alA);
  SLOAD(SO, KVBLK); if constexpr (SDEPTH == 2) { if (2 < NT) SLOAD(SE, 2 * KVBLK); }
  SWAIT(); SWRITE(1, SO); __syncthreads();
  for (int j = 1; j + 1 < NT; j += 2) {
    SBAR(); qkt(pB0, pB1, K_lds + SHM_K, R_lds + SHM_R, qn, qr, r32, hi);
    finishSM(pA0, pA1, alA, l_reg, pa0, pa1, pa2, pa3); SBAR();
    SLOAD(SO, (j + SDEPTH) * KVBLK); SBAR();
    pv_d0(o, vb0, pa0, pa1, pa2, pa3); partialSM(pB0, pB1, m_reg, mnB, alB);
    __syncthreads(); SWAIT(); SWRITE(0, SE);
    RESC(alB); __syncthreads();
    SBAR(); qkt(pA0, pA1, K_lds, R_lds, qn, qr, r32, hi);
    finishSM(pB0, pB1, alB, l_reg, pa0, pa1, pa2, pa3); SBAR();
    if (SDEPTH == 1 || j + 3 < NT) SLOAD(SE, (j + 1 + SDEPTH) * KVBLK); SBAR();
    pv_d0(o, vb0 + SHM_V, pa0, pa1, pa2, pa3); partialSM(pA0, pA1, m_reg, mnA, alA);
    __syncthreads(); SWAIT(); SWRITE(1, SO);
    RESC(alA); __syncthreads();
  }
  SBAR(); qkt(pB0, pB1, K_lds + SHM_K, R_lds + SHM_R, qn, qr, r32, hi);
  finishSM(pA0, pA1, alA, l_reg, pa0, pa1, pa2, pa3); SBAR();
  pv_d0(o, vb0, pa0, pa1, pa2, pa3); partialSM(pB0, pB1, m_reg, mnB, alB);
  __syncthreads(); RESC(alB);
  finishSM(pB0, pB1, alB, l_reg, pa0, pa1, pa2, pa3); SBAR();
  pv_d0(o, vb0 + SHM_V, pa0, pa1, pa2, pa3);
  if (hi == 0) li_l[r32] = l_reg; asm volatile("s_waitcnt lgkmcnt(0)" ::: "memory");
  float rli[16];
#pragma unroll
  for (int r = 0; r < 16; ++r) rli[r] = __builtin_amdgcn_rcpf(li_l[crow(r, hi)]);
  bf16* Ow = Mo + (long)(wid * QBLK) * LDO; const bf16* Gw = Ga + (long)(wid * QBLK) * LDO;
#pragma unroll
  for (int r = 0; r < 16; ++r) { const int orow = crow(r, hi);
#pragma unroll
    for (int d0 = 0; d0 < 4; ++d0) { const long off = (long)orow * LDO + d0 * 32 + r32;
      const float g = __uint_as_float((unsigned)Gw[off] << 16);
      Ow[off] = f2bf(o[d0][r] * rli[r] * sigm(g)); } }
  __syncthreads();
#undef SLOAD
#undef SWRITE
#undef SWAIT
#undef RESC
}
#undef KSWZ
#undef RSWZ
#undef SBAR
}

constexpr int NWAVES = 8;
constexpr int DM = 4096, NPR = 8192, NROW = 24576;
constexpr int NKEY = 8192 + 4 * 4608;
constexpr int NIN = 12032;
constexpr int NCHUNK = NROW / 16;
constexpr float EPSN = 1e-6f;
constexpr float QSCALE = 0.07216878364870322f * 1.4426950408889634f;
constexpr size_t O_Y = 0, O_CKV = 100663296, O_KR = 104857600, O_S5 = 105381888, O_END = 106430464;

constexpr size_t MiB = 1u << 20;
constexpr size_t WS_CTL = 0, CTL_ZERO_BYTES = 1 * MiB;
constexpr size_t WS_PAR = 1 * MiB;
constexpr size_t WS_TAB = 2 * MiB;
constexpr size_t WS_QSTAT = 3 * MiB;
constexpr size_t WS_KVSTAT = 5 * MiB;
constexpr size_t WS_OSTAT = 6 * MiB;
constexpr size_t WS_MODPART = 12 * MiB;
constexpr size_t WS_WGLU = 28 * MiB, WS_WOUT = 60 * MiB, WS_WUQ = 92 * MiB, WS_WUKV = 104 * MiB;
constexpr size_t WS_GA = 112 * MiB, WS_GB = 304 * MiB;
constexpr size_t WS_WFF1 = 112 * MiB, WS_WFF2 = 240 * MiB;
constexpr size_t WS_A = 496 * MiB;
constexpr size_t WS_X = 688 * MiB;
constexpr size_t WS_WIN = WS_X, WS_MSTATE = WS_X + 94 * MiB, WS_MCAT = WS_X + 110 * MiB, WS_QRAW = WS_X + 142 * MiB, WS_CKVRAW = WS_X + 190 * MiB,
                 WS_KRRAW = WS_X + 238 * MiB, WS_UH = WS_X + 244 * MiB;
constexpr size_t WS_Q = WS_X, WS_KV = WS_X + 288 * MiB;
constexpr size_t WS_OUTB = WS_X;
constexpr size_t WS_A1 = WS_X;
constexpr size_t WS_QN = 1392 * MiB, WS_CKVN = 1440 * MiB, WS_KR = 1466 * MiB, WS_YG = 1470 * MiB, WS_END = 1566 * MiB;
static_assert(WS_WIN + (size_t)NIN * 4096 * 2 <= WS_MSTATE && WS_UH + (size_t)128 * 1536 * 512 * 2 <= WS_QN && WS_KV + (size_t)NKEY * 8192 * 2 <= WS_QN, "arena");
static_assert(WS_KR + (size_t)NKEY * 64 * 2 <= WS_YG && WS_CKVN + (size_t)NKEY * 512 * 2 <= WS_KR && WS_A1 + (size_t)NROW * 16384 * 2 <= WS_END, "arena 2");
constexpr int CW_TMO = 0, CW_CODE = 1, CW_BAR = 4096;

constexpr int RING_OFF = 0, RING_BYTES = 131072;
constexpr int LDSCTL_OFF = RING_BYTES, MISC_OFF = LDSCTL_OFF + 320;
constexpr int LDS_BYTES = 147456;
static_assert(att::ATT_LDS <= RING_BYTES, "attention LDS");

#define GAS __attribute__((address_space(1)))
#define LAS __attribute__((address_space(3)))
typedef unsigned short bf16;
typedef unsigned v4u __attribute__((ext_vector_type(4)));
typedef float f32x4 __attribute__((ext_vector_type(4)));
typedef short bf16x8 __attribute__((ext_vector_type(8)));
typedef GAS unsigned gu32;
typedef GAS unsigned long long gu64;
#define RLX_AGENT __ATOMIC_RELAXED, __HIP_MEMORY_SCOPE_AGENT
#define LDS_WAIT() asm volatile("s_waitcnt lgkmcnt(0)" ::: "memory")
#define VM_WAIT() asm volatile("s_waitcnt vmcnt(0)" ::: "memory")
__device__ __forceinline__ unsigned long long rt() { return __builtin_amdgcn_s_memrealtime(); }
__device__ __forceinline__ unsigned f2bf(float f) { unsigned u = __builtin_bit_cast(unsigned, f); return (u + 0x7fffu + ((u >> 16) & 1u)) >> 16; }
__device__ __forceinline__ unsigned pk2(float lo, float hi) { return f2bf(lo) | (f2bf(hi) << 16); }

#define XB_TMO      128
#define XB_XCNT(j)  (256  + 64 * (j))
#define XB_XSUB(j)  (1280 + 64 * (j))
#define XB_XGEN(j)  (2304 + 64 * (j))
#define XB_TOP      3328
#define XB_TOPGEN   3392
#define XCD_BAR_WORDS 3456
#define XB_SPIN_CAP (1u << 18)

__device__ __forceinline__ unsigned xb_ld(unsigned* p)              { return __hip_atomic_load(p, __ATOMIC_RELAXED, __HIP_MEMORY_SCOPE_AGENT); }
__device__ __forceinline__ unsigned xb_add(unsigned* p, unsigned v) { return __hip_atomic_fetch_add(p, v, __ATOMIC_RELAXED, __HIP_MEMORY_SCOPE_AGENT); }
__device__ __forceinline__ unsigned xb_xcc_id() { return (unsigned)__builtin_amdgcn_s_getreg((3 << 11) | 20) & 0xFu; }
#define XB_SPIN(cond, bar) do { unsigned _sp = 0; while (cond) { __builtin_amdgcn_s_sleep(1); \
    if ((++_sp & 255u) == 0u) { if (xb_ld(&(bar)[XB_TMO])) break; if (_sp > XB_SPIN_CAP) { atomicAdd(&(bar)[XB_TMO], 1u); break; } } } } while (0)

struct XcdBarrier {
    unsigned* bar; unsigned x;
    volatile LAS unsigned* st;
};

__device__ __forceinline__ XcdBarrier xcd_barrier_post(unsigned* bar, volatile LAS unsigned* st) {
    XcdBarrier b; b.bar = bar; b.x = xb_xcc_id(); b.st = st;
    if (threadIdx.x == 0) (void)xb_add(&bar[XB_XCNT(b.x)], 1u);
    return b;
}
__device__ __forceinline__ void xcd_barrier_complete(unsigned* bar, unsigned x, unsigned& nloc, unsigned& nx) {
    const unsigned G = gridDim.x * gridDim.y * gridDim.z;
    unsigned sum, cnt, mine, sp = 0u;
    for (;;) {
        sum = 0u; cnt = 0u; mine = 0u;
#pragma unroll
        for (unsigned j = 0; j < 16; ++j) { const unsigned c = xb_ld(&bar[XB_XCNT(j)]); sum += c; cnt += (c > 0u) ? 1u : 0u; mine = (j == x) ? c : mine; }
        if (sum == G) break;
        __builtin_amdgcn_s_sleep(1);
        if ((++sp & 255u) == 0u) { if (xb_ld(&bar[XB_TMO])) break; if (sp > XB_SPIN_CAP) { atomicAdd(&bar[XB_TMO], 1u); break; } }
    }
    nloc = mine > 0u ? mine : 1u; nx = cnt > 0u ? cnt : 1u;
}

__device__ __forceinline__ void xcd_barrier(const XcdBarrier& b) {
    asm volatile("s_waitcnt vmcnt(0)" ::: "memory");
    __syncthreads();
    if (threadIdx.x == 0) {
        unsigned* bar = b.bar;
        __builtin_amdgcn_s_waitcnt(0);
        unsigned nloc = b.st[0], nx = b.st[1];
        if (nloc == 0u) { xcd_barrier_complete(bar, b.x, nloc, nx); b.st[0] = nloc; b.st[1] = nx; }
        const unsigned old = xb_add(&bar[XB_XSUB(b.x)], 1u);
        const unsigned gen = old / nloc;
        if (old + 1u == (gen + 1u) * nloc) {
            __builtin_amdgcn_fence(__ATOMIC_RELEASE, "agent");
            asm volatile("s_waitcnt vmcnt(0)" ::: "memory");
            const unsigned og = xb_add(&bar[XB_TOP], 1u);
            const unsigned tg = og / nx;
            if (og + 1u == (tg + 1u) * nx) xb_add(&bar[XB_TOPGEN], 1u);
            else XB_SPIN(xb_ld(&bar[XB_TOPGEN]) == tg, bar);
            __builtin_amdgcn_fence(__ATOMIC_ACQUIRE, "agent");
            xb_add(&bar[XB_XGEN(b.x)], 1u);
            asm volatile("s_waitcnt vmcnt(0)" ::: "memory");
        } else {
            XB_SPIN(xb_ld(&bar[XB_XGEN(b.x)]) == gen, bar);
            __builtin_amdgcn_fence(__ATOMIC_ACQUIRE, "agent");
            asm volatile("s_waitcnt vmcnt(0)" ::: "memory");
        }
    }
    __syncthreads();
}


typedef float f32x2 __attribute__((ext_vector_type(2)));
typedef unsigned u32x2 __attribute__((ext_vector_type(2)));
struct Frame {
    LAS unsigned char* lds;
    volatile LAS unsigned* MISC;
    gu32* ctl;
    int tid, lane, wave;
    int vcu, G;
    float* out; unsigned char* ws;
};
typedef const float* cfp_t;
typedef __attribute__((address_space(4))) const cfp_t* kargp_t;
__device__ __forceinline__ const float* inp(int k) { kargp_t p = (kargp_t)__builtin_amdgcn_kernarg_segment_ptr(); asm volatile("" : "+s"(p)); return p[k]; }
__device__ __forceinline__ float wave_sum(float v) {
#pragma unroll
    for (int o = 1; o < 64; o <<= 1) v += __shfl_xor(v, o);
    return v;
}
__device__ __forceinline__ float bf2f(unsigned short h) { return __uint_as_float((unsigned)h << 16); }
__device__ __forceinline__ float sigmf(float x) { return __builtin_amdgcn_rcpf(1.0f + __builtin_amdgcn_exp2f(-1.4426950408889634f * x)); }

__device__ __forceinline__ int mapcol(int code, int n) {
    if (code == 1) return n < 1536 ? n : (n < 11776 ? n + 64 : (n < 11840 ? n - 11776 + 1536 : -1));
    if (code == 2) { if (n < 4096) return (n >> 7) * 192 + (n & 127); const int m = n - 4096, h = m >> 6, i = m & 63; return h * 192 + 128 + (i >> 1) + 32 * (i & 1); }
    if (code == 3) { const int t = n >> 8, r = n & 255; return r < 128 ? t * 128 + r : 4096 + t * 128 + (r - 128); }
    return n;
}
__device__ __forceinline__ void transpose_item(const float* W, int K, int Nsrc, int Ndst, int code, bf16* WT, LAS float* scr, int item, int lane) {
    const int nblk = Ndst / 32, kb = item / nblk, nb = item - kb * nblk, k0 = 64 * kb, n0 = 32 * nb;
    const int sc = mapcol(code, n0 + (lane & 31));
#pragma unroll 8
    for (int i = 0; i < 32; ++i) { const int kk = 2 * i + (lane >> 5); scr[kk * 33 + (lane & 31)] = sc >= 0 ? W[(size_t)(k0 + kk) * Nsrc + sc] : 0.f; }
    LDS_WAIT(); asm volatile("" ::: "memory");
    const int c = lane & 7;
#pragma unroll
    for (int j = 0; j < 4; ++j) { const int n = (lane >> 3) + 8 * j; const LAS float* s = scr + (8 * c) * 33 + n;
        v4u o; o.x = pk2(s[0 * 33], s[1 * 33]); o.y = pk2(s[2 * 33], s[3 * 33]); o.z = pk2(s[4 * 33], s[5 * 33]); o.w = pk2(s[6 * 33], s[7 * 33]);
        *(GAS v4u*)(WT + (size_t)(n0 + n) * K + k0 + 8 * c) = o; }
    LDS_WAIT(); asm volatile("" ::: "memory");
}

__device__ __forceinline__ void adaln_unit(Frame& F, int id) {
    const int slab = id >> 5, ks = id & 31, k0 = ks * 128, col0 = slab * 1024;
    LAS float* sl = (LAS float*)(F.lds);
    LAS f32x4* red = (LAS f32x4*)(F.lds + 4096);
    for (int i = F.tid; i < 640; i += 512) { const int j = i >> 7, k = i & 127; const float v = (j == 0) ? inp(6)[k0 + k] : inp(2)[(j - 1) * 4096 + k0 + k];
        sl[i] = v / (1.0f + expf(-v)); }
    __syncthreads();
    const int c4 = F.tid & 255, kh = F.tid >> 8;
    f32x4 acc[5];
#pragma unroll
    for (int j = 0; j < 5; ++j) acc[j] = (f32x4){0.f, 0.f, 0.f, 0.f};
    const float* wp = inp(7) + (size_t)(k0 + kh * 64) * 24576 + col0 + c4 * 4;
#pragma unroll 8
    for (int kk = 0; kk < 64; ++kk) { const f32x4 w = *(const GAS f32x4*)(wp + (size_t)kk * 24576);
#pragma unroll
        for (int j = 0; j < 5; ++j) acc[j] += sl[j * 128 + kh * 64 + kk] * w; }
    if (kh == 1) {
#pragma unroll
        for (int j = 0; j < 5; ++j) red[j * 256 + c4] = acc[j]; }
    __syncthreads();
    if (kh == 0) { float* mp = (float*)(F.ws + WS_MODPART);
#pragma unroll
        for (int j = 0; j < 5; ++j) { const f32x4 v = acc[j] + red[j * 256 + c4]; *(GAS f32x4*)(mp + (size_t)(ks * 5 + j) * 24576 + col0 + c4 * 4) = v; } }
    __syncthreads();
}

__device__ __forceinline__ void s5_task(Frame& F, int g) {
    LAS f32x2* pw = (LAS f32x2*)(F.lds);
    LAS f32x2* coef = (LAS f32x2*)(F.lds + 17408);
    LAS f32x2* Bb = (LAS f32x2*)(F.lds + 18432);
    LAS f32x2* Cc = (LAS f32x2*)(F.lds + 34816);
    LAS float* Kt = (LAS float*)(F.lds + 51200);
    const int tid = F.tid;
    if (tid < 128) { const int dir = tid >> 6, p = tid & 63, idx = (dir * 128 + g) * 64 + p;
        const double lr = (double)inp(15)[idx], li = (double)inp(16)[idx], dt = exp((double)inp(17)[dir * 128 + g]);
        const double zr = lr * dt, zi = li * dt, er = exp(zr), ar = er * cos(zi), ai = er * sin(zi);
        const double nr = ar - 1.0, ni = ai, den = lr * lr + li * li;
        coef[dir * 64 + p] = (f32x2){(float)((nr * lr + ni * li) / den), (float)((ni * lr - nr * li) / den)};
        double pr = 1.0, pi = 0.0;
        for (int d = 0; d <= 16; ++d) { pw[(dir * 17 + d) * 64 + p] = (f32x2){(float)pr, (float)pi}; const double t = pr * ar - pi * ai; pi = pr * ai + pi * ar; pr = t; }
        const f32x2 a16 = pw[(dir * 17 + 16) * 64 + p];
        ((f32x2*)(F.ws + WS_PAR + 512 * 1024))[(dir * 128 + g) * 64 + p] = a16; }
    __syncthreads();
    for (int i = tid; i < 2048; i += 512) { const int dir = i >> 10, p = (i >> 4) & 63, j = i & 15; const size_t gi = ((size_t)(dir * 128 + g) * 64 + p) * 16 + j;
        const float br = inp(18)[gi], bi = inp(19)[gi]; const f32x2 cf = coef[dir * 64 + p];
        Bb[i] = (f32x2){cf.x * br - cf.y * bi, cf.x * bi + cf.y * br}; }
    for (int i = tid; i < 2048; i += 512) { const int dir = i >> 10; const size_t gi = (size_t)(dir * 128 + g) * 1024 + (i & 1023);
        Cc[i] = (f32x2){inp(20)[gi], inp(21)[gi]}; }
    __syncthreads();
    { const int dir = tid >> 8, jj = tid & 255, j = jj >> 4, jp = jj & 15; float acc[16];
#pragma unroll
        for (int d = 0; d < 16; ++d) acc[d] = 0.f;
        for (int p = 0; p < 64; ++p) { const f32x2 c = Cc[(dir * 16 + j) * 64 + p], b = Bb[(dir * 64 + p) * 16 + jp]; const float Pr = c.x * b.x - c.y * b.y, Pi = c.x * b.y + c.y * b.x;
#pragma unroll
            for (int d = 0; d < 16; ++d) { const f32x2 w = pw[(dir * 17 + d) * 64 + p]; acc[d] += Pr * w.x - Pi * w.y; } }
#pragma unroll
        for (int d = 0; d < 16; ++d) Kt[(dir * 16 + d) * 256 + jj] = acc[d]; }
    __syncthreads();
    bf16* Mcat = (bf16*)(F.ws + WS_MCAT) + (size_t)g * 256 * 512; bf16* Mst = (bf16*)(F.ws + WS_MSTATE) + (size_t)g * 256 * 256;
    for (int it = 0; it < 32; ++it) { const int idx = tid + 512 * it, n = idx >> 6, k8 = (idx & 63) * 8, tau = n >> 4, j = n & 15; float v[8];
        if (k8 < 256) { const int sg = k8 >> 4, j0 = k8 & 15;
#pragma unroll
            for (int e = 0; e < 8; ++e) { const int jp = j0 + e; float x = 0.f;
                if (sg <= tau) x += Kt[(0 * 16 + (tau - sg)) * 256 + j * 16 + jp];
                if (sg >= tau) x += Kt[(1 * 16 + (sg - tau)) * 256 + j * 16 + jp];
                if (sg == tau && j == jp) x += inp(22)[g * 16 + j];
                v[e] = x; }
        } else { const int kk = k8 - 256, dir = kk >> 7, part = (kk >> 6) & 1, p0 = kk & 63, ep = dir == 0 ? tau + 1 : 16 - tau;
#pragma unroll
            for (int e = 0; e < 8; ++e) { const f32x2 w = pw[(dir * 17 + ep) * 64 + p0 + e], c = Cc[(dir * 16 + j) * 64 + p0 + e];
                v[e] = part == 0 ? (c.x * w.x - c.y * w.y) : -(c.x * w.y + c.y * w.x); } }
        v4u o; o.x = pk2(v[0], v[1]); o.y = pk2(v[2], v[3]); o.z = pk2(v[4], v[5]); o.w = pk2(v[6], v[7]);
        *(GAS v4u*)(Mcat + (size_t)n * 512 + k8) = o; }
    for (int it = 0; it < 16; ++it) { const int idx = tid + 512 * it, n = idx >> 5, k8 = (idx & 31) * 8, dir = n >> 7, part = (n >> 6) & 1, p = n & 63, sg = k8 >> 4, j0 = k8 & 15, ep = dir == 0 ? 15 - sg : sg;
        const f32x2 w = pw[(dir * 17 + ep) * 64 + p]; float v[8];
#pragma unroll
        for (int e = 0; e < 8; ++e) { const f32x2 b = Bb[(dir * 64 + p) * 16 + j0 + e]; v[e] = part == 0 ? (w.x * b.x - w.y * b.y) : (w.x * b.y + w.y * b.x); }
        v4u o; o.x = pk2(v[0], v[1]); o.y = pk2(v[2], v[3]); o.z = pk2(v[4], v[5]); o.w = pk2(v[6], v[7]);
        *(GAS v4u*)(Mst + (size_t)n * 256 + k8) = o; }
    __syncthreads();
}

__device__ __forceinline__ void p0_prologue(Frame& F) {
    for (int id = F.vcu; id < 768; id += F.G) adaln_unit(F, id);
    for (int g = F.vcu; g < 128; g += F.G) s5_task(F, g);
    { float* tab = (float*)(F.ws + WS_TAB);
      for (int idx = F.vcu * 512 + F.tid; idx < 4096 * 32; idx += F.G * 512) { const int t = idx >> 5, p = idx & 31, pos = p < 16 ? (t >> 6) : (t & 63), f = p & 15;
        const double inv = exp(-(double)f * (9.210340371976184 / 16.0)), ang = (double)pos * inv;
        *(GAS f32x2*)(tab + (size_t)idx * 2) = (f32x2){(float)cos(ang), (float)sin(ang)}; } }
    LAS float* scr = (LAS float*)(F.lds + RING_OFF + F.wave * 16384);
    const int gw = F.vcu * NWAVES + F.wave, NGW = F.G * NWAVES;
    constexpr int I_IN = (4096 / 64) * (NIN / 32), I_UQ = (1024 / 64) * (6144 / 32), I_UKV = (512 / 64) * (8192 / 32), I_GLU = (2048 / 64) * (8192 / 32), I_OUT = (4096 / 64) * (4096 / 32);
    for (int it = gw; it < I_IN + I_UQ + I_UKV + I_GLU + I_OUT; it += NGW) {
        int r = it;
        if (r < I_IN) { transpose_item(inp(10), 4096, 11840, NIN, 1, (bf16*)(F.ws + WS_WIN), scr, r, F.lane); continue; } r -= I_IN;
        if (r < I_UQ) { transpose_item(inp(13), 1024, 6144, 6144, 2, (bf16*)(F.ws + WS_WUQ), scr, r, F.lane); continue; } r -= I_UQ;
        if (r < I_UKV) { transpose_item(inp(14), 512, 8192, 8192, 0, (bf16*)(F.ws + WS_WUKV), scr, r, F.lane); continue; } r -= I_UKV;
        if (r < I_GLU) { transpose_item(inp(23), 2048, 8192, 8192, 3, (bf16*)(F.ws + WS_WGLU), scr, r, F.lane); continue; } r -= I_GLU;
        transpose_item(inp(24), 4096, 4096, 4096, 0, (bf16*)(F.ws + WS_WOUT), scr, r, F.lane);
    }
}
__device__ __forceinline__ void p0b_modreduce(Frame& F) {
    const float* mp = (const float*)(F.ws + WS_MODPART); float* par = (float*)(F.ws + WS_PAR);
    for (int idx = F.vcu * 512 + F.tid; idx < 5 * 4096; idx += F.G * 512) { const int j = idx >> 12, k = idx & 4095; float m[6];
#pragma unroll
        for (int i = 0; i < 6; ++i) { const int n = i * 4096 + k; float s = inp(8)[n];
            for (int ks = 0; ks < 32; ++ks) s += mp[(size_t)(ks * 5 + j) * 24576 + n];
            m[i] = s; }
        par[0 * 20480 + idx] = inp(9)[k] * (1.0f + m[1]); par[1 * 20480 + idx] = m[0]; par[2 * 20480 + idx] = m[2] * inp(25)[k];
        par[3 * 20480 + idx] = inp(26)[k] * (1.0f + m[4]); par[4 * 20480 + idx] = m[3]; par[5 * 20480 + idx] = m[5] * inp(29)[k]; }
}
__device__ __forceinline__ int cond_of_row(int m) { return m < NPR ? 0 : 1 + ((m - NPR) >> 12); }
__device__ __forceinline__ const float* xrow_of(const Frame& F, int m) { return m < NPR ? inp(0) + (size_t)m * DM : inp(1) + (size_t)(m - NPR) * DM; }
__device__ __forceinline__ void p1_modnorm(Frame& F) {
    const int gw = F.vcu * NWAVES + F.wave, NGW = F.G * NWAVES; const float* par = (const float*)(F.ws + WS_PAR); bf16* H = (bf16*)(F.ws + WS_A);
    for (int m = gw; m < NROW; m += NGW) { const int cd = cond_of_row(m); const GAS f32x4* xr = (const GAS f32x4*)xrow_of(F, m) + F.lane;
        const GAS f32x4* A = (const GAS f32x4*)(par + 0 * 20480 + cd * 4096) + F.lane; const GAS f32x4* B = (const GAS f32x4*)(par + 1 * 20480 + cd * 4096) + F.lane;
        f32x4 v[16]; float s = 0.f;
#pragma unroll
        for (int j = 0; j < 16; ++j) { v[j] = xr[64 * j]; s += (v[j].x * v[j].x + v[j].y * v[j].y) + (v[j].z * v[j].z + v[j].w * v[j].w); }
        const float rinv = 1.0f / sqrtf(wave_sum(s) * (1.0f / DM) + EPSN);
        GAS u32x2* o8 = (GAS u32x2*)(H + (size_t)m * DM) + F.lane;
#pragma unroll
        for (int j = 0; j < 16; ++j) { const f32x4 a = A[64 * j], b = B[64 * j]; const f32x4 y = v[j] * rinv * a + b; o8[64 * j] = (u32x2){pk2(y.x, y.y), pk2(y.z, y.w)}; } }
}
__device__ __forceinline__ void p3_rowpass(Frame& F) {
    const int gw = F.vcu * NWAVES + F.wave, NGW = F.G * NWAVES, lane = F.lane;
    const bf16* qraw = (const bf16*)(F.ws + WS_QRAW); const float* ckvraw = (const float*)(F.ws + WS_CKVRAW); const float* krraw = (const float*)(F.ws + WS_KRRAW);
    const float* qstat = (const float*)(F.ws + WS_QSTAT); const float* kvstat = (const float*)(F.ws + WS_KVSTAT); const float* tab = (const float*)(F.ws + WS_TAB);
    bf16* qn = (bf16*)(F.ws + WS_QN); bf16* ckvn = (bf16*)(F.ws + WS_CKVN); bf16* Kr = (bf16*)(F.ws + WS_KR);
    for (int m = gw; m < NROW + 2048; m += NGW) {
        if (m < NROW) {
            const int keyrow = m < NPR ? m : NPR + ((m - NPR) >> 12) * 4608 + 512 + ((m - NPR) & 4095);
            const float qs = wave_sum(lane < 16 ? qstat[m * 16 + lane] : 0.f), ks = wave_sum(lane < 8 ? kvstat[m * 8 + lane] : 0.f);
            const float rq = 1.0f / sqrtf(qs * (1.0f / 1024.f) + EPSN), rk = 1.0f / sqrtf(ks * (1.0f / 512.f) + EPSN);
#pragma unroll
            for (int hh = 0; hh < 2; ++hh) { const int k0 = hh * 512 + lane * 8; const v4u w = *(const GAS v4u*)(qraw + (size_t)m * 1024 + k0);
                const f32x4 g0 = *(const GAS f32x4*)(inp(11) + k0), g1 = *(const GAS f32x4*)(inp(11) + k0 + 4); v4u o;
                o.x = pk2(__uint_as_float(w.x << 16) * rq * g0.x, __uint_as_float(w.x & 0xffff0000u) * rq * g0.y); o.y = pk2(__uint_as_float(w.y << 16) * rq * g0.z, __uint_as_float(w.y & 0xffff0000u) * rq * g0.w);
                o.z = pk2(__uint_as_float(w.z << 16) * rq * g1.x, __uint_as_float(w.z & 0xffff0000u) * rq * g1.y); o.w = pk2(__uint_as_float(w.w << 16) * rq * g1.z, __uint_as_float(w.w & 0xffff0000u) * rq * g1.w);
                *(GAS v4u*)(qn + (size_t)m * 1024 + k0) = o; }
            { const int k0 = lane * 8; const f32x4 a = *(const GAS f32x4*)(ckvraw + (size_t)m * 512 + k0), b = *(const GAS f32x4*)(ckvraw + (size_t)m * 512 + k0 + 4);
              const f32x4 g0 = *(const GAS f32x4*)(inp(12) + k0), g1 = *(const GAS f32x4*)(inp(12) + k0 + 4); const f32x4 ya = a * rk * g0, yb = b * rk * g1;
              v4u o; o.x = pk2(ya.x, ya.y); o.y = pk2(ya.z, ya.w); o.z = pk2(yb.x, yb.y); o.w = pk2(yb.z, yb.w);
              *(GAS v4u*)(ckvn + (size_t)keyrow * 512 + k0) = o;
              if (m < NPR) { float* oc = F.out + O_CKV + (size_t)m * 512 + k0; *(GAS f32x4*)oc = ya; *(GAS f32x4*)(oc + 4) = yb; } }
            if (lane < 32) { float lo = krraw[(size_t)m * 64 + lane], hi = krraw[(size_t)m * 64 + lane + 32];
                if (m < NPR) { F.out[O_KR + (size_t)m * 64 + lane] = lo; F.out[O_KR + (size_t)m * 64 + lane + 32] = hi; }
                else { const int t = (m - NPR) & 4095; const f32x2 cs = *(const GAS f32x2*)(tab + ((size_t)t * 32 + lane) * 2); const float l2 = lo * cs.x - hi * cs.y, h2 = hi * cs.x + lo * cs.y; lo = l2; hi = h2; }
                *(GAS unsigned*)(Kr + (size_t)keyrow * 64 + 2 * lane) = pk2(lo, hi); }
        } else {
            const int idx = m - NROW, b = idx >> 9, s = idx & 511, keyrow = NPR + b * 4608 + s, k0 = lane * 8;
            const f32x4 a = *(const GAS f32x4*)(inp(3) + (size_t)idx * 512 + k0), bb = *(const GAS f32x4*)(inp(3) + (size_t)idx * 512 + k0 + 4);
            v4u o; o.x = pk2(a.x, a.y); o.y = pk2(a.z, a.w); o.z = pk2(bb.x, bb.y); o.w = pk2(bb.z, bb.w);
            *(GAS v4u*)(ckvn + (size_t)keyrow * 512 + k0) = o;
            if (lane < 32) *(GAS unsigned*)(Kr + (size_t)keyrow * 64 + 2 * lane) = pk2(inp(4)[(size_t)idx * 64 + lane], inp(4)[(size_t)idx * 64 + lane + 32]);
        }
    }
}
__device__ __forceinline__ void scan_task(Frame& F, int seq, int g, int dir) {
    const int lane = F.lane; const bool prompt = seq < 32; const int nc = prompt ? 16 : 256, cbase = prompt ? seq * 16 : 512 + (seq - 32) * 256;
    const f32x2 aT = ((const f32x2*)(F.ws + WS_PAR + 512 * 1024))[(dir * 128 + g) * 64 + lane];
    float hr = 0.f, hi = 0.f;
    if (!prompt) { const size_t si = ((size_t)((seq - 32) * 2 + dir) * 2) * 8192 + g * 64 + lane; hr = inp(5)[si]; hi = inp(5)[si + 8192]; }
    const float* S = (const float*)(F.ws + WS_A) + ((size_t)g * NCHUNK + cbase) * 256 + dir * 128 + lane;
    bf16* Hb = (bf16*)(F.ws + WS_UH) + ((size_t)g * NCHUNK + cbase) * 512 + 256 + dir * 128 + lane;
    for (int c0 = 0; c0 < nc; c0 += 8) { float sr[8], si[8];
#pragma unroll
        for (int e = 0; e < 8; ++e) { const int c = dir == 0 ? c0 + e : nc - 1 - (c0 + e); sr[e] = S[(size_t)c * 256]; si[e] = S[(size_t)c * 256 + 64]; }
#pragma unroll
        for (int e = 0; e < 8; ++e) { const int c = dir == 0 ? c0 + e : nc - 1 - (c0 + e);
            Hb[(size_t)c * 512] = (bf16)f2bf(hr); Hb[(size_t)c * 512 + 64] = (bf16)f2bf(hi);
            const float nr = aT.x * hr - aT.y * hi + sr[e], ni = aT.x * hi + aT.y * hr + si[e]; hr = nr; hi = ni; } }
    if (prompt) { float* o = F.out + O_S5 + ((size_t)(seq * 2 + dir) * 2) * 8192 + g * 64 + lane; o[0] = hr; o[8192] = hi; }
}
__device__ __forceinline__ void p4b_scan(Frame& F) {
    const int gw = F.vcu * NWAVES + F.wave, NGW = F.G * NWAVES;
    for (int t = gw; t < 2048; t += NGW) {
        if (t < 1024) scan_task(F, 32 + (t >> 8), (t >> 1) & 127, t & 1);
        else { const int base = (t - 1024) * 8; for (int e = 0; e < 8; ++e) { const int q = base + e; scan_task(F, q >> 8, (q >> 1) & 127, q & 1); } }
    }
}
__device__ __forceinline__ void p9_rowpass(Frame& F) {
    const int gw = F.vcu * NWAVES + F.wave, NGW = F.G * NWAVES, lane = F.lane; const float* par = (const float*)(F.ws + WS_PAR);
    const bf16* ob = (const bf16*)(F.ws + WS_OUTB); const float* ostat = (const float*)(F.ws + WS_OSTAT); bf16* H2 = (bf16*)(F.ws + WS_A);
    for (int m = gw; m < NROW; m += NGW) { const int cd = cond_of_row(m); const GAS f32x4* xr = (const GAS f32x4*)xrow_of(F, m) + lane;
        const float r1 = 1.0f / sqrtf(wave_sum(ostat[(size_t)m * 64 + lane]) * (1.0f / DM) + EPSN);
        const GAS f32x4* P2 = (const GAS f32x4*)(par + 2 * 20480 + cd * 4096) + lane; const GAS u32x2* o2 = (const GAS u32x2*)(ob + (size_t)m * DM) + lane;
        GAS f32x4* yo = (GAS f32x4*)(F.out + O_Y + (size_t)m * DM) + lane;
        f32x4 v[16]; float s = 0.f;
#pragma unroll
        for (int j = 0; j < 16; ++j) { const u32x2 w = o2[64 * j]; const f32x4 o = (f32x4){__uint_as_float(w.x << 16), __uint_as_float(w.x & 0xffff0000u), __uint_as_float(w.y << 16), __uint_as_float(w.y & 0xffff0000u)};
            v[j] = xr[64 * j] + P2[64 * j] * o * r1; yo[64 * j] = v[j]; s += (v[j].x * v[j].x + v[j].y * v[j].y) + (v[j].z * v[j].z + v[j].w * v[j].w); }
        const float r2 = 1.0f / sqrtf(wave_sum(s) * (1.0f / DM) + EPSN);
        const GAS f32x4* A = (const GAS f32x4*)(par + 3 * 20480 + cd * 4096) + lane; const GAS f32x4* B = (const GAS f32x4*)(par + 4 * 20480 + cd * 4096) + lane;
        GAS u32x2* o8 = (GAS u32x2*)(H2 + (size_t)m * DM) + lane;
#pragma unroll
        for (int j = 0; j < 16; ++j) { const f32x4 y = v[j] * r2 * A[64 * j] + B[64 * j]; o8[64 * j] = (u32x2){pk2(y.x, y.y), pk2(y.z, y.w)}; } }
    LAS float* scr = (LAS float*)(F.lds + RING_OFF + F.wave * 16384);
    constexpr int I_F1 = (4096 / 64) * (16384 / 32), I_F2 = (16384 / 64) * (4096 / 32);
    for (int it = gw; it < I_F1 + I_F2; it += NGW) {
        if (it < I_F1) transpose_item(inp(27), 4096, 16384, 16384, 0, (bf16*)(F.ws + WS_WFF1), scr, it, lane);
        else transpose_item(inp(28), 16384, 4096, 4096, 0, (bf16*)(F.ws + WS_WFF2), scr, it - I_F1, lane);
    }
}
__device__ __forceinline__ void p12_rowpass(Frame& F) {
    const int gw = F.vcu * NWAVES + F.wave, NGW = F.G * NWAVES, lane = F.lane; const float* par = (const float*)(F.ws + WS_PAR);
    const bf16* ab = (const bf16*)(F.ws + WS_A); const float* ostat = (const float*)(F.ws + WS_OSTAT);
    for (int m = gw; m < NROW; m += NGW) { const int cd = cond_of_row(m);
        const float r1 = 1.0f / sqrtf(wave_sum(ostat[(size_t)m * 64 + lane]) * (1.0f / DM) + EPSN);
        const GAS f32x4* P5 = (const GAS f32x4*)(par + 5 * 20480 + cd * 4096) + lane; const GAS u32x2* o2 = (const GAS u32x2*)(ab + (size_t)m * DM) + lane;
        GAS f32x4* yo = (GAS f32x4*)(F.out + O_Y + (size_t)m * DM) + lane;
#pragma unroll
        for (int j = 0; j < 16; ++j) { const u32x2 w = o2[64 * j]; const f32x4 o = (f32x4){__uint_as_float(w.x << 16), __uint_as_float(w.x & 0xffff0000u), __uint_as_float(w.y << 16), __uint_as_float(w.y & 0xffff0000u)};
            yo[64 * j] = yo[64 * j] + P5[64 * j] * o * r1; } }
}

struct Args { const float* in[30]; float* out; unsigned char* ws; };
__global__ void __launch_bounds__(NWAVES * 64, 2) mk_fwd(Args args) {
    extern __shared__ __attribute__((aligned(16))) unsigned char lds[];
    Frame F;
    F.lds = (LAS unsigned char*)lds;
    F.MISC = (volatile LAS unsigned*)(F.lds + MISC_OFF);
    F.tid = threadIdx.x; F.lane = F.tid & 63; F.wave = __builtin_amdgcn_readfirstlane(F.tid >> 6);
    F.G = gridDim.x; { const int bx = blockIdx.x; F.vcu = (F.G % 8 == 0) ? (bx % 8) * (F.G / 8) + bx / 8 : bx; }
    F.out = args.out; F.ws = args.ws;
    unsigned char* ws = args.ws;
    F.ctl = (gu32*)(ws + WS_CTL);
    for (int u = F.tid; u < (LDS_BYTES - LDSCTL_OFF) / 4; u += NWAVES * 64) ((LAS unsigned*)(F.lds + LDSCTL_OFF))[u] = 0u;
    __syncthreads();
    XcdBarrier bar = xcd_barrier_post((unsigned*)(F.ctl + CW_BAR), F.MISC + 8);
#define REFRESH() do { int t_ = threadIdx.x; asm volatile("" : "+v"(t_)); F.tid = t_; F.lane = t_ & 63; } while (0)
#define GRID_BAR() do { xcd_barrier(bar); REFRESH(); } while (0)
    typedef pg8::bf16_t bt;
    const int bx = (int)blockIdx.x;

    p0_prologue(F); GRID_BAR();
    p0b_modreduce(F); GRID_BAR();
    p1_modnorm(F); GRID_BAR();
    { pg8::Gemm g{(const bt*)(ws + WS_A), (const bt*)(ws + WS_WIN), 4096, 4096, 4096}; pg8::StaticOrder S; S.init(NROW, NIN, F.G, bx);
      pg8::EpiIn E{(bt*)(ws + WS_QRAW), (float*)(ws + WS_CKVRAW), (float*)(ws + WS_KRRAW), (bt*)(ws + WS_UH), (bt*)(ws + WS_GA), (bt*)(ws + WS_GB), (float*)(ws + WS_QSTAT), (float*)(ws + WS_KVSTAT)};
      pg8::gemm_phase<pg8::EpiIn, pg8::StaticOrder, true, true>(F.lds + RING_OFF, g, S, E); }
    GRID_BAR();
    p3_rowpass(F); GRID_BAR();
    { pg8::Gemm g{(const bt*)(ws + WS_UH), (const bt*)(ws + WS_MSTATE), 512, 256, 256}; pg8::GroupOrder S{768, 6, F.G, bx};
      pg8::EpiS E{(float*)(ws + WS_A)};
      pg8::gemm_phase<pg8::EpiS, pg8::GroupOrder, true, true>(F.lds + RING_OFF, g, S, E); }
    GRID_BAR();
    p4b_scan(F); GRID_BAR();
    { pg8::Gemm g{(const bt*)(ws + WS_UH), (const bt*)(ws + WS_MCAT), 512, 512, 512}; pg8::GroupOrder S{768, 6, F.G, bx};
      pg8::EpiY E{(bt*)(ws + WS_YG)};
      pg8::gemm_phase<pg8::EpiY, pg8::GroupOrder, true, true>(F.lds + RING_OFF, g, S, E); }
    GRID_BAR();
    { pg8::Gemm g{(const bt*)(ws + WS_QN), (const bt*)(ws + WS_WUQ), 1024, 1024, 1024}; pg8::StaticOrder S; S.init(NROW, 6144, F.G, bx);
      pg8::EpiQ E{(bt*)(ws + WS_Q), (const float*)(ws + WS_TAB), QSCALE};
      pg8::gemm_phase<pg8::EpiQ, pg8::StaticOrder, true, true>(F.lds + RING_OFF, g, S, E); }
    { pg8::Gemm g{(const bt*)(ws + WS_CKVN), (const bt*)(ws + WS_WUKV), 512, 512, 512}; pg8::StaticOrder S; S.init(NKEY, 8192, F.G, bx);
      pg8::EpiBf E{(bt*)(ws + WS_KV), 8192};
      pg8::gemm_phase<pg8::EpiBf, pg8::StaticOrder, true, true>(F.lds + RING_OFF, g, S, E); }
    GRID_BAR();
    { const att::bf16* Q = (const att::bf16*)(ws + WS_Q); const att::bf16* KV = (const att::bf16*)(ws + WS_KV); const att::bf16* KR = (const att::bf16*)(ws + WS_KR);
      const att::bf16* GA = (const att::bf16*)(ws + WS_GA); att::bf16* MO = (att::bf16*)(ws + WS_A);
      for (int u = F.vcu; u < 3072; u += F.G) {
          int h, qrow0, krow0, seq;
          if (u < 2048) { const int bh = u >> 4, qb = u & 15, b = bh >> 5; h = bh & 31; qrow0 = NPR + b * 4096 + qb * 256; krow0 = NPR + b * 4608; seq = 4608; }
          else { const int v = u - 2048, b = v >> 5; h = v & 31; qrow0 = b * 256; krow0 = b * 256; seq = 256; }
          att::attn_unit(Q + (size_t)qrow0 * 6144 + h * 128, Q + (size_t)qrow0 * 6144 + 4096 + h * 64, KV + (size_t)krow0 * 8192 + h * 256, KV + (size_t)krow0 * 8192 + h * 256 + 128,
                         KR + (size_t)krow0 * 64, GA + (size_t)qrow0 * 4096 + h * 128, MO + (size_t)qrow0 * 4096 + h * 128, seq, (char*)lds + RING_OFF);
      } }
    GRID_BAR();
    { pg8::Gemm g{(const bt*)(ws + WS_YG), (const bt*)(ws + WS_WGLU), 2048, 2048, 2048}; pg8::StaticOrder S; S.init(NROW, 8192, F.G, bx);
      pg8::EpiGlu E{(bt*)(ws + WS_A), (const bt*)(ws + WS_GB)};
      pg8::gemm_phase<pg8::EpiGlu, pg8::StaticOrder, true, true>(F.lds + RING_OFF, g, S, E); }
    GRID_BAR();
    { pg8::Gemm g{(const bt*)(ws + WS_A), (const bt*)(ws + WS_WOUT), 4096, 4096, 4096}; pg8::StaticOrder S; S.init(NROW, 4096, F.G, bx);
      pg8::EpiStat E{(bt*)(ws + WS_OUTB), (float*)(ws + WS_OSTAT)};
      pg8::gemm_phase<pg8::EpiStat, pg8::StaticOrder, true, true>(F.lds + RING_OFF, g, S, E); }
    GRID_BAR();
    p9_rowpass(F); GRID_BAR();
    { pg8::Gemm g{(const bt*)(ws + WS_A), (const bt*)(ws + WS_WFF1), 4096, 4096, 4096}; pg8::StaticOrder S; S.init(NROW, 16384, F.G, bx);
      pg8::EpiRelu2 E{(bt*)(ws + WS_A1)};
      pg8::gemm_phase<pg8::EpiRelu2, pg8::StaticOrder, true, true>(F.lds + RING_OFF, g, S, E); }
    GRID_BAR();
    { pg8::Gemm g{(const bt*)(ws + WS_A1), (const bt*)(ws + WS_WFF2), 16384, 16384, 16384}; pg8::StaticOrder S; S.init(NROW, 4096, F.G, bx);
      pg8::EpiStat E{(bt*)(ws + WS_A), (float*)(ws + WS_OSTAT)};
      pg8::gemm_phase<pg8::EpiStat, pg8::StaticOrder, true, true>(F.lds + RING_OFF, g, S, E); }
    GRID_BAR();
    p12_rowpass(F);
#undef GRID_BAR
#undef REFRESH
}

extern "C" void kernel_launch(void* const* d_in, const int* in_sizes, int n_in, void* d_out, int out_size, void* d_ws, size_t ws_size, hipStream_t stream) {
    static int grid = 0;
    if (grid == 0) {
        if (n_in != 30 || in_sizes[0] != NPR * DM || out_size != (int)O_END || ws_size < WS_END) { fprintf(stderr, "kernel_launch: shape mismatch (n_in %d, in0 %d, out %d, ws %zu; need ws >= %zu); nothing launched\n", n_in, n_in > 0 ? in_sizes[0] : -1, out_size, ws_size, (size_t)WS_END); grid = -1; return; }
        int dev = 0, cus = 0, per_cu = 0;
        if (hipGetDevice(&dev) != hipSuccess || hipDeviceGetAttribute(&cus, hipDeviceAttributeMultiprocessorCount, dev) != hipSuccess) { grid = -1; return; }
        if (hipFuncSetAttribute((const void*)mk_fwd, hipFuncAttributeMaxDynamicSharedMemorySize, LDS_BYTES) != hipSuccess) { fprintf(stderr, "kernel_launch: hipFuncSetAttribute failed\n"); grid = -1; return; }
        if (hipOccupancyMaxActiveBlocksPerMultiprocessor(&per_cu, (const void*)mk_fwd, NWAVES * 64, LDS_BYTES) != hipSuccess || per_cu < 1) { fprintf(stderr, "kernel_launch: occupancy query reports %d workgroups per CU\n", per_cu); }
        (void)hipGetLastError();
        grid = cus;
    }
    if (grid < 0) return;
    if (hipMemsetAsync((char*)d_ws + WS_CTL, 0, CTL_ZERO_BYTES, stream) != hipSuccess) return;
    Args a{};
    for (int i = 0; i < 30; ++i) a.in[i] = (const float*)d_in[i];
    a.out = (float*)d_out; a.ws = (unsigned char*)d_ws;
    hipLaunchKernelGGL(mk_fwd, dim3(grid), dim3(NWAVES * 64), LDS_BYTES, stream, a);
    const hipError_t le = hipPeekAtLastError();
    if (le != hipSuccess) fprintf(stderr, "kernel_launch: launch failed: %s\n", hipGetErrorName(le));
}
```

```cpp
#include <hip/hip_runtime.h>
#include <cstdio>
#include <cstdint>
namespace pg8 {
#define PG8_LAS __attribute__((address_space(3)))
typedef unsigned short bf16_t;
typedef short bf16x8 __attribute__((ext_vector_type(8)));
typedef float f32x4 __attribute__((ext_vector_type(4)));
typedef unsigned u32x4 __attribute__((ext_vector_type(4)));
constexpr int BM = 256, BK = 64, HALF = 128, HTB = HALF * BK * 2  , STAGE_BYTES = 8 * HTB, NXCD = 8, WGM = 4;

__host__ __device__ __forceinline__ int lds_byte(int r, int c) { const int st = (r >> 4) * 2 + (c >> 5), rr = r & 15, cc = c & 31, ob = rr * 64 + cc * 2; return st * 1024 + (ob ^ (((ob >> 9) & 1) << 5)); }
__host__ __device__ __forceinline__ void stage_rc(int b, int& R, int& C) { const int st = b / 1024, sb = b % 1024, swz = sb ^ (((sb >> 9) & 1) << 5); R = (st >> 1) * 16 + swz / 64; C = (st & 1) * 32 + (swz % 64) / 2; }
__host__ __device__ __forceinline__ int perm32(int rho) { const int n = rho >> 4, i = rho & 15; return 8 * (i >> 2) + 4 * n + (i & 3); }

struct Unit { int pm, pn; };
struct Gemm { const bf16_t* A; const bf16_t* Bt; int lda, ldb, K; };

struct StaticOrder {
    int nM, nN, nwg, G, c;
    __host__ __device__ void init(int M, int N, int G_, int c_) { nM = M / BM; nN = N / BM; nwg = nM * nN; G = G_; c = c_; }
    __host__ __device__ bool next(int i, Unit& u) const {
        const long L = (long)i * G + c; if (L >= nwg) return false;
        int wgid = (int)L; { const int q = nwg / NXCD, r = nwg % NXCD, xcd = wgid % NXCD, off = wgid / NXCD; wgid = (xcd < r ? xcd * (q + 1) : r * (q + 1) + (xcd - r) * q) + off; }
        const int nig = WGM * nN, gid = wgid / nig, fm = gid * WGM, gsz = (nM - fm) < WGM ? (nM - fm) : WGM;
        u.pm = fm + ((wgid % nig) % gsz); u.pn = (wgid % nig) / gsz; return true;
    }
    __device__ __forceinline__ void a_ready(const Unit&) const {}
    __device__ __forceinline__ void done(const Unit&) const {}
};
struct GroupOrder {
    int nunits, per, G, c;
    __device__ bool next(int i, Unit& u) const { const int L = i * G + c; if (L >= nunits) return false; u.pm = L; u.pn = L / per; return true; }
    __device__ __forceinline__ void a_ready(const Unit&) const {}
    __device__ __forceinline__ void done(const Unit&) const {}
};

__device__ __forceinline__ unsigned cvt_pk_bf16(float lo, float hi) { unsigned r; asm volatile("v_cvt_pk_bf16_f32 %0, %1, %2" : "=v"(r) : "v"(lo), "v"(hi)); return r; }
__device__ __forceinline__ u32x4 pack8(const f32x4 a, const f32x4 b) { u32x4 w; w.x = cvt_pk_bf16(a[0], a[1]); w.y = cvt_pk_bf16(a[2], a[3]); w.z = cvt_pk_bf16(b[0], b[1]); w.w = cvt_pk_bf16(b[2], b[3]); return w; }
__device__ __forceinline__ float bflo(unsigned w) { return __uint_as_float(w << 16); }
__device__ __forceinline__ float bfhi(unsigned w) { return __uint_as_float(w & 0xffff0000u); }
__device__ __forceinline__ float sigm(float x) { return __builtin_amdgcn_rcpf(1.0f + __builtin_amdgcn_exp2f(-1.4426950408889634f * x)); }
__device__ __forceinline__ float gelu_tanh(float y) { return y * sigm(1.5957691216057308f * (y + 0.044715f * y * y * y)); }
__device__ __forceinline__ float sumsq8(const f32x4 a, const f32x4 b) { return (a[0] * a[0] + a[1] * a[1]) + (a[2] * a[2] + a[3] * a[3]) + (b[0] * b[0] + b[1] * b[1]) + (b[2] * b[2] + b[3] * b[3]); }

struct EpiIn {
    static constexpr bool PERM = true, AFTER_DRAIN = false;
    bf16_t* qraw; float* ckvraw; float* krraw; bf16_t* UH; bf16_t* ga; bf16_t* gb; float* qstat; float* kvstat;
    __device__ __forceinline__ void operator()(const f32x4 (&acc)[2][2][4][2], const Unit& u, int wr, int wc, int fr, int fq) const {
        asm volatile("" : "+v"(fr), "+v"(fq));
        const int row0 = u.pm * BM + wr * 64 + fr, colL = wc * 32 + 8 * fq, pn = u.pn;
        if (pn < 4) {
#pragma unroll
            for (int ai = 0; ai < 2; ++ai)
#pragma unroll
                for (int m = 0; m < 4; ++m) { const int row = row0 + ai * HALF + m * 16; float ss = 0.f;
#pragma unroll
                    for (int bj = 0; bj < 2; ++bj) { const f32x4 a = acc[ai][bj][m][0], b = acc[ai][bj][m][1]; ss += sumsq8(a, b);
                        *(u32x4*)(qraw + (size_t)row * 1024 + pn * 256 + bj * HALF + colL) = pack8(a, b); }
                    ss += __shfl_xor(ss, 16); ss += __shfl_xor(ss, 32);
                    if (fq == 0) qstat[row * 16 + pn * 4 + wc] = ss; }
        } else if (pn < 6) {
            const int t = pn - 4;
#pragma unroll
            for (int ai = 0; ai < 2; ++ai)
#pragma unroll
                for (int m = 0; m < 4; ++m) { const int row = row0 + ai * HALF + m * 16; float ss = 0.f;
#pragma unroll
                    for (int bj = 0; bj < 2; ++bj) { const f32x4 a = acc[ai][bj][m][0], b = acc[ai][bj][m][1]; ss += sumsq8(a, b);
                        float* p = ckvraw + (size_t)row * 512 + t * 256 + bj * HALF + colL; *(f32x4*)p = a; *(f32x4*)(p + 4) = b; }
                    ss += __shfl_xor(ss, 16); ss += __shfl_xor(ss, 32);
                    if (fq == 0) kvstat[row * 8 + t * 4 + wc] = ss; }
        } else if (pn < 14) {
            const int t = pn - 6;
#pragma unroll
            for (int ai = 0; ai < 2; ++ai)
#pragma unroll
                for (int m = 0; m < 4; ++m) { const int row = row0 + ai * HALF + m * 16;
#pragma unroll
                    for (int bj = 0; bj < 2; ++bj) { const int col = t * 256 + bj * HALF + colL, g = col >> 4, j0 = col & 15;
                        *(u32x4*)(UH + ((size_t)g * 1536 + (row >> 4)) * 512 + (row & 15) * 16 + j0) = pack8(acc[ai][bj][m][0], acc[ai][bj][m][1]); } }
        } else if (pn < 46) {
            bf16_t* dst = pn < 30 ? ga + (pn - 14) * 256 : gb + (pn - 30) * 256;
#pragma unroll
            for (int ai = 0; ai < 2; ++ai)
#pragma unroll
                for (int m = 0; m < 4; ++m) { const int row = row0 + ai * HALF + m * 16;
#pragma unroll
                    for (int bj = 0; bj < 2; ++bj) *(u32x4*)(dst + (size_t)row * 4096 + bj * HALF + colL) = pack8(acc[ai][bj][m][0], acc[ai][bj][m][1]); }
        } else {
            if (wc < 2) {
#pragma unroll
                for (int ai = 0; ai < 2; ++ai)
#pragma unroll
                    for (int m = 0; m < 4; ++m) { const int row = row0 + ai * HALF + m * 16; float* p = krraw + (size_t)row * 64 + colL;
                        *(f32x4*)p = acc[ai][0][m][0]; *(f32x4*)(p + 4) = acc[ai][0][m][1]; }
            }
        }
    }
};
struct EpiBf {
    static constexpr bool PERM = true, AFTER_DRAIN = false;
    bf16_t* O; int ldc;
    __device__ __forceinline__ void operator()(const f32x4 (&acc)[2][2][4][2], const Unit& u, int wr, int wc, int fr, int fq) const {
        asm volatile("" : "+v"(fr), "+v"(fq));
        const int row0 = u.pm * BM + wr * 64 + fr, col0 = u.pn * BM + wc * 32 + 8 * fq;
#pragma unroll
        for (int ai = 0; ai < 2; ++ai)
#pragma unroll
            for (int m = 0; m < 4; ++m) { bf16_t* rowp = O + (size_t)(row0 + ai * HALF + m * 16) * ldc + col0;
#pragma unroll
                for (int bj = 0; bj < 2; ++bj) *(u32x4*)(rowp + bj * HALF) = pack8(acc[ai][bj][m][0], acc[ai][bj][m][1]); }
    }
};
struct EpiQ {
    static constexpr bool PERM = true, AFTER_DRAIN = false;
    bf16_t* Q; const float* tab; float c2;
    __device__ __forceinline__ void operator()(const f32x4 (&acc)[2][2][4][2], const Unit& u, int wr, int wc, int fr, int fq) const {
        asm volatile("" : "+v"(fr), "+v"(fq));
        const int row0 = u.pm * BM + wr * 64 + fr, col0 = u.pn * BM + wc * 32 + 8 * fq;
        const bool rope = (u.pn >= 16) && (u.pm >= 32);
#pragma unroll
        for (int ai = 0; ai < 2; ++ai)
#pragma unroll
            for (int m = 0; m < 4; ++m) { const int row = row0 + ai * HALF + m * 16; bf16_t* rowp = Q + (size_t)row * 6144 + col0;
#pragma unroll
                for (int bj = 0; bj < 2; ++bj) { f32x4 a = acc[ai][bj][m][0], b = acc[ai][bj][m][1];
                    if (rope) { const int t = (row - 8192) & 4095, p0 = ((col0 + bj * HALF - 4096) & 63) >> 1;
                        const f32x4 cs0 = *(const f32x4*)(tab + ((size_t)t * 32 + p0) * 2), cs1 = *(const f32x4*)(tab + ((size_t)t * 32 + p0 + 2) * 2);
                        f32x4 ra, rb;
                        ra[0] = a[0] * cs0[0] - a[1] * cs0[1]; ra[1] = a[1] * cs0[0] + a[0] * cs0[1]; ra[2] = a[2] * cs0[2] - a[3] * cs0[3]; ra[3] = a[3] * cs0[2] + a[2] * cs0[3];
                        rb[0] = b[0] * cs1[0] - b[1] * cs1[1]; rb[1] = b[1] * cs1[0] + b[0] * cs1[1]; rb[2] = b[2] * cs1[2] - b[3] * cs1[3]; rb[3] = b[3] * cs1[2] + b[2] * cs1[3];
                        a = ra; b = rb; }
                    *(u32x4*)(rowp + bj * HALF) = pack8(a * c2, b * c2); } }
    }
};
struct EpiS {
    static constexpr bool PERM = false, AFTER_DRAIN = false;
    float* S;
    __device__ __forceinline__ void operator()(const f32x4 (&acc)[2][2][4][2], const Unit& u, int wr, int wc, int fr, int fq) const {
        asm volatile("" : "+v"(fr), "+v"(fq));
        const int row0 = u.pm * BM + wr * 64 + fr, col0 = wc * 32 + 4 * fq;
#pragma unroll
        for (int ai = 0; ai < 2; ++ai)
#pragma unroll
            for (int m = 0; m < 4; ++m) { float* rowp = S + (size_t)(row0 + ai * HALF + m * 16) * 256 + col0;
#pragma unroll
                for (int bj = 0; bj < 2; ++bj)
#pragma unroll
                    for (int n = 0; n < 2; ++n) *(f32x4*)(rowp + bj * HALF + n * 16) = acc[ai][bj][m][n]; }
    }
};
struct EpiY {
    static constexpr bool PERM = true, AFTER_DRAIN = false;
    bf16_t* Yg;
    __device__ __forceinline__ void operator()(const f32x4 (&acc)[2][2][4][2], const Unit& u, int wr, int wc, int fr, int fq) const {
        asm volatile("" : "+v"(fr), "+v"(fq));
        const int g = u.pn, c0 = (u.pm - 6 * g) * BM + wr * 64 + fr, n0 = wc * 32 + 8 * fq;
#pragma unroll
        for (int ai = 0; ai < 2; ++ai)
#pragma unroll
            for (int m = 0; m < 4; ++m) { const int c = c0 + ai * HALF + m * 16;
#pragma unroll
                for (int bj = 0; bj < 2; ++bj) { const int nn = bj * HALF + n0, tau = nn >> 4, j0 = nn & 15; f32x4 a = acc[ai][bj][m][0], b = acc[ai][bj][m][1];
#pragma unroll
                    for (int e = 0; e < 4; ++e) { a[e] = gelu_tanh(a[e]); b[e] = gelu_tanh(b[e]); }
                    *(u32x4*)(Yg + (size_t)(c * 16 + tau) * 2048 + g * 16 + j0) = pack8(a, b); } }
    }
};
struct EpiGlu {
    static constexpr bool PERM = true, AFTER_DRAIN = false;
    bf16_t* M; const bf16_t* gb;
    __device__ __forceinline__ void operator()(const f32x4 (&acc)[2][2][4][2], const Unit& u, int wr, int wc, int fr, int fq) const {
        asm volatile("" : "+v"(fr), "+v"(fq));
        const int row0 = u.pm * BM + wr * 64 + fr, col0 = u.pn * HALF + wc * 32 + 8 * fq;
#pragma unroll
        for (int ai = 0; ai < 2; ++ai)
#pragma unroll
            for (int m = 0; m < 4; ++m) { const size_t off = (size_t)(row0 + ai * HALF + m * 16) * 4096 + col0;
                const u32x4 gv = *(const u32x4*)(gb + off), mv = *(const u32x4*)(M + off); f32x4 o0, o1;
#pragma unroll
                for (int e = 0; e < 4; ++e) { const unsigned gw = gv[e >> 1], mw = mv[e >> 1];
                    const float g = (e & 1) ? bfhi(gw) : bflo(gw), ma = (e & 1) ? bfhi(mw) : bflo(mw);
                    o0[e] = sigm(g) * (acc[ai][0][m][0][e] * sigm(acc[ai][1][m][0][e])) + ma; }
#pragma unroll
                for (int e = 0; e < 4; ++e) { const unsigned gw = gv[2 + (e >> 1)], mw = mv[2 + (e >> 1)];
                    const float g = (e & 1) ? bfhi(gw) : bflo(gw), ma = (e & 1) ? bfhi(mw) : bflo(mw);
                    o1[e] = sigm(g) * (acc[ai][0][m][1][e] * sigm(acc[ai][1][m][1][e])) + ma; }
                *(u32x4*)(M + off) = pack8(o0, o1); }
    }
};
struct EpiStat {
    static constexpr bool PERM = true, AFTER_DRAIN = false;
    bf16_t* O; float* stat;
    __device__ __forceinline__ void operator()(const f32x4 (&acc)[2][2][4][2], const Unit& u, int wr, int wc, int fr, int fq) const {
        asm volatile("" : "+v"(fr), "+v"(fq));
        const int row0 = u.pm * BM + wr * 64 + fr, col0 = u.pn * BM + wc * 32 + 8 * fq;
#pragma unroll
        for (int ai = 0; ai < 2; ++ai)
#pragma unroll
            for (int m = 0; m < 4; ++m) { const int row = row0 + ai * HALF + m * 16; float ss = 0.f;
#pragma unroll
                for (int bj = 0; bj < 2; ++bj) { const f32x4 a = acc[ai][bj][m][0], b = acc[ai][bj][m][1]; ss += sumsq8(a, b);
                    *(u32x4*)(O + (size_t)row * 4096 + col0 + bj * HALF) = pack8(a, b); }
                ss += __shfl_xor(ss, 16); ss += __shfl_xor(ss, 32);
                if (fq == 0) stat[row * 64 + u.pn * 4 + wc] = ss; }
    }
};
struct EpiRelu2 {
    static constexpr bool PERM = true, AFTER_DRAIN = false;
    bf16_t* O;
    __device__ __forceinline__ void operator()(const f32x4 (&acc)[2][2][4][2], const Unit& u, int wr, int wc, int fr, int fq) const {
        asm volatile("" : "+v"(fr), "+v"(fq));
        const int row0 = u.pm * BM + wr * 64 + fr, col0 = u.pn * BM + wc * 32 + 8 * fq;
#pragma unroll
        for (int ai = 0; ai < 2; ++ai)
#pragma unroll
            for (int m = 0; m < 4; ++m) { bf16_t* rowp = O + (size_t)(row0 + ai * HALF + m * 16) * 16384 + col0;
#pragma unroll
                for (int bj = 0; bj < 2; ++bj) { f32x4 a = acc[ai][bj][m][0], b = acc[ai][bj][m][1];
#pragma unroll
                    for (int e = 0; e < 4; ++e) { const float x = fmaxf(a[e], 0.f), y = fmaxf(b[e], 0.f); a[e] = x * x; b[e] = y * y; }
                    *(u32x4*)(rowp + bj * HALF) = pack8(a, b); } }
    }
};

template <class Epi, class Sched, bool ALIGN_EPI = false, bool SP2 = false>
__device__ __forceinline__ void gemm_phase(PG8_LAS unsigned char* lds, const Gemm g, const Sched& S, const Epi& E) {
    int tid_ = threadIdx.x; asm volatile("" : "+v"(tid_));
    const int tid = tid_, wid = __builtin_amdgcn_readfirstlane(tid >> 6), lane = tid & 63, wr = wid >> 2, wc = wid & 3, fr = lane & 15, fq = lane >> 4;
    const int K = g.K, nt = K / BK, lda = g.lda, ldb = g.ldb;
    unsigned voffA[2], voffB[2];
#pragma unroll
    for (int i = 0; i < 2; ++i) { int R, C; stage_rc(tid * 16 + i * 8192, R, C); const int Rb = Epi::PERM ? ((R & ~31) + perm32(R & 31)) : R;
        voffA[i] = (unsigned)(R * lda + C) * 2u; voffB[i] = (unsigned)(Rb * ldb + C) * 2u; }
    const size_t kstep = (size_t)(BK * 2);
    const size_t hstepA = (size_t)HALF * lda * 2, hstepB = (size_t)HALF * ldb * 2;
    const size_t tstepA = 2 * hstepA, tstepB = 2 * hstepB;
    const unsigned ldsw = (unsigned)wid * 1024u;
    const int aoff = lds_byte(wr * 64 + fr, fq * 8), boff = lds_byte(wc * 32 + fr, fq * 8);
#define PG8_SA(b, h) (((b) * 2 + (h)) * HTB)
#define PG8_SB(b, h) ((4 + (b) * 2 + (h)) * HTB)
#define PG8_STAGE(bufoff, gbase, voff) do { _Pragma("unroll") for (int _i = 0; _i < 2; ++_i) \
        __builtin_amdgcn_global_load_lds((const unsigned*)((const char*)(gbase) + (voff)[_i]), (PG8_LAS unsigned*)(lds + (bufoff) + ldsw + _i * 8192), 16, 0, 0); } while (0)
#define PG8_LDA(dst, b, h) do { _Pragma("unroll") for (int m = 0; m < 4; ++m) _Pragma("unroll") for (int k = 0; k < 2; ++k) dst[m][k] = *(const PG8_LAS bf16x8*)(lds + PG8_SA(b, h) + aoff + m * 2048 + k * 1024); } while (0)
#define PG8_LDB(dst, b, h) do { _Pragma("unroll") for (int n = 0; n < 2; ++n) _Pragma("unroll") for (int k = 0; k < 2; ++k) dst[n][k] = *(const PG8_LAS bf16x8*)(lds + PG8_SB(b, h) + boff + n * 2048 + k * 1024); } while (0)
#define PG8_MMA(ai, bj, At, Bt) do { __builtin_amdgcn_s_setprio(1); _Pragma("unroll") for (int m = 0; m < 4; ++m) _Pragma("unroll") for (int n = 0; n < 2; ++n) _Pragma("unroll") for (int k = 0; k < 2; ++k) \
        acc[ai][bj][m][n] = __builtin_amdgcn_mfma_f32_16x16x32_bf16(Bt[n][k], At[m][k], acc[ai][bj][m][n], 0, 0, 0); __builtin_amdgcn_s_setprio(0); } while (0)
#define PG8_WAIT_V(n) asm volatile("s_waitcnt vmcnt(" #n ")" ::: "memory")
#define PG8_WAIT_L(n) asm volatile("s_waitcnt lgkmcnt(" #n ")" ::: "memory")
#define PG8_BAR __builtin_amdgcn_s_barrier()
#define PG8_SCHED __builtin_amdgcn_sched_barrier(0)
    Unit cur, nxt; int ui = 0;
    if (!S.next(0, cur)) return;
    f32x4 acc[2][2][4][2];
#pragma unroll
    for (int a = 0; a < 2; ++a)
#pragma unroll
        for (int b = 0; b < 2; ++b)
#pragma unroll
            for (int m = 0; m < 4; ++m)
#pragma unroll
                for (int n = 0; n < 2; ++n) acc[a][b][m][n] = (f32x4){0.f, 0.f, 0.f, 0.f};
    bf16x8 At[4][2], B0[2][2], B1[2][2];
    const char* cA = (const char*)g.A + (size_t)cur.pm * tstepA; const char* cB = (const char*)g.Bt + (size_t)cur.pn * tstepB;
    S.a_ready(cur);
    if constexpr (SP2) {
        PG8_STAGE(PG8_SB(0, 0), cB, voffB); PG8_STAGE(PG8_SB(0, 1), cB + hstepB, voffB); PG8_STAGE(PG8_SA(0, 0), cA, voffA); PG8_STAGE(PG8_SA(0, 1), cA + hstepA, voffA);
        if (wr == 1) PG8_BAR;
        PG8_WAIT_V(2); PG8_BAR;
        PG8_STAGE(PG8_SB(1, 0), cB + kstep, voffB); PG8_STAGE(PG8_SA(1, 0), cA + kstep, voffA); PG8_STAGE(PG8_SB(1, 1), cB + hstepB + kstep, voffB);
        PG8_WAIT_V(6); PG8_BAR;
    } else {
        PG8_STAGE(PG8_SB(0, 0), cB, voffB); PG8_STAGE(PG8_SA(0, 0), cA, voffA); PG8_STAGE(PG8_SB(0, 1), cB + hstepB, voffB); PG8_STAGE(PG8_SA(0, 1), cA + hstepA, voffA);
        if (wr == 1) PG8_BAR;
        PG8_WAIT_V(4); PG8_BAR;
        PG8_STAGE(PG8_SB(1, 0), cB + kstep, voffB); PG8_STAGE(PG8_SA(1, 0), cA + kstep, voffA); PG8_STAGE(PG8_SB(1, 1), cB + hstepB + kstep, voffB);
        PG8_WAIT_V(6); PG8_BAR;
    }
    for (;;) {
        const bool has_next = S.next(ui + 1, nxt);
        const char* nA = has_next ? (const char*)g.A + (size_t)nxt.pm * tstepA : cA; const char* nB = has_next ? (const char*)g.Bt + (size_t)nxt.pn * tstepB : cB;
        for (int t = 0; t < nt; t += 2) {
            const bool last = (t == nt - 2);
            const char* a1 = cA + (size_t)(t + 1) * kstep;
            const char* a2 = last ? nA : cA + (size_t)(t + 2) * kstep; const char* b2 = last ? nB : cB + (size_t)(t + 2) * kstep;
            const char* a3 = a2 + kstep; const char* b3 = b2 + kstep;
            if (last && has_next) S.a_ready(nxt);
            if constexpr (SP2) {
            PG8_LDB(B0, 0, 0); PG8_LDB(B1, 0, 1); PG8_SCHED; PG8_LDA(At, 0, 0); PG8_STAGE(PG8_SA(1, 1), a1 + hstepA, voffA);
            PG8_WAIT_V(8); PG8_WAIT_L(0); PG8_BAR; PG8_MMA(0, 0, At, B0); PG8_MMA(0, 1, At, B1); PG8_BAR; PG8_SCHED;
            PG8_LDA(At, 0, 1); PG8_STAGE(PG8_SB(0, 0), b2, voffB); PG8_STAGE(PG8_SB(0, 1), b2 + hstepB, voffB); PG8_STAGE(PG8_SA(0, 0), a2, voffA);
            PG8_WAIT_V(8); PG8_WAIT_L(0); PG8_BAR; PG8_MMA(1, 0, At, B0); PG8_MMA(1, 1, At, B1); PG8_BAR; PG8_SCHED;
            PG8_LDB(B0, 1, 0); PG8_LDB(B1, 1, 1); PG8_SCHED; PG8_LDA(At, 1, 0); PG8_STAGE(PG8_SA(0, 1), a2 + hstepA, voffA);
            PG8_WAIT_V(8); PG8_WAIT_L(0); PG8_BAR; PG8_MMA(0, 0, At, B0); PG8_MMA(0, 1, At, B1); PG8_BAR; PG8_SCHED;
            PG8_LDA(At, 1, 1); PG8_STAGE(PG8_SB(1, 0), b3, voffB); PG8_STAGE(PG8_SB(1, 1), b3 + hstepB, voffB); PG8_STAGE(PG8_SA(1, 0), a3, voffA);
            PG8_WAIT_V(8); PG8_WAIT_L(0); PG8_BAR; PG8_MMA(1, 0, At, B0); PG8_MMA(1, 1, At, B1); PG8_BAR; PG8_SCHED;
            } else {
            PG8_LDB(B0, 0, 0); PG8_SCHED; PG8_LDA(At, 0, 0); PG8_STAGE(PG8_SA(1, 1), a1 + hstepA, voffA);
            PG8_WAIT_L(8); PG8_BAR; PG8_WAIT_L(0); PG8_MMA(0, 0, At, B0); PG8_BAR; PG8_SCHED;
            PG8_LDB(B1, 0, 1); PG8_STAGE(PG8_SB(0, 0), b2, voffB);
            PG8_BAR; PG8_WAIT_L(0); PG8_MMA(0, 1, At, B1); PG8_BAR;
            PG8_LDA(At, 0, 1); PG8_STAGE(PG8_SA(0, 0), a2, voffA);
            PG8_BAR; PG8_WAIT_L(0); PG8_MMA(1, 0, At, B0); PG8_BAR; PG8_SCHED;
            PG8_STAGE(PG8_SB(0, 1), b2 + hstepB, voffB);
            PG8_WAIT_V(6); PG8_BAR; PG8_MMA(1, 1, At, B1); PG8_BAR;
            PG8_LDB(B0, 1, 0); PG8_SCHED; PG8_LDA(At, 1, 0); PG8_STAGE(PG8_SA(0, 1), a2 + hstepA, voffA);
            PG8_WAIT_L(8); PG8_BAR; PG8_WAIT_L(0); PG8_MMA(0, 0, At, B0); PG8_BAR; PG8_SCHED;
            PG8_LDB(B1, 1, 1); PG8_STAGE(PG8_SB(1, 0), b3, voffB);
            PG8_BAR; PG8_WAIT_L(0); PG8_MMA(0, 1, At, B1); PG8_BAR;
            PG8_LDA(At, 1, 1); PG8_STAGE(PG8_SA(1, 0), a3, voffA);
            PG8_BAR; PG8_WAIT_L(0); PG8_MMA(1, 0, At, B0); PG8_BAR; PG8_SCHED;
            PG8_STAGE(PG8_SB(1, 1), b3 + hstepB, voffB);
            PG8_WAIT_V(6); PG8_BAR; PG8_MMA(1, 1, At, B1); PG8_BAR;
            }
        }
        if constexpr (ALIGN_EPI) { if (wr == 0) PG8_BAR; }
        if constexpr (!Epi::AFTER_DRAIN) { E(acc, cur, wr, wc, fr, fq); S.done(cur); }
        if (!has_next) break;
#pragma unroll
        for (int a = 0; a < 2; ++a)
#pragma unroll
            for (int b = 0; b < 2; ++b)
#pragma unroll
                for (int m = 0; m < 4; ++m)
#pragma unroll
                    for (int n = 0; n < 2; ++n) acc[a][b][m][n] = (f32x4){0.f, 0.f, 0.f, 0.f};
        cur = nxt; cA = nA; cB = nB; ++ui;
        if constexpr (ALIGN_EPI) { if (wr == 1) PG8_BAR; }
    }
    PG8_WAIT_V(0);
    if constexpr (!ALIGN_EPI) { if (wr == 0) PG8_BAR; }
    PG8_BAR;
    if constexpr (Epi::AFTER_DRAIN) { E.fused(acc, cur, wr, wc, fr, fq, lds, wid, lane); S.done(cur); }
#undef PG8_SA
#undef PG8_SB
#undef PG8_STAGE
#undef PG8_LDA
#undef PG8_LDB
#undef PG8_MMA
#undef PG8_WAIT_V
#undef PG8_WAIT_L
#undef PG8_BAR
#undef PG8_SCHED
}
}

namespace att {
using bf16x8 = __attribute__((ext_vector_type(8))) short;
using s16x4  = __attribute__((ext_vector_type(4))) short;
using f32x16 = __attribute__((ext_vector_type(16))) float;
using u32x4  = __attribute__((ext_vector_type(4))) unsigned;
typedef unsigned short bf16;
#ifndef ATT_SDEPTH
#define ATT_SDEPTH 1
#endif
constexpr int NW = 8, QBLK = 32, KVBLK = 64;
constexpr int SHM_V = 16384, SHM_K = 16384, SHM_R = 8192;
constexpr int OFF_V = 0, OFF_K = 2 * SHM_V, OFF_R = OFF_K + 2 * SHM_K, OFF_WS = OFF_R + 2 * SHM_R, ATT_LDS = OFF_WS + NW * 256;
constexpr int LDQ = 6144, LDK = 8192, LDR = 64, LDO = 4096;
constexpr float THR_L2 = 11.5415603f;
#define KSWZ(row, colB) ((row) * 256 + ((colB) ^ (((row) & 15) << 4)))
#define RSWZ(row, colB) ((row) * 128 + ((colB) ^ ((((row) >> 1) & 7) << 4)))
#define SBAR() __builtin_amdgcn_sched_barrier(0)
__device__ __forceinline__ int crow(int r, int hi) { return (r & 3) + 8 * (r >> 2) + 4 * hi; }
__device__ __forceinline__ unsigned cvtpk(float lo, float hi) { unsigned r; asm volatile("v_cvt_pk_bf16_f32 %0, %1, %2" : "=v"(r) : "v"(lo), "v"(hi)); return r; }
__device__ __forceinline__ bf16x8 ld8(const bf16* p) { return *reinterpret_cast<const bf16x8*>(p); }

__device__ __forceinline__ void partialSM(f32x16& p0, f32x16& p1, float& m_reg, float& mn, float& alpha) {
  float pmax = p0[0];
#pragma unroll
  for (int r = 1; r < 16; ++r) pmax = fmaxf(pmax, p0[r]);
#pragma unroll
  for (int r = 0; r < 16; ++r) pmax = fmaxf(pmax, p1[r]);
  { auto rr = __builtin_amdgcn_permlane32_swap(__float_as_uint(pmax), __float_as_uint(pmax), false, false);
    pmax = fmaxf(__uint_as_float(rr[0]), __uint_as_float(rr[1])); }
  if (__builtin_expect(__all(pmax - m_reg <= THR_L2), 1)) { mn = m_reg; alpha = 1.f; }
  else { mn = fmaxf(m_reg, pmax); alpha = __builtin_amdgcn_exp2f(m_reg - mn); m_reg = mn; }
#pragma unroll
  for (int r = 0; r < 16; ++r) p0[r] = p0[r] - mn;
#pragma unroll
  for (int r = 0; r < 16; ++r) p1[r] = p1[r] - mn;
#pragma unroll
  for (int r = 0; r < 16; ++r) p0[r] = __builtin_amdgcn_exp2f(p0[r]);
}
__device__ __forceinline__ void finishSM(f32x16& p0, f32x16& p1, float alpha, float& l_reg, bf16x8& pa0, bf16x8& pa1, bf16x8& pa2, bf16x8& pa3) {
#pragma unroll
  for (int r = 0; r < 16; ++r) p1[r] = __builtin_amdgcn_exp2f(p1[r]);
  float ps = 0;
#pragma unroll
  for (int r = 0; r < 16; ++r) ps += p0[r];
#pragma unroll
  for (int r = 0; r < 16; ++r) ps += p1[r];
  { auto rr = __builtin_amdgcn_permlane32_swap(__float_as_uint(ps), __float_as_uint(ps), false, false);
    ps = __uint_as_float(rr[0]) + __uint_as_float(rr[1]); }
  l_reg = l_reg * alpha + ps;
#define PK4(P, BASE, OUT) do { u32x4 w = {cvtpk(P[BASE + 0], P[BASE + 1]), cvtpk(P[BASE + 2], P[BASE + 3]), cvtpk(P[BASE + 4], P[BASE + 5]), cvtpk(P[BASE + 6], P[BASE + 7])}; OUT = *reinterpret_cast<bf16x8*>(&w); } while (0)
  PK4(p0, 0, pa0); PK4(p0, 8, pa1); PK4(p1, 0, pa2); PK4(p1, 8, pa3);
#undef PK4
}
__device__ __forceinline__ void qkt(f32x16& p0, f32x16& p1, const char* Ks, const char* Rs, const bf16x8* qn, const bf16x8* qr, int r32, int hi) {
  p0 = f32x16{}; p1 = f32x16{};
#pragma unroll
  for (int d0 = 0; d0 < 8; ++d0) { const int cb = (d0 * 16 + hi * 8) * 2;
    bf16x8 b0 = *reinterpret_cast<const bf16x8*>(Ks + KSWZ(r32, cb));
    bf16x8 b1 = *reinterpret_cast<const bf16x8*>(Ks + KSWZ(32 + r32, cb));
    p0 = __builtin_amdgcn_mfma_f32_32x32x16_bf16(b0, qn[d0], p0, 0, 0, 0);
    p1 = __builtin_amdgcn_mfma_f32_32x32x16_bf16(b1, qn[d0], p1, 0, 0, 0); }
#pragma unroll
  for (int d0 = 0; d0 < 4; ++d0) { const int cb = (d0 * 16 + hi * 8) * 2;
    bf16x8 b0 = *reinterpret_cast<const bf16x8*>(Rs + RSWZ(r32, cb));
    bf16x8 b1 = *reinterpret_cast<const bf16x8*>(Rs + RSWZ(32 + r32, cb));
    p0 = __builtin_amdgcn_mfma_f32_32x32x16_bf16(b0, qr[d0], p0, 0, 0, 0);
    p1 = __builtin_amdgcn_mfma_f32_32x32x16_bf16(b1, qr[d0], p1, 0, 0, 0); }
}
__device__ __forceinline__ int v_st(int k, int c) { const int kk = (k & ~0xC) | ((k & 4) << 1) | ((k & 8) >> 1); return ((kk >> 3) * 4 + (c >> 5)) * 512 + ((kk & 7) * 32 + (c & 31)) * 2; }
__device__ __forceinline__ int v_rd_base(int lane) { return ((lane & 3) << 3) | (((lane >> 2) & 3) << 6) | (((lane >> 4) & 1) << 5) | (((lane >> 5) & 1) << 8); }
constexpr int v_rd_off(int d0, int ks, int half) { return d0 * 512 + ks * 4096 + half * 2048; }
template <int OFF> __device__ __forceinline__ s16x4 tr_read(int vb) {
  s16x4 r; asm volatile("ds_read_b64_tr_b16 %0, %1 offset:%2" : "=&v"(r) : "v"(vb), "i"(OFF) : "memory"); return r;
}
template <int D0> __device__ __forceinline__ void pv_one(f32x16& od, int vb, bf16x8 pa0, bf16x8 pa1, bf16x8 pa2, bf16x8 pa3) {
  const s16x4 l0 = tr_read<v_rd_off(D0, 0, 0)>(vb), h0 = tr_read<v_rd_off(D0, 0, 1)>(vb), l1 = tr_read<v_rd_off(D0, 1, 0)>(vb), h1 = tr_read<v_rd_off(D0, 1, 1)>(vb);
  const s16x4 l2 = tr_read<v_rd_off(D0, 2, 0)>(vb), h2 = tr_read<v_rd_off(D0, 2, 1)>(vb), l3 = tr_read<v_rd_off(D0, 3, 0)>(vb), h3 = tr_read<v_rd_off(D0, 3, 1)>(vb);
  asm volatile("s_waitcnt lgkmcnt(0)" ::: "memory"); SBAR();
#define PK(L, H) (bf16x8){L[0], L[1], L[2], L[3], H[0], H[1], H[2], H[3]}
  od = __builtin_amdgcn_mfma_f32_32x32x16_bf16(pa0, PK(l0, h0), od, 0, 0, 0);
  od = __builtin_amdgcn_mfma_f32_32x32x16_bf16(pa1, PK(l1, h1), od, 0, 0, 0);
  od = __builtin_amdgcn_mfma_f32_32x32x16_bf16(pa2, PK(l2, h2), od, 0, 0, 0);
  od = __builtin_amdgcn_mfma_f32_32x32x16_bf16(pa3, PK(l3, h3), od, 0, 0, 0);
#undef PK
}
__device__ __forceinline__ void pv_d0(f32x16* o, int vb, bf16x8 pa0, bf16x8 pa1, bf16x8 pa2, bf16x8 pa3) {
  pv_one<0>(o[0], vb, pa0, pa1, pa2, pa3); pv_one<1>(o[1], vb, pa0, pa1, pa2, pa3); pv_one<2>(o[2], vb, pa0, pa1, pa2, pa3); pv_one<3>(o[3], vb, pa0, pa1, pa2, pa3);
}
__device__ __forceinline__ float sigm(float x) { return __builtin_amdgcn_rcpf(1.0f + __builtin_amdgcn_exp2f(-1.4426950408889634f * x)); }
__device__ __forceinline__ unsigned short f2bf(float f) { unsigned u = __float_as_uint(f); return (unsigned short)((u + 0x7fffu + ((u >> 16) & 1u)) >> 16); }

typedef __attribute__((address_space(3))) const char* lds_cptr;
typedef short v4i16_t __attribute__((ext_vector_type(4)));
typedef float f32x2_t __attribute__((ext_vector_type(2))); typedef __bf16 bf16x2_t __attribute__((ext_vector_type(2)));
__device__ __forceinline__ unsigned cvtpk_s(float lo, float hi) { f32x2_t v = {lo, hi}; bf16x2_t b = __builtin_convertvector(v, bf16x2_t); return __builtin_bit_cast(unsigned, b); }
__device__ __forceinline__ s16x4 vtr(lds_cptr p) { return __builtin_bit_cast(s16x4, __builtin_amdgcn_ds_read_tr16_b64_v4i16((__attribute__((address_space(3))) v4i16_t*)p)); }
#define EX2(x) __builtin_amdgcn_exp2f(x)
#define MFMA32(a, b, c) __builtin_amdgcn_mfma_f32_32x32x16_bf16(a, b, c, 0, 0, 0)
__device__ __forceinline__ void phaseA(f32x16& n0, f32x16& n1, const f32x16& q0, f32x16& q1, float alpha, float& l_reg, bf16x8& pa0, bf16x8& pa1, bf16x8& pa2, bf16x8& pa3,
                                       const char* Ks, const char* Rs, const bf16x8* qn, const bf16x8* qr, int kpre, int rpre, float ones_k0, float neg_m) {
  asm volatile("" : "+v"(kpre), "+v"(rpre));
  n0 = __builtin_amdgcn_mfma_f32_32x32x2f32(ones_k0, neg_m, f32x16{}, 0, 0, 0); n1 = __builtin_amdgcn_mfma_f32_32x32x2f32(ones_k0, neg_m, f32x16{}, 0, 0, 0);
  float s0 = 0.f, s1 = 0.f; unsigned ca0 = 0, ca1 = 0, cb0 = 0, cb1 = 0; float ps = 0.f;
#define PKA(P, B) do { ca0 = cvtpk_s(P[B + 0], P[B + 1]); ca1 = cvtpk_s(P[B + 2], P[B + 3]); } while (0)
#define PKB(P, B) do { cb0 = cvtpk_s(P[B + 4], P[B + 5]); cb1 = cvtpk_s(P[B + 6], P[B + 7]); } while (0)
#define PKS(OUT) do { u32x4 w_ = {ca0, ca1, cb0, cb1}; OUT = *reinterpret_cast<bf16x8*>(&w_); } while (0)
  constexpr int KPF = 2;
  bf16x8 kq0[KPF + 1], kq1[KPF + 1];
#define KFRAG(st) do { if ((st) < 8) { const int ad_ = kpre ^ ((st) * 32); kq0[(st) % (KPF + 1)] = *reinterpret_cast<const bf16x8*>(Ks + ad_); kq1[(st) % (KPF + 1)] = *reinterpret_cast<const bf16x8*>(Ks + ad_ + 8192); } \
    else { const int ad_ = rpre ^ (((st) - 8) * 32); kq0[(st) % (KPF + 1)] = *reinterpret_cast<const bf16x8*>(Rs + ad_); kq1[(st) % (KPF + 1)] = *reinterpret_cast<const bf16x8*>(Rs + ad_ + 4096); } } while (0)
#pragma unroll
  for (int s = 0; s < KPF; ++s) KFRAG(s);
#pragma unroll
  for (int s = 0; s < 12; ++s) {
    if (s + KPF < 12) KFRAG(s + KPF);
    const bf16x8 kb0 = kq0[s % (KPF + 1)], kb1 = kq1[s % (KPF + 1)];
    const bf16x8 qf = s < 8 ? qn[s < 8 ? s : 0] : qr[s >= 8 ? s - 8 : 0];
    n0 = MFMA32(kb0, qf, n0);
    if (s < 8) { q1[2 * s] = EX2(q1[2 * s]); s0 += q0[2 * s]; s0 += q0[2 * s + 1]; }
    if (s == 0) PKA(q0, 0); if (s == 1) PKS(pa0); if (s == 2) PKA(q0, 8); if (s == 3) PKS(pa1);
    if (s == 4) PKA(q1, 0); if (s == 5) PKS(pa2); if (s == 8) PKA(q1, 8); if (s == 9) PKS(pa3);
    if (s == 10) { ps = s0 + s1; auto rr = __builtin_amdgcn_permlane32_swap(__float_as_uint(ps), __float_as_uint(ps), false, false); ps = __uint_as_float(rr[0]) + __uint_as_float(rr[1]); }
    SBAR();
    n1 = MFMA32(kb1, qf, n1);
    if (s < 8) { q1[2 * s + 1] = EX2(q1[2 * s + 1]); }
    if (s >= 2 && s < 10) { s1 += q1[2 * (s - 2)]; s1 += q1[2 * (s - 2) + 1]; }
    if (s == 0) PKB(q0, 0); if (s == 2) PKB(q0, 8); if (s == 4) PKB(q1, 0); if (s == 8) PKB(q1, 8);
    if (s == 11) l_reg = l_reg * alpha + ps;
    SBAR();
  }
#undef KFRAG
#undef PKA
#undef PKB
#undef PKS
}
__device__ __forceinline__ void decide_rel(f32x16& p0, f32x16& p1, float& m_reg, float& alpha) {
  float a = fmaxf(fmaxf(p0[0], p0[1]), p1[0]), b = fmaxf(fmaxf(p0[2], p0[3]), p1[1]); a = fmaxf(fmaxf(a, p1[2]), p1[3]);
#pragma unroll
  for (int r = 4; r < 16; r += 4) { a = fmaxf(fmaxf(a, p0[r]), p0[r + 1]); b = fmaxf(fmaxf(b, p0[r + 2]), p0[r + 3]); a = fmaxf(fmaxf(a, p1[r]), p1[r + 1]); b = fmaxf(fmaxf(b, p1[r + 2]), p1[r + 3]); }
  float pmax = fmaxf(a, b);
  { auto rr = __builtin_amdgcn_permlane32_swap(__float_as_uint(pmax), __float_as_uint(pmax), false, false); pmax = fmaxf(__uint_as_float(rr[0]), __uint_as_float(rr[1])); }
  if (__builtin_expect(__all(pmax <= THR_L2), 1)) { alpha = 1.f; }
  else { const float d = fmaxf(pmax, 0.f); alpha = __builtin_amdgcn_exp2f(-d); m_reg += d;
#pragma unroll
    for (int r = 0; r < 16; ++r) { p0[r] -= d; p1[r] -= d; } }
}
__device__ __forceinline__ void decide(const f32x16& p0, const f32x16& p1, float& m_reg, float& mn, float& alpha) {
  float a = fmaxf(fmaxf(p0[0], p0[1]), p1[0]), b = fmaxf(fmaxf(p0[2], p0[3]), p1[1]); a = fmaxf(fmaxf(a, p1[2]), p1[3]);
#pragma unroll
  for (int r = 4; r < 16; r += 4) { a = fmaxf(fmaxf(a, p0[r]), p0[r + 1]); b = fmaxf(fmaxf(b, p0[r + 2]), p0[r + 3]); a = fmaxf(fmaxf(a, p1[r]), p1[r + 1]); b = fmaxf(fmaxf(b, p1[r + 2]), p1[r + 3]); }
  float pmax = fmaxf(a, b);
  { auto rr = __builtin_amdgcn_permlane32_swap(__float_as_uint(pmax), __float_as_uint(pmax), false, false); pmax = fmaxf(__uint_as_float(rr[0]), __uint_as_float(rr[1])); }
  mn = fmaxf(m_reg, pmax); alpha = __builtin_amdgcn_exp2f(m_reg - mn); m_reg = mn;
}
typedef __attribute__((address_space(3))) char* lds_ptr;
struct DmaArgs { const bf16* kt; const bf16* rt; const bf16* vt; int koff0, koff1, roff, voff0, voff1; int dk, dr, dv; lds_ptr l3; };
#define GLDS(src, dstoff) __builtin_amdgcn_global_load_lds((const unsigned*)(src), (__attribute__((address_space(3))) unsigned*)(D.l3 + (dstoff)), 16, 0, 0)
constexpr int VPF = 3;
__device__ __forceinline__ void phaseB_pre(s16x4 (&l)[VPF + 1], s16x4 (&h)[VPF + 1], lds_cptr vp) {
#pragma unroll
  for (int i = 0; i < VPF; ++i) { l[i] = vtr(vp + v_rd_off(i >> 2, i & 3, 0)); h[i] = vtr(vp + v_rd_off(i >> 2, i & 3, 1)); }
}
template <bool DOK, bool DOV> __device__ __forceinline__ void phaseB(f32x16* o, f32x16& n0, f32x16& n1, bf16x8 pa0, bf16x8 pa1, bf16x8 pa2, bf16x8 pa3, lds_cptr vp,
                                                                          s16x4 (&l)[VPF + 1], s16x4 (&h)[VPF + 1], const DmaArgs& D) {
  constexpr int PF = VPF;
#pragma unroll
  for (int i = 0; i < 16; ++i) { const int d0 = i >> 2, ks = i & 3;
    if (i + PF < 16) { l[(i + PF) % (PF + 1)] = vtr(vp + v_rd_off((i + PF) >> 2, (i + PF) & 3, 0)); h[(i + PF) % (PF + 1)] = vtr(vp + v_rd_off((i + PF) >> 2, (i + PF) & 3, 1)); }
    const s16x4 lc = l[i % (PF + 1)], hc = h[i % (PF + 1)];
    const bf16x8 vf = (bf16x8){lc[0], lc[1], lc[2], lc[3], hc[0], hc[1], hc[2], hc[3]};
    o[d0] = MFMA32(ks == 0 ? pa0 : ks == 1 ? pa1 : ks == 2 ? pa2 : pa3, vf, o[d0]);
    n0[i] = EX2(n0[i]);
    {
      if (DOV && i == 0) GLDS(D.vt + D.voff0, D.dv);
      if (DOV && i == 1) GLDS(D.vt + D.voff1, D.dv + 1024);
      if (DOK && i == 2) GLDS(D.kt + D.koff0, D.dk);
      if (DOK && i == 3) GLDS(D.kt + D.koff1, D.dk + 1024);
      if (DOK && i == 4) GLDS(D.rt + D.roff, D.dr); }
    SBAR(); }
}
#undef GLDS

__device__ __forceinline__ void attn_unit(const bf16* __restrict__ Qn, const bf16* __restrict__ Qr, const bf16* __restrict__ Kh, const bf16* __restrict__ Vh,
                                          const bf16* __restrict__ Kr, const bf16* __restrict__ Ga, bf16* __restrict__ Mo, int seq, char* lds) {
  int tid_ = threadIdx.x; asm volatile("" : "+v"(tid_));
  const int tid = tid_, lane = tid & 63, r32 = lane & 31, hi = lane >> 5; const int wid = __builtin_amdgcn_readfirstlane(tid >> 6);
  char* V_lds = lds + OFF_V; char* K_lds = lds + OFF_K; char* R_lds = lds + OFF_R;
  const lds_ptr l3 = (lds_ptr)lds;
  float* ws = (float*)(lds + OFF_WS) + wid * 64; float* li_l = ws; float* al_l = ws + 32;
  float m_reg = -1e30f, l_reg = 0; f32x16 o[4] = {}; bf16x8 qn[8], qr[4];
  int koff[2], voff[2], roff;
#pragma unroll
  for (int i = 0; i < 2; ++i) { const int bi = wid * 2 + i;
    { const int row = 4 * bi + (lane >> 4), lc = (lane & 15) ^ (row & 15); koff[i] = row * LDK + lc * 8; }
    { const int k = (bi >> 1) * 8 + ((lane & 31) >> 2), cc = (2 * (bi & 1) + (lane >> 5)) * 32 + (lane & 3) * 8; voff[i] = k * LDK + cc; } }
  { const int row = 8 * wid + (lane >> 3), lc = (lane & 7) ^ ((row >> 1) & 7); roff = row * LDR + lc * 8; }
#define GLDS(src, dstoff) __builtin_amdgcn_global_load_lds((const unsigned*)(src), (__attribute__((address_space(3))) unsigned*)(l3 + (dstoff)), 16, 0, 0)
#define DMA_K(t, b) do { const bf16* ks_ = Kh + (long)(t) * KVBLK * LDK; GLDS(ks_ + koff[0], OFF_K + (b) * SHM_K + (wid * 2) * 1024); GLDS(ks_ + koff[1], OFF_K + (b) * SHM_K + (wid * 2 + 1) * 1024); \
    GLDS(Kr + (long)(t) * KVBLK * LDR + roff, OFF_R + (b) * SHM_R + wid * 1024); } while (0)
#define DMA_V(t, b) do { const bf16* vs_ = Vh + (long)(t) * KVBLK * LDK; GLDS(vs_ + voff[0], OFF_V + (b) * SHM_V + (wid * 2) * 1024); GLDS(vs_ + voff[1], OFF_V + (b) * SHM_V + (wid * 2 + 1) * 1024); } while (0)
#define RESC(a) do { if (__any((a) < 1.f)) { if (hi == 0) al_l[r32] = (a); asm volatile("s_waitcnt lgkmcnt(0)" ::: "memory"); \
    _Pragma("unroll") for (int d = 0; d < 4; ++d) _Pragma("unroll") for (int r = 0; r < 16; ++r) o[d][r] *= al_l[crow(r, hi)]; } } while (0)
  const int NT = seq / KVBLK;
  DMA_K(0, 0);
  { const bf16* Qw = Qn + (long)(wid * QBLK + r32) * LDQ + hi * 8;
#pragma unroll
    for (int d0 = 0; d0 < 8; ++d0) qn[d0] = ld8(Qw + d0 * 16);
    const bf16* Rw = Qr + (long)(wid * QBLK + r32) * LDQ + hi * 8;
#pragma unroll
    for (int d0 = 0; d0 < 4; ++d0) qr[d0] = ld8(Rw + d0 * 16); }
  const lds_cptr vp0 = (lds_cptr)V_lds + v_rd_base(lane);
  const int kpre = (r32 * 256 + ((r32 & 15) << 4)) ^ (hi * 16), rpre = (r32 * 128 + (((r32 >> 1) & 7) << 4)) ^ (hi * 16);
  f32x16 pA0, pA1, pB0, pB1; float mnA, alA, alB; bf16x8 pa0, pa1, pa2, pa3;
  const float ones_k0 = hi ? 0.f : 1.f;
  __syncthreads();
  DMA_K(1, 1); DMA_V(0, 0);
  qkt(pA0, pA1, K_lds, R_lds, qn, qr, r32, hi); decide(pA0, pA1, m_reg, mnA, alA);
#pragma unroll
  for (int r = 0; r < 16; ++r) { pA0[r] = EX2(pA0[r] - mnA); pA1[r] = pA1[r] - mnA; }
  __syncthreads();
  s16x4 vl[VPF + 1], vh[VPF + 1];
  DmaArgs D; D.koff0 = koff[0]; D.koff1 = koff[1]; D.roff = roff; D.voff0 = voff[0]; D.voff1 = voff[1]; D.l3 = l3;
#define DSET(tk, bk, tv, bv) do { D.kt = Kh + (long)(tk) * KVBLK * LDK; D.rt = Kr + (long)(tk) * KVBLK * LDR; D.vt = Vh + (long)(tv) * KVBLK * LDK; \
    D.dk = OFF_K + (bk) * SHM_K + (wid * 2) * 1024; D.dr = OFF_R + (bk) * SHM_R + wid * 1024; D.dv = OFF_V + (bv) * SHM_V + (wid * 2) * 1024; } while (0)
  for (int j = 1; j + 1 < NT; j += 2) {
    DSET(j + 1, 0, j, 1);
    SBAR(); phaseA(pB0, pB1, pA0, pA1, alA, l_reg, pa0, pa1, pa2, pa3, K_lds + SHM_K, R_lds + SHM_R, qn, qr, kpre, rpre, ones_k0, -m_reg);
    phaseB_pre(vl, vh, vp0);
    decide_rel(pB0, pB1, m_reg, alB); SBAR();
    phaseB<true, true>(o, pB0, pB1, pa0, pa1, pa2, pa3, vp0, vl, vh, D);
    RESC(alB); __syncthreads();
    DSET(j + 2, 1, j + 1, 0);
    SBAR(); phaseA(pA0, pA1, pB0, pB1, alB, l_reg, pa0, pa1, pa2, pa3, K_lds, R_lds, qn, qr, kpre, rpre, ones_k0, -m_reg);
    phaseB_pre(vl, vh, vp0 + SHM_V);
    decide_rel(pA0, pA1, m_reg, alA); SBAR();
    phaseB<true, true>(o, pA0, pA1, pa0, pa1, pa2, pa3, vp0 + SHM_V, vl, vh, D);
    RESC(alA); __syncthreads();
  }
  DSET(NT - 1, 0, NT - 1, 1);
  SBAR(); phaseA(pB0, pB1, pA0, pA1, alA, l_reg, pa0, pa1, pa2, pa3, K_lds + SHM_K, R_lds + SHM_R, qn, qr, kpre, rpre, ones_k0, -m_reg);
  phaseB_pre(vl, vh, vp0);
  decide_rel(pB0, pB1, m_reg, alB); SBAR();
  phaseB<false, true>(o, pB0, pB1, pa0, pa1, pa2, pa3, vp0, vl, vh, D);
  RESC(alB); __syncthreads();
#undef DSET
  finishSM(pB0, pB1, alB, l_reg, pa0, pa1, pa2, pa3); SBAR();
  pv_d0(o, (int)(unsigned)(uintptr_t)V_lds + v_rd_base(lane) + SHM_V, pa0, pa1, pa2, pa3);
  if (hi == 0) li_l[r32] = l_reg; asm volatile("s_waitcnt lgkmcnt(0)" ::: "memory");
  float rli[16];
#pragma unroll
  for (int r = 0; r < 16; ++r) rli[r] = __builtin_amdgcn_rcpf(li_l[crow(r, hi)]);
  bf16* Ow = Mo + (long)(wid * QBLK) * LDO; const bf16* Gw = Ga + (long)(wid * QBLK) * LDO;
#pragma unroll
  for (int r = 0; r < 16; ++r) { const int orow = crow(r, hi);
#pragma unroll
    for (int d0 = 0; d0 < 4; ++d0) { const long off = (long)orow * LDO + d0 * 32 + r32;
      const float g = __uint_as_float((unsigned)Gw[off] << 16);
      Ow[off] = f2bf(o[d0][r] * rli[r] * sigm(g)); } }
  __syncthreads();
#undef GLDS
#undef DMA_K
#undef DMA_V
#undef RESC
}
#undef KSWZ
#undef RSWZ
#undef SBAR
}

constexpr int NWAVES = 8;
constexpr int DM = 4096, NPR = 8192, NROW = 24576;
constexpr int NKEY = 8192 + 4 * 4608;
constexpr int NIN = 12032;
constexpr int NCHUNK = NROW / 16;
constexpr float EPSN = 1e-6f;
constexpr float QSCALE = 0.07216878364870322f * 1.4426950408889634f;
constexpr size_t O_Y = 0, O_CKV = 100663296, O_KR = 104857600, O_S5 = 105381888, O_END = 106430464;

constexpr size_t MiB = 1u << 20;
constexpr size_t WS_CTL = 0, CTL_ZERO_BYTES = 1 * MiB;
constexpr size_t WS_PAR = 1 * MiB;
constexpr size_t WS_TAB = 2 * MiB;
constexpr size_t WS_QSTAT = 3 * MiB;
constexpr size_t WS_KVSTAT = 5 * MiB;
constexpr size_t WS_OSTAT = 6 * MiB;
constexpr size_t WS_MODPART = 12 * MiB;
constexpr size_t WS_WGLU = 28 * MiB, WS_WOUT = 60 * MiB, WS_WUQ = 92 * MiB, WS_WUKV = 104 * MiB;
constexpr size_t WS_GA = 112 * MiB, WS_GB = 304 * MiB;
constexpr size_t WS_WFF1 = 112 * MiB, WS_WFF2 = 240 * MiB;
constexpr size_t WS_A = 496 * MiB;
constexpr size_t WS_X = 688 * MiB;
constexpr size_t WS_WIN = WS_X, WS_MSTATE = WS_X + 94 * MiB, WS_MCAT = WS_X + 110 * MiB, WS_QRAW = WS_X + 142 * MiB, WS_CKVRAW = WS_X + 190 * MiB,
                 WS_KRRAW = WS_X + 238 * MiB, WS_UH = WS_X + 244 * MiB;
constexpr size_t WS_Q = WS_X, WS_KV = WS_X + 288 * MiB;
constexpr size_t WS_OUTB = WS_X;
constexpr size_t WS_A1 = WS_X;
constexpr size_t WS_QN = 1392 * MiB, WS_CKVN = 1440 * MiB, WS_KR = 1466 * MiB, WS_YG = 1470 * MiB, WS_END = 1566 * MiB;
static_assert(WS_WIN + (size_t)NIN * 4096 * 2 <= WS_MSTATE && WS_UH + (size_t)128 * 1536 * 512 * 2 <= WS_QN && WS_KV + (size_t)NKEY * 8192 * 2 <= WS_QN, "arena");
static_assert(WS_KR + (size_t)NKEY * 64 * 2 <= WS_YG && WS_CKVN + (size_t)NKEY * 512 * 2 <= WS_KR && WS_A1 + (size_t)NROW * 16384 * 2 <= WS_END, "arena 2");
constexpr int CW_TMO = 0, CW_CODE = 1, CW_BAR = 4096;

constexpr int RING_OFF = 0, RING_BYTES = 131072;
constexpr int LDSCTL_OFF = RING_BYTES, MISC_OFF = LDSCTL_OFF + 320;
constexpr int LDS_BYTES = 147456;
static_assert(att::ATT_LDS <= RING_BYTES, "attention LDS");

#define GAS __attribute__((address_space(1)))
#define LAS __attribute__((address_space(3)))
typedef unsigned short bf16;
typedef unsigned v4u __attribute__((ext_vector_type(4)));
typedef float f32x4 __attribute__((ext_vector_type(4)));
typedef short bf16x8 __attribute__((ext_vector_type(8)));
typedef GAS unsigned gu32;
typedef GAS unsigned long long gu64;
#define RLX_AGENT __ATOMIC_RELAXED, __HIP_MEMORY_SCOPE_AGENT
#define LDS_WAIT() asm volatile("s_waitcnt lgkmcnt(0)" ::: "memory")
#define VM_WAIT() asm volatile("s_waitcnt vmcnt(0)" ::: "memory")
__device__ __forceinline__ unsigned long long rt() { return __builtin_amdgcn_s_memrealtime(); }
__device__ __forceinline__ unsigned f2bf(float f) { unsigned u = __builtin_bit_cast(unsigned, f); return (u + 0x7fffu + ((u >> 16) & 1u)) >> 16; }
__device__ __forceinline__ unsigned pk2(float lo, float hi) { return f2bf(lo) | (f2bf(hi) << 16); }

#define XB_TMO      128
#define XB_XCNT(j)  (256  + 64 * (j))
#define XB_XSUB(j)  (1280 + 64 * (j))
#define XB_XGEN(j)  (2304 + 64 * (j))
#define XB_TOP      3328
#define XB_TOPGEN   3392
#define XCD_BAR_WORDS 3456
#define XB_SPIN_CAP (1u << 18)

__device__ __forceinline__ unsigned xb_ld(unsigned* p)              { return __hip_atomic_load(p, __ATOMIC_RELAXED, __HIP_MEMORY_SCOPE_AGENT); }
__device__ __forceinline__ unsigned xb_add(unsigned* p, unsigned v) { return __hip_atomic_fetch_add(p, v, __ATOMIC_RELAXED, __HIP_MEMORY_SCOPE_AGENT); }
__device__ __forceinline__ unsigned xb_xcc_id() { return (unsigned)__builtin_amdgcn_s_getreg((3 << 11) | 20) & 0xFu; }
#define XB_SPIN(cond, bar) do { unsigned _sp = 0; while (cond) { __builtin_amdgcn_s_sleep(1); \
    if ((++_sp & 255u) == 0u) { if (xb_ld(&(bar)[XB_TMO])) break; if (_sp > XB_SPIN_CAP) { atomicAdd(&(bar)[XB_TMO], 1u); break; } } } } while (0)

struct XcdBarrier {
    unsigned* bar; unsigned x;
    volatile LAS unsigned* st;
};

__device__ __forceinline__ XcdBarrier xcd_barrier_post(unsigned* bar, volatile LAS unsigned* st) {
    XcdBarrier b; b.bar = bar; b.x = xb_xcc_id(); b.st = st;
    if (threadIdx.x == 0) (void)xb_add(&bar[XB_XCNT(b.x)], 1u);
    return b;
}
__device__ __forceinline__ void xcd_barrier_complete(unsigned* bar, unsigned x, unsigned& nloc, unsigned& nx) {
    const unsigned G = gridDim.x * gridDim.y * gridDim.z;
    unsigned sum, cnt, mine, sp = 0u;
    for (;;) {
        sum = 0u; cnt = 0u; mine = 0u;
#pragma unroll
        for (unsigned j = 0; j < 16; ++j) { const unsigned c = xb_ld(&bar[XB_XCNT(j)]); sum += c; cnt += (c > 0u) ? 1u : 0u; mine = (j == x) ? c : mine; }
        if (sum == G) break;
        __builtin_amdgcn_s_sleep(1);
        if ((++sp & 255u) == 0u) { if (xb_ld(&bar[XB_TMO])) break; if (sp > XB_SPIN_CAP) { atomicAdd(&bar[XB_TMO], 1u); break; } }
    }
    nloc = mine > 0u ? mine : 1u; nx = cnt > 0u ? cnt : 1u;
}

__device__ __forceinline__ void xcd_barrier(const XcdBarrier& b) {
    asm volatile("s_waitcnt vmcnt(0)" ::: "memory");
    __syncthreads();
    if (threadIdx.x == 0) {
        unsigned* bar = b.bar;
        __builtin_amdgcn_s_waitcnt(0);
        unsigned nloc = b.st[0], nx = b.st[1];
        if (nloc == 0u) { xcd_barrier_complete(bar, b.x, nloc, nx); b.st[0] = nloc; b.st[1] = nx; }
        const unsigned old = xb_add(&bar[XB_XSUB(b.x)], 1u);
        const unsigned gen = old / nloc;
        if (old + 1u == (gen + 1u) * nloc) {
            __builtin_amdgcn_fence(__ATOMIC_RELEASE, "agent");
            asm volatile("s_waitcnt vmcnt(0)" ::: "memory");
            const unsigned og = xb_add(&bar[XB_TOP], 1u);
            const unsigned tg = og / nx;
            if (og + 1u == (tg + 1u) * nx) xb_add(&bar[XB_TOPGEN], 1u);
            else XB_SPIN(xb_ld(&bar[XB_TOPGEN]) == tg, bar);
            __builtin_amdgcn_fence(__ATOMIC_ACQUIRE, "agent");
            xb_add(&bar[XB_XGEN(b.x)], 1u);
            asm volatile("s_waitcnt vmcnt(0)" ::: "memory");
        } else {
            XB_SPIN(xb_ld(&bar[XB_XGEN(b.x)]) == gen, bar);
            __builtin_amdgcn_fence(__ATOMIC_ACQUIRE, "agent");
            asm volatile("s_waitcnt vmcnt(0)" ::: "memory");
        }
    }
    __syncthreads();
}


typedef float f32x2 __attribute__((ext_vector_type(2)));
typedef unsigned u32x2 __attribute__((ext_vector_type(2)));
struct Frame {
    LAS unsigned char* lds;
    volatile LAS unsigned* MISC;
    gu32* ctl;
    int tid, lane, wave;
    int vcu, G;
    float* out; unsigned char* ws;
};
typedef const float* cfp_t;
typedef __attribute__((address_space(4))) const cfp_t* kargp_t;
__device__ __forceinline__ const float* inp(int k) { kargp_t p = (kargp_t)__builtin_amdgcn_kernarg_segment_ptr(); asm volatile("" : "+s"(p)); return p[k]; }
__device__ __forceinline__ float wave_sum(float v) {
#pragma unroll
    for (int o = 1; o < 64; o <<= 1) v += __shfl_xor(v, o);
    return v;
}
__device__ __forceinline__ float bf2f(unsigned short h) { return __uint_as_float((unsigned)h << 16); }
__device__ __forceinline__ float sigmf(float x) { return __builtin_amdgcn_rcpf(1.0f + __builtin_amdgcn_exp2f(-1.4426950408889634f * x)); }

__device__ __forceinline__ int mapcol(int code, int n) {
    if (code == 1) return n < 1536 ? n : (n < 11776 ? n + 64 : (n < 11840 ? n - 11776 + 1536 : -1));
    if (code == 2) { if (n < 4096) return (n >> 7) * 192 + (n & 127); const int m = n - 4096, h = m >> 6, i = m & 63; return h * 192 + 128 + (i >> 1) + 32 * (i & 1); }
    if (code == 3) { const int t = n >> 8, r = n & 255; return r < 128 ? t * 128 + r : 4096 + t * 128 + (r - 128); }
    return n;
}
__device__ __forceinline__ void transpose_item(const float* W, int K, int Nsrc, int Ndst, int code, bf16* WT, LAS float* scr, int item, int lane) {
    const int nblk = Ndst / 32, kb = item / nblk, nb = item - kb * nblk, k0 = 64 * kb, n0 = 32 * nb;
    const int sc = mapcol(code, n0 + (lane & 31));
#pragma unroll 8
    for (int i = 0; i < 32; ++i) { const int kk = 2 * i + (lane >> 5); scr[kk * 33 + (lane & 31)] = sc >= 0 ? W[(size_t)(k0 + kk) * Nsrc + sc] : 0.f; }
    LDS_WAIT(); asm volatile("" ::: "memory");
    const int c = lane & 7;
#pragma unroll
    for (int j = 0; j < 4; ++j) { const int n = (lane >> 3) + 8 * j; const LAS float* s = scr + (8 * c) * 33 + n;
        v4u o; o.x = pk2(s[0 * 33], s[1 * 33]); o.y = pk2(s[2 * 33], s[3 * 33]); o.z = pk2(s[4 * 33], s[5 * 33]); o.w = pk2(s[6 * 33], s[7 * 33]);
        *(GAS v4u*)(WT + (size_t)(n0 + n) * K + k0 + 8 * c) = o; }
    LDS_WAIT(); asm volatile("" ::: "memory");
}

struct ConvJob { const float* W; bf16* WT; int K, Nsrc, Ndst, code, item; };
__device__ __forceinline__ void conv_item_kn(const ConvJob& j, int& kb, int& nb) {
    const int nblk = j.Ndst / 32;
    if (j.code == 0 && j.K >= 4096 && (nblk & 31) == 0) { const int r = j.item & 2047, q = j.item >> 11, kg = j.K / 4096; kb = (q % kg) * 64 + (r >> 5); nb = (q / kg) * 32 + (r & 31); }
    else { kb = j.item / nblk; nb = j.item - kb * nblk; }
}
__device__ __forceinline__ void conv_load(const ConvJob& j, int lane, f32x4 (&v)[8]) {
    int kb, nb; conv_item_kn(j, kb, nb); const int k0 = 64 * kb, n0 = 32 * nb, c4 = lane & 7, r8 = lane >> 3;
    const int sc = mapcol(j.code, n0 + c4 * 4);
    if (sc >= 0) {
#pragma unroll
        for (int i = 0; i < 8; ++i) v[i] = __builtin_nontemporal_load((const GAS f32x4*)(j.W + (size_t)(k0 + i * 8 + r8) * j.Nsrc + sc));
    } else {
#pragma unroll
        for (int i = 0; i < 8; ++i) v[i] = (f32x4){0.f, 0.f, 0.f, 0.f};
    }
}
__device__ __forceinline__ void conv_lds_write(LAS float* scr, int lane, const f32x4 (&v)[8]) {
    const int c4 = lane & 7, r8 = lane >> 3;
#pragma unroll
    for (int i = 0; i < 8; ++i) { LAS float* d = scr + (i * 8 + r8) * 33 + c4 * 4; d[0] = v[i].x; d[1] = v[i].y; d[2] = v[i].z; d[3] = v[i].w; }
}
__device__ __forceinline__ void conv_store(const ConvJob& j, LAS float* scr, int lane) {
    int kb, nb; conv_item_kn(j, kb, nb); const int k0 = 64 * kb, n0 = 32 * nb, c = lane & 7;
#pragma unroll
    for (int jj = 0; jj < 4; ++jj) { const int n = (lane >> 3) + 8 * jj; const LAS float* s = scr + (8 * c) * 33 + n;
        v4u o; o.x = pk2(s[0 * 33], s[1 * 33]); o.y = pk2(s[2 * 33], s[3 * 33]); o.z = pk2(s[4 * 33], s[5 * 33]); o.w = pk2(s[6 * 33], s[7 * 33]);
        *(GAS v4u*)(j.WT + (size_t)(n0 + n) * j.K + k0 + 8 * c) = o; }
}
template <int MODE>
__device__ __forceinline__ ConvJob conv_resolve(int r, const float* w0, const float* w1, const float* w2, const float* w3, unsigned char* ws) {
    ConvJob j;
    if (MODE == 0) {
        constexpr int I_IN = (4096 / 64) * (NIN / 32), I_UKV = (512 / 64) * (8192 / 32), I_GLU = (2048 / 64) * (8192 / 32);
        if (r < I_IN) { j.W = w0; j.WT = (bf16*)(ws + WS_WIN); j.K = 4096; j.Nsrc = 11840; j.Ndst = NIN; j.code = 1; j.item = r; }
        else if (r < I_IN + I_UKV) { j.W = w1; j.WT = (bf16*)(ws + WS_WUKV); j.K = 512; j.Nsrc = 8192; j.Ndst = 8192; j.code = 0; j.item = r - I_IN; }
        else if (r < I_IN + I_UKV + I_GLU) { j.W = w2; j.WT = (bf16*)(ws + WS_WGLU); j.K = 2048; j.Nsrc = 8192; j.Ndst = 8192; j.code = 3; j.item = r - I_IN - I_UKV; }
        else { j.W = w3; j.WT = (bf16*)(ws + WS_WOUT); j.K = 4096; j.Nsrc = 4096; j.Ndst = 4096; j.code = 0; j.item = r - I_IN - I_UKV - I_GLU; }
    } else {
        constexpr int I_F1 = (4096 / 64) * (16384 / 32);
        if (r < I_F1) { j.W = w0; j.WT = (bf16*)(ws + WS_WFF1); j.K = 4096; j.Nsrc = 16384; j.Ndst = 16384; j.code = 0; j.item = r; }
        else { j.W = w1; j.WT = (bf16*)(ws + WS_WFF2); j.K = 16384; j.Nsrc = 4096; j.Ndst = 4096; j.code = 0; j.item = r - I_F1; }
    }
    return j;
}
template <int MODE>
__device__ __forceinline__ void conv_run(const float* w0, const float* w1, const float* w2, const float* w3, unsigned char* ws, int total, int gw, int NGW, LAS float* scr, int lane, int first = 0) {
    int it = first + gw; if (it >= total) return;
    ConvJob cur = conv_resolve<MODE>(it, w0, w1, w2, w3, ws); f32x4 v[8]; conv_load(cur, lane, v);
    for (;;) {
        conv_lds_write(scr, lane, v);
        const int nit = it + NGW; const bool more = nit < total;
        if (more) { const ConvJob nxt = conv_resolve<MODE>(nit, w0, w1, w2, w3, ws); conv_load(nxt, lane, v); }
        LDS_WAIT(); asm volatile("" ::: "memory");
        conv_store(cur, scr, lane);
        LDS_WAIT(); asm volatile("" ::: "memory");
        if (!more) break;
        it = nit; cur = conv_resolve<MODE>(it, w0, w1, w2, w3, ws);
    }
}

__device__ __forceinline__ void adaln_unit(Frame& F, int id) {
    const int slab = id >> 5, ks = id & 31, k0 = ks * 128, col0 = slab * 1024;
    LAS float* sl = (LAS float*)(F.lds);
    LAS f32x4* red = (LAS f32x4*)(F.lds + 4096);
    for (int i = F.tid; i < 640; i += 512) { const int j = i >> 7, k = i & 127; const float v = (j == 0) ? inp(6)[k0 + k] : inp(2)[(j - 1) * 4096 + k0 + k];
        sl[i] = v / (1.0f + expf(-v)); }
    __syncthreads();
    const int c4 = F.tid & 255, kh = F.tid >> 8;
    f32x4 acc[5];
#pragma unroll
    for (int j = 0; j < 5; ++j) acc[j] = (f32x4){0.f, 0.f, 0.f, 0.f};
    const float* wp = inp(7) + (size_t)(k0 + kh * 64) * 24576 + col0 + c4 * 4;
#pragma unroll 8
    for (int kk = 0; kk < 64; ++kk) { const f32x4 w = *(const GAS f32x4*)(wp + (size_t)kk * 24576);
#pragma unroll
        for (int j = 0; j < 5; ++j) acc[j] += sl[j * 128 + kh * 64 + kk] * w; }
    if (kh == 1) {
#pragma unroll
        for (int j = 0; j < 5; ++j) red[j * 256 + c4] = acc[j]; }
    __syncthreads();
    if (kh == 0) { float* mp = (float*)(F.ws + WS_MODPART);
#pragma unroll
        for (int j = 0; j < 5; ++j) { const f32x4 v = acc[j] + red[j * 256 + c4]; *(GAS f32x4*)(mp + (size_t)(ks * 5 + j) * 24576 + col0 + c4 * 4) = v; } }
    __syncthreads();
}

__device__ __forceinline__ void s5_task(Frame& F, int g) {
    LAS f32x2* pw = (LAS f32x2*)(F.lds);
    LAS f32x2* coef = (LAS f32x2*)(F.lds + 17408);
    LAS f32x2* Bb = (LAS f32x2*)(F.lds + 18432);
    LAS f32x2* Cc = (LAS f32x2*)(F.lds + 34816);
    LAS float* Kt = (LAS float*)(F.lds + 51200);
    const int tid = F.tid;
    if (tid < 128) { const int dir = tid >> 6, p = tid & 63, idx = (dir * 128 + g) * 64 + p;
        const double lr = (double)inp(15)[idx], li = (double)inp(16)[idx], dt = exp((double)inp(17)[dir * 128 + g]);
        const double zr = lr * dt, zi = li * dt, er = exp(zr), ar = er * cos(zi), ai = er * sin(zi);
        const double nr = ar - 1.0, ni = ai, den = lr * lr + li * li;
        coef[dir * 64 + p] = (f32x2){(float)((nr * lr + ni * li) / den), (float)((ni * lr - nr * li) / den)};
        double pr = 1.0, pi = 0.0;
        for (int d = 0; d <= 16; ++d) { pw[(dir * 17 + d) * 64 + p] = (f32x2){(float)pr, (float)pi}; const double t = pr * ar - pi * ai; pi = pr * ai + pi * ar; pr = t; }
        const f32x2 a16 = pw[(dir * 17 + 16) * 64 + p];
        ((f32x2*)(F.ws + WS_PAR + 512 * 1024))[(dir * 128 + g) * 64 + p] = a16; }
    __syncthreads();
    for (int i = tid; i < 2048; i += 512) { const int dir = i >> 10, p = (i >> 4) & 63, j = i & 15; const size_t gi = ((size_t)(dir * 128 + g) * 64 + p) * 16 + j;
        const float br = inp(18)[gi], bi = inp(19)[gi]; const f32x2 cf = coef[dir * 64 + p];
        Bb[i] = (f32x2){cf.x * br - cf.y * bi, cf.x * bi + cf.y * br}; }
    for (int i = tid; i < 2048; i += 512) { const int dir = i >> 10; const size_t gi = (size_t)(dir * 128 + g) * 1024 + (i & 1023);
        Cc[i] = (f32x2){inp(20)[gi], inp(21)[gi]}; }
    __syncthreads();
    { const int dir = tid >> 8, jj = tid & 255, j = jj >> 4, jp = jj & 15; float acc[16];
#pragma unroll
        for (int d = 0; d < 16; ++d) acc[d] = 0.f;
        for (int p = 0; p < 64; ++p) { const f32x2 c = Cc[(dir * 16 + j) * 64 + p], b = Bb[(dir * 64 + p) * 16 + jp]; const float Pr = c.x * b.x - c.y * b.y, Pi = c.x * b.y + c.y * b.x;
#pragma unroll
            for (int d = 0; d < 16; ++d) { const f32x2 w = pw[(dir * 17 + d) * 64 + p]; acc[d] += Pr * w.x - Pi * w.y; } }
#pragma unroll
        for (int d = 0; d < 16; ++d) Kt[(dir * 16 + d) * 256 + jj] = acc[d]; }
    __syncthreads();
    bf16* Mcat = (bf16*)(F.ws + WS_MCAT) + (size_t)g * 256 * 512; bf16* Mst = (bf16*)(F.ws + WS_MSTATE) + (size_t)g * 256 * 256;
    for (int it = 0; it < 32; ++it) { const int idx = tid + 512 * it, n = idx >> 6, k8 = (idx & 63) * 8, tau = n >> 4, j = n & 15; float v[8];
        if (k8 < 256) { const int sg = k8 >> 4, j0 = k8 & 15;
#pragma unroll
            for (int e = 0; e < 8; ++e) { const int jp = j0 + e; float x = 0.f;
                if (sg <= tau) x += Kt[(0 * 16 + (tau - sg)) * 256 + j * 16 + jp];
                if (sg >= tau) x += Kt[(1 * 16 + (sg - tau)) * 256 + j * 16 + jp];
                if (sg == tau && j == jp) x += inp(22)[g * 16 + j];
                v[e] = x; }
        } else { const int kk = k8 - 256, dir = kk >> 7, part = (kk >> 6) & 1, p0 = kk & 63, ep = dir == 0 ? tau + 1 : 16 - tau;
#pragma unroll
            for (int e = 0; e < 8; ++e) { const f32x2 w = pw[(dir * 17 + ep) * 64 + p0 + e], c = Cc[(dir * 16 + j) * 64 + p0 + e];
                v[e] = part == 0 ? (c.x * w.x - c.y * w.y) : -(c.x * w.y + c.y * w.x); } }
        v4u o; o.x = pk2(v[0], v[1]); o.y = pk2(v[2], v[3]); o.z = pk2(v[4], v[5]); o.w = pk2(v[6], v[7]);
        *(GAS v4u*)(Mcat + (size_t)n * 512 + k8) = o; }
    for (int it = 0; it < 16; ++it) { const int idx = tid + 512 * it, n = idx >> 5, k8 = (idx & 31) * 8, dir = n >> 7, part = (n >> 6) & 1, p = n & 63, sg = k8 >> 4, j0 = k8 & 15, ep = dir == 0 ? 15 - sg : sg;
        const f32x2 w = pw[(dir * 17 + ep) * 64 + p]; float v[8];
#pragma unroll
        for (int e = 0; e < 8; ++e) { const f32x2 b = Bb[(dir * 64 + p) * 16 + j0 + e]; v[e] = part == 0 ? (w.x * b.x - w.y * b.y) : (w.x * b.y + w.y * b.x); }
        v4u o; o.x = pk2(v[0], v[1]); o.y = pk2(v[2], v[3]); o.z = pk2(v[4], v[5]); o.w = pk2(v[6], v[7]);
        *(GAS v4u*)(Mst + (size_t)n * 256 + k8) = o; }
    __syncthreads();
}

__device__ __forceinline__ void p0_prologue(Frame& F) {
    for (int id = F.vcu; id < 768; id += F.G) adaln_unit(F, id);
    for (int g = F.vcu; g < 128; g += F.G) s5_task(F, g);
    { float* tab = (float*)(F.ws + WS_TAB);
      for (int idx = F.vcu * 512 + F.tid; idx < 4096 * 32; idx += F.G * 512) { const int t = idx >> 5, p = idx & 31, pos = p < 16 ? (t >> 6) : (t & 63), f = p & 15;
        const double inv = exp(-(double)f * (9.210340371976184 / 16.0)), ang = (double)pos * inv;
        *(GAS f32x2*)(tab + (size_t)idx * 2) = (f32x2){(float)cos(ang), (float)sin(ang)}; } }
    LAS float* scr = (LAS float*)(F.lds + RING_OFF + F.wave * 16384);
    const int gw = F.vcu * NWAVES + F.wave, NGW = F.G * NWAVES;
    constexpr int I_IN = (4096 / 64) * (NIN / 32), I_UQ = (1024 / 64) * (6144 / 32), I_UKV = (512 / 64) * (8192 / 32), I_GLU = (2048 / 64) * (8192 / 32), I_OUT = (4096 / 64) * (4096 / 32);
    { constexpr int I_ALL = I_IN + I_UKV + I_GLU + I_OUT;
      if (F.G == 256) { constexpr int I_EVEN = (I_ALL * 3 / 4) & ~2047;
          conv_run<0>(inp(10), inp(14), inp(23), inp(24), F.ws, I_EVEN, gw, NGW, scr, F.lane);
          if (F.vcu >= 128) conv_run<0>(inp(10), inp(14), inp(23), inp(24), F.ws, I_ALL, gw - 128 * NWAVES, 128 * NWAVES, scr, F.lane, I_EVEN); }
      else conv_run<0>(inp(10), inp(14), inp(23), inp(24), F.ws, I_ALL, gw, NGW, scr, F.lane); }
    { const float* w_uq = inp(13);
      for (int it = gw; it < I_UQ; it += NGW) transpose_item(w_uq, 1024, 6144, 6144, 2, (bf16*)(F.ws + WS_WUQ), scr, it, F.lane); }
}
__device__ __forceinline__ void p0b_modreduce(Frame& F) {
    const float* mp = (const float*)(F.ws + WS_MODPART); float* par = (float*)(F.ws + WS_PAR);
    for (int idx = F.vcu * 512 + F.tid; idx < 5 * 4096; idx += F.G * 512) { const int j = idx >> 12, k = idx & 4095; float m[6];
#pragma unroll
        for (int i = 0; i < 6; ++i) { const int n = i * 4096 + k; float s = inp(8)[n];
            for (int ks = 0; ks < 32; ++ks) s += mp[(size_t)(ks * 5 + j) * 24576 + n];
            m[i] = s; }
        par[0 * 20480 + idx] = inp(9)[k] * (1.0f + m[1]); par[1 * 20480 + idx] = m[0]; par[2 * 20480 + idx] = m[2] * inp(25)[k];
        par[3 * 20480 + idx] = inp(26)[k] * (1.0f + m[4]); par[4 * 20480 + idx] = m[3]; par[5 * 20480 + idx] = m[5] * inp(29)[k]; }
}
__device__ __forceinline__ int cond_of_row(int m) { return m < NPR ? 0 : 1 + ((m - NPR) >> 12); }
__device__ __forceinline__ const float* xrow_of(const Frame& F, int m) { return m < NPR ? inp(0) + (size_t)m * DM : inp(1) + (size_t)(m - NPR) * DM; }
__device__ __forceinline__ void p1_modnorm(Frame& F) {
    const int gw = F.vcu * NWAVES + F.wave, NGW = F.G * NWAVES; const float* par = (const float*)(F.ws + WS_PAR); bf16* H = (bf16*)(F.ws + WS_A);
    for (int m = gw; m < NROW; m += NGW) { const int cd = cond_of_row(m); const GAS f32x4* xr = (const GAS f32x4*)xrow_of(F, m) + F.lane;
        const GAS f32x4* A = (const GAS f32x4*)(par + 0 * 20480 + cd * 4096) + F.lane; const GAS f32x4* B = (const GAS f32x4*)(par + 1 * 20480 + cd * 4096) + F.lane;
        f32x4 v[16]; float s = 0.f;
#pragma unroll
        for (int j = 0; j < 16; ++j) { v[j] = xr[64 * j]; s += (v[j].x * v[j].x + v[j].y * v[j].y) + (v[j].z * v[j].z + v[j].w * v[j].w); }
        const float rinv = 1.0f / sqrtf(wave_sum(s) * (1.0f / DM) + EPSN);
        GAS u32x2* o8 = (GAS u32x2*)(H + (size_t)m * DM) + F.lane;
#pragma unroll
        for (int j = 0; j < 16; ++j) { const f32x4 a = A[64 * j], b = B[64 * j]; const f32x4 y = v[j] * rinv * a + b; o8[64 * j] = (u32x2){pk2(y.x, y.y), pk2(y.z, y.w)}; } }
}
__device__ __forceinline__ void p3_rowpass(Frame& F) {
    const int gw = F.vcu * NWAVES + F.wave, NGW = F.G * NWAVES, lane = F.lane;
    const bf16* qraw = (const bf16*)(F.ws + WS_QRAW); const float* ckvraw = (const float*)(F.ws + WS_CKVRAW); const float* krraw = (const float*)(F.ws + WS_KRRAW);
    const float* qstat = (const float*)(F.ws + WS_QSTAT); const float* kvstat = (const float*)(F.ws + WS_KVSTAT); const float* tab = (const float*)(F.ws + WS_TAB);
    bf16* qn = (bf16*)(F.ws + WS_QN); bf16* ckvn = (bf16*)(F.ws + WS_CKVN); bf16* Kr = (bf16*)(F.ws + WS_KR);
    for (int m = gw; m < NROW + 2048; m += NGW) {
        if (m < NROW) {
            const int keyrow = m < NPR ? m : NPR + ((m - NPR) >> 12) * 4608 + 512 + ((m - NPR) & 4095);
            const float qs = wave_sum(lane < 16 ? qstat[m * 16 + lane] : 0.f), ks = wave_sum(lane < 8 ? kvstat[m * 8 + lane] : 0.f);
            const float rq = 1.0f / sqrtf(qs * (1.0f / 1024.f) + EPSN), rk = 1.0f / sqrtf(ks * (1.0f / 512.f) + EPSN);
#pragma unroll
            for (int hh = 0; hh < 2; ++hh) { const int k0 = hh * 512 + lane * 8; const v4u w = *(const GAS v4u*)(qraw + (size_t)m * 1024 + k0);
                const f32x4 g0 = *(const GAS f32x4*)(inp(11) + k0), g1 = *(const GAS f32x4*)(inp(11) + k0 + 4); v4u o;
                o.x = pk2(__uint_as_float(w.x << 16) * rq * g0.x, __uint_as_float(w.x & 0xffff0000u) * rq * g0.y); o.y = pk2(__uint_as_float(w.y << 16) * rq * g0.z, __uint_as_float(w.y & 0xffff0000u) * rq * g0.w);
                o.z = pk2(__uint_as_float(w.z << 16) * rq * g1.x, __uint_as_float(w.z & 0xffff0000u) * rq * g1.y); o.w = pk2(__uint_as_float(w.w << 16) * rq * g1.z, __uint_as_float(w.w & 0xffff0000u) * rq * g1.w);
                *(GAS v4u*)(qn + (size_t)m * 1024 + k0) = o; }
            { const int k0 = lane * 8; const f32x4 a = *(const GAS f32x4*)(ckvraw + (size_t)m * 512 + k0), b = *(const GAS f32x4*)(ckvraw + (size_t)m * 512 + k0 + 4);
              const f32x4 g0 = *(const GAS f32x4*)(inp(12) + k0), g1 = *(const GAS f32x4*)(inp(12) + k0 + 4); const f32x4 ya = a * rk * g0, yb = b * rk * g1;
              v4u o; o.x = pk2(ya.x, ya.y); o.y = pk2(ya.z, ya.w); o.z = pk2(yb.x, yb.y); o.w = pk2(yb.z, yb.w);
              *(GAS v4u*)(ckvn + (size_t)keyrow * 512 + k0) = o;
              if (m < NPR) { float* oc = F.out + O_CKV + (size_t)m * 512 + k0; *(GAS f32x4*)oc = ya; *(GAS f32x4*)(oc + 4) = yb; } }
            if (lane < 32) { float lo = krraw[(size_t)m * 64 + lane], hi = krraw[(size_t)m * 64 + lane + 32];
                if (m < NPR) { F.out[O_KR + (size_t)m * 64 + lane] = lo; F.out[O_KR + (size_t)m * 64 + lane + 32] = hi; }
                else { const int t = (m - NPR) & 4095; const f32x2 cs = *(const GAS f32x2*)(tab + ((size_t)t * 32 + lane) * 2); const float l2 = lo * cs.x - hi * cs.y, h2 = hi * cs.x + lo * cs.y; lo = l2; hi = h2; }
                *(GAS unsigned*)(Kr + (size_t)keyrow * 64 + 2 * lane) = pk2(lo, hi); }
        } else {
            const int idx = m - NROW, b = idx >> 9, s = idx & 511, keyrow = NPR + b * 4608 + s, k0 = lane * 8;
            const f32x4 a = *(const GAS f32x4*)(inp(3) + (size_t)idx * 512 + k0), bb = *(const GAS f32x4*)(inp(3) + (size_t)idx * 512 + k0 + 4);
            v4u o; o.x = pk2(a.x, a.y); o.y = pk2(a.z, a.w); o.z = pk2(bb.x, bb.y); o.w = pk2(bb.z, bb.w);
            *(GAS v4u*)(ckvn + (size_t)keyrow * 512 + k0) = o;
            if (lane < 32) *(GAS unsigned*)(Kr + (size_t)keyrow * 64 + 2 * lane) = pk2(inp(4)[(size_t)idx * 64 + lane], inp(4)[(size_t)idx * 64 + lane + 32]);
        }
    }
}
__device__ __forceinline__ void scan_task(Frame& F, int seq, int g, int dir) {
    const int lane = F.lane; const bool prompt = seq < 32; const int nc = prompt ? 16 : 256, cbase = prompt ? seq * 16 : 512 + (seq - 32) * 256;
    const f32x2 aT = ((const f32x2*)(F.ws + WS_PAR + 512 * 1024))[(dir * 128 + g) * 64 + lane];
    float hr = 0.f, hi = 0.f;
    if (!prompt) { const size_t si = ((size_t)((seq - 32) * 2 + dir) * 2) * 8192 + g * 64 + lane; hr = inp(5)[si]; hi = inp(5)[si + 8192]; }
    const float* S = (const float*)(F.ws + WS_A) + ((size_t)g * NCHUNK + cbase) * 256 + dir * 128 + lane;
    bf16* Hb = (bf16*)(F.ws + WS_UH) + ((size_t)g * NCHUNK + cbase) * 512 + 256 + dir * 128 + lane;
    for (int c0 = 0; c0 < nc; c0 += 8) { float sr[8], si[8];
#pragma unroll
        for (int e = 0; e < 8; ++e) { const int c = dir == 0 ? c0 + e : nc - 1 - (c0 + e); sr[e] = S[(size_t)c * 256]; si[e] = S[(size_t)c * 256 + 64]; }
#pragma unroll
        for (int e = 0; e < 8; ++e) { const int c = dir == 0 ? c0 + e : nc - 1 - (c0 + e);
            Hb[(size_t)c * 512] = (bf16)f2bf(hr); Hb[(size_t)c * 512 + 64] = (bf16)f2bf(hi);
            const float nr = aT.x * hr - aT.y * hi + sr[e], ni = aT.x * hi + aT.y * hr + si[e]; hr = nr; hi = ni; } }
    if (prompt) { float* o = F.out + O_S5 + ((size_t)(seq * 2 + dir) * 2) * 8192 + g * 64 + lane; o[0] = hr; o[8192] = hi; }
}
__device__ __forceinline__ void p4b_scan(Frame& F) {
    const int gw = F.vcu * NWAVES + F.wave, NGW = F.G * NWAVES;
    for (int t = gw; t < 2048; t += NGW) {
        if (t < 1024) scan_task(F, 32 + (t >> 8), (t >> 1) & 127, t & 1);
        else { const int base = (t - 1024) * 8; for (int e = 0; e < 8; ++e) { const int q = base + e; scan_task(F, q >> 8, (q >> 1) & 127, q & 1); } }
    }
}
__device__ __forceinline__ void p9_rowpass(Frame& F) {
    const int gw = F.vcu * NWAVES + F.wave, NGW = F.G * NWAVES, lane = F.lane; const float* par = (const float*)(F.ws + WS_PAR);
    const bf16* ob = (const bf16*)(F.ws + WS_OUTB); const float* ostat = (const float*)(F.ws + WS_OSTAT); bf16* H2 = (bf16*)(F.ws + WS_A);
    for (int m = gw; m < NROW; m += NGW) { const int cd = cond_of_row(m); const GAS f32x4* xr = (const GAS f32x4*)xrow_of(F, m) + lane;
        const float r1 = 1.0f / sqrtf(wave_sum(ostat[(size_t)m * 64 + lane]) * (1.0f / DM) + EPSN);
        const GAS f32x4* P2 = (const GAS f32x4*)(par + 2 * 20480 + cd * 4096) + lane; const GAS u32x2* o2 = (const GAS u32x2*)(ob + (size_t)m * DM) + lane;
        GAS u32x2* xo = (GAS u32x2*)(F.out + O_Y + (size_t)m * DM + DM / 2) + lane;
        f32x4 v[16]; float s = 0.f;
#pragma unroll
        for (int j = 0; j < 16; ++j) { const u32x2 w = o2[64 * j]; const f32x4 o = (f32x4){__uint_as_float(w.x << 16), __uint_as_float(w.x & 0xffff0000u), __uint_as_float(w.y << 16), __uint_as_float(w.y & 0xffff0000u)};
            v[j] = xr[64 * j] + P2[64 * j] * o * r1; xo[64 * j] = (u32x2){pk2(v[j].x, v[j].y), pk2(v[j].z, v[j].w)}; s += (v[j].x * v[j].x + v[j].y * v[j].y) + (v[j].z * v[j].z + v[j].w * v[j].w); }
        const float r2 = 1.0f / sqrtf(wave_sum(s) * (1.0f / DM) + EPSN);
        const GAS f32x4* A = (const GAS f32x4*)(par + 3 * 20480 + cd * 4096) + lane; const GAS f32x4* B = (const GAS f32x4*)(par + 4 * 20480 + cd * 4096) + lane;
        GAS u32x2* o8 = (GAS u32x2*)(H2 + (size_t)m * DM) + lane;
#pragma unroll
        for (int j = 0; j < 16; ++j) { const f32x4 y = v[j] * r2 * A[64 * j] + B[64 * j]; o8[64 * j] = (u32x2){pk2(y.x, y.y), pk2(y.z, y.w)}; } }
    LAS float* scr = (LAS float*)(F.lds + RING_OFF + F.wave * 16384);
    constexpr int I_F1 = (4096 / 64) * (16384 / 32), I_F2 = (16384 / 64) * (4096 / 32);
    conv_run<1>(inp(27), inp(28), nullptr, nullptr, F.ws, I_F1 + I_F2, gw, NGW, scr, lane);
}
__device__ __forceinline__ void p12_rowpass(Frame& F) {
    const int gw = F.vcu * NWAVES + F.wave, NGW = F.G * NWAVES, lane = F.lane; const float* par = (const float*)(F.ws + WS_PAR);
    const bf16* ab = (const bf16*)(F.ws + WS_A); const float* ostat = (const float*)(F.ws + WS_OSTAT);
    for (int m = gw; m < NROW; m += NGW) { const int cd = cond_of_row(m);
        const float r1 = 1.0f / sqrtf(wave_sum(ostat[(size_t)m * 64 + lane]) * (1.0f / DM) + EPSN);
        const GAS f32x4* P5 = (const GAS f32x4*)(par + 5 * 20480 + cd * 4096) + lane; const GAS u32x2* o2 = (const GAS u32x2*)(ab + (size_t)m * DM) + lane;
        GAS f32x4* yo = (GAS f32x4*)(F.out + O_Y + (size_t)m * DM) + lane; const GAS u32x2* xo = (const GAS u32x2*)(F.out + O_Y + (size_t)m * DM + DM / 2) + lane;
        u32x2 xw[16], aw[16];
#pragma unroll
        for (int j = 0; j < 16; ++j) { xw[j] = xo[64 * j]; aw[j] = o2[64 * j]; }
        asm volatile("s_waitcnt vmcnt(0)" ::: "memory");
#pragma unroll
        for (int j = 0; j < 16; ++j) { const u32x2 w = aw[j], x = xw[j];
            const f32x4 o = (f32x4){__uint_as_float(w.x << 16), __uint_as_float(w.x & 0xffff0000u), __uint_as_float(w.y << 16), __uint_as_float(w.y & 0xffff0000u)};
            const f32x4 x1 = (f32x4){__uint_as_float(x.x << 16), __uint_as_float(x.x & 0xffff0000u), __uint_as_float(x.y << 16), __uint_as_float(x.y & 0xffff0000u)};
            yo[64 * j] = x1 + P5[64 * j] * o * r1; } }
}

struct Args { const float* in[30]; float* out; unsigned char* ws; };
__global__ void __launch_bounds__(NWAVES * 64, 2) mk_fwd(Args args) {
    extern __shared__ __attribute__((aligned(16))) unsigned char lds[];
    Frame F;
    F.lds = (LAS unsigned char*)lds;
    F.MISC = (volatile LAS unsigned*)(F.lds + MISC_OFF);
    F.tid = threadIdx.x; F.lane = F.tid & 63; F.wave = __builtin_amdgcn_readfirstlane(F.tid >> 6);
    F.G = gridDim.x; { const int bx = blockIdx.x; F.vcu = (F.G % 8 == 0) ? (bx % 8) * (F.G / 8) + bx / 8 : bx; }
    F.out = args.out; F.ws = args.ws;
    unsigned char* ws = args.ws;
    F.ctl = (gu32*)(ws + WS_CTL);
    for (int u = F.tid; u < (LDS_BYTES - LDSCTL_OFF) / 4; u += NWAVES * 64) ((LAS unsigned*)(F.lds + LDSCTL_OFF))[u] = 0u;
    __syncthreads();
    XcdBarrier bar = xcd_barrier_post((unsigned*)(F.ctl + CW_BAR), F.MISC + 8);
#define REFRESH() do { int t_ = threadIdx.x; asm volatile("" : "+v"(t_)); F.tid = t_; F.lane = t_ & 63; } while (0)
#define GRID_BAR() do { xcd_barrier(bar); REFRESH(); } while (0)
    typedef pg8::bf16_t bt;
    const int bx = (int)blockIdx.x;

    p0_prologue(F); GRID_BAR();
    p0b_modreduce(F); GRID_BAR();
    p1_modnorm(F); GRID_BAR();
    { pg8::Gemm g{(const bt*)(ws + WS_A), (const bt*)(ws + WS_WIN), 4096, 4096, 4096}; pg8::StaticOrder S; S.init(NROW, NIN, F.G, bx);
      pg8::EpiIn E{(bt*)(ws + WS_QRAW), (float*)(ws + WS_CKVRAW), (float*)(ws + WS_KRRAW), (bt*)(ws + WS_UH), (bt*)(ws + WS_GA), (bt*)(ws + WS_GB), (float*)(ws + WS_QSTAT), (float*)(ws + WS_KVSTAT)};
      pg8::gemm_phase<pg8::EpiIn, pg8::StaticOrder, true, true>(F.lds + RING_OFF, g, S, E); }
    GRID_BAR();
    p3_rowpass(F); __syncthreads(); REFRESH();
    { pg8::Gemm g{(const bt*)(ws + WS_UH), (const bt*)(ws + WS_MSTATE), 512, 256, 256}; pg8::GroupOrder S{768, 6, F.G, bx};
      pg8::EpiS E{(float*)(ws + WS_A)};
      pg8::gemm_phase<pg8::EpiS, pg8::GroupOrder, true, true>(F.lds + RING_OFF, g, S, E); }
    GRID_BAR();
    p4b_scan(F); GRID_BAR();
    { pg8::Gemm g{(const bt*)(ws + WS_UH), (const bt*)(ws + WS_MCAT), 512, 512, 512}; pg8::GroupOrder S{768, 6, F.G, bx};
      pg8::EpiY E{(bt*)(ws + WS_YG)};
      pg8::gemm_phase<pg8::EpiY, pg8::GroupOrder, true, true>(F.lds + RING_OFF, g, S, E); }
    GRID_BAR();
    { pg8::Gemm g{(const bt*)(ws + WS_QN), (const bt*)(ws + WS_WUQ), 1024, 1024, 1024}; pg8::StaticOrder S; S.init(NROW, 6144, F.G, bx);
      pg8::EpiQ E{(bt*)(ws + WS_Q), (const float*)(ws + WS_TAB), QSCALE};
      pg8::gemm_phase<pg8::EpiQ, pg8::StaticOrder, true, true>(F.lds + RING_OFF, g, S, E); }
    { pg8::Gemm g{(const bt*)(ws + WS_CKVN), (const bt*)(ws + WS_WUKV), 512, 512, 512}; pg8::StaticOrder S; S.init(NKEY, 8192, F.G, bx);
      pg8::EpiBf E{(bt*)(ws + WS_KV), 8192};
      pg8::gemm_phase<pg8::EpiBf, pg8::StaticOrder, true, true>(F.lds + RING_OFF, g, S, E); }
    GRID_BAR();
    { const att::bf16* Q = (const att::bf16*)(ws + WS_Q); const att::bf16* KV = (const att::bf16*)(ws + WS_KV); const att::bf16* KR = (const att::bf16*)(ws + WS_KR);
      const att::bf16* GA = (const att::bf16*)(ws + WS_GA); att::bf16* MO = (att::bf16*)(ws + WS_A);
      for (int u = F.vcu; u < 3072; u += F.G) {
          int h, qrow0, krow0, seq;
          if (u < 2048) { const int bh = u >> 4, qb = u & 15, b = bh >> 5; h = bh & 31; qrow0 = NPR + b * 4096 + qb * 256; krow0 = NPR + b * 4608; seq = 4608; }
          else { const int v = u - 2048, b = v >> 5; h = v & 31; qrow0 = b * 256; krow0 = b * 256; seq = 256; }
          att::attn_unit(Q + (size_t)qrow0 * 6144 + h * 128, Q + (size_t)qrow0 * 6144 + 4096 + h * 64, KV + (size_t)krow0 * 8192 + h * 256, KV + (size_t)krow0 * 8192 + h * 256 + 128,
                         KR + (size_t)krow0 * 64, GA + (size_t)qrow0 * 4096 + h * 128, MO + (size_t)qrow0 * 4096 + h * 128, seq, (char*)lds + RING_OFF);
      }
      }
    GRID_BAR();
    { pg8::Gemm g{(const bt*)(ws + WS_YG), (const bt*)(ws + WS_WGLU), 2048, 2048, 2048}; pg8::StaticOrder S; S.init(NROW, 8192, F.G, bx);
      pg8::EpiGlu E{(bt*)(ws + WS_A), (const bt*)(ws + WS_GB)};
      pg8::gemm_phase<pg8::EpiGlu, pg8::StaticOrder, true, true>(F.lds + RING_OFF, g, S, E); }
    GRID_BAR();
    { pg8::Gemm g{(const bt*)(ws + WS_A), (const bt*)(ws + WS_WOUT), 4096, 4096, 4096}; pg8::StaticOrder S; S.init(NROW, 4096, F.G, bx);
      pg8::EpiStat E{(bt*)(ws + WS_OUTB), (float*)(ws + WS_OSTAT)};
      pg8::gemm_phase<pg8::EpiStat, pg8::StaticOrder, true, true>(F.lds + RING_OFF, g, S, E); }
    GRID_BAR();
    p9_rowpass(F); GRID_BAR();
    { pg8::Gemm g{(const bt*)(ws + WS_A), (const bt*)(ws + WS_WFF1), 4096, 4096, 4096}; pg8::StaticOrder S; S.init(NROW, 16384, F.G, bx);
      pg8::EpiRelu2 E{(bt*)(ws + WS_A1)};
      pg8::gemm_phase<pg8::EpiRelu2, pg8::StaticOrder, true, true>(F.lds + RING_OFF, g, S, E);
    }
    GRID_BAR();
    { pg8::Gemm g{(const bt*)(ws + WS_A1), (const bt*)(ws + WS_WFF2), 16384, 16384, 16384}; pg8::StaticOrder S; S.init(NROW, 4096, F.G, bx);
      pg8::EpiStat E{(bt*)(ws + WS_A), (float*)(ws + WS_OSTAT)};
      pg8::gemm_phase<pg8::EpiStat, pg8::StaticOrder, true, true>(F.lds + RING_OFF, g, S, E); }
    GRID_BAR();
    p12_rowpass(F);
#undef GRID_BAR
#undef REFRESH
}

extern "C" void kernel_launch(void* const* d_in, const int* in_sizes, int n_in, void* d_out, int out_size, void* d_ws, size_t ws_size, hipStream_t stream) {
    static int grid = 0;
    if (grid == 0) {
        if (n_in != 30 || in_sizes[0] != NPR * DM || out_size != (int)O_END || ws_size < WS_END) { fprintf(stderr, "kernel_launch: shape mismatch (n_in %d, in0 %d, out %d, ws %zu; need ws >= %zu); nothing launched\n", n_in, n_in > 0 ? in_sizes[0] : -1, out_size, ws_size, (size_t)WS_END); grid = -1; return; }
        int dev = 0, cus = 0, per_cu = 0;
        if (hipGetDevice(&dev) != hipSuccess || hipDeviceGetAttribute(&cus, hipDeviceAttributeMultiprocessorCount, dev) != hipSuccess) { grid = -1; return; }
        if (hipFuncSetAttribute((const void*)mk_fwd, hipFuncAttributeMaxDynamicSharedMemorySize, LDS_BYTES) != hipSuccess) { fprintf(stderr, "kernel_launch: hipFuncSetAttribute failed\n"); grid = -1; return; }
        if (hipOccupancyMaxActiveBlocksPerMultiprocessor(&per_cu, (const void*)mk_fwd, NWAVES * 64, LDS_BYTES) != hipSuccess || per_cu < 1) { fprintf(stderr, "kernel_launch: occupancy query reports %d workgroups per CU\n", per_cu); }
        (void)hipGetLastError();
        grid = cus;
    }
    if (grid < 0) return;
    if (hipMemsetAsync((char*)d_ws + WS_CTL, 0, CTL_ZERO_BYTES, stream) != hipSuccess) return;
    Args a{};
    for (int i = 0; i < 30; ++i) a.in[i] = (const float*)d_in[i];
    a.out = (float*)d_out; a.ws = (unsigned char*)d_ws;
    hipLaunchKernelGGL(mk_fwd, dim3(grid), dim3(NWAVES * 64), LDS_BYTES, stream, a);
    const hipError_t le = hipPeekAtLastError();
    if (le != hipSuccess) fprintf(stderr, "kernel_launch: launch failed: %s\n", hipGetErrorName(le));
}
```

```cpp
#include <hip/hip_runtime.h>
#include <cstdio>
#include <cstdint>
namespace pg8 {
#define PG8_LAS __attribute__((address_space(3)))
typedef unsigned short bf16_t;
typedef short bf16x8 __attribute__((ext_vector_type(8)));
typedef float f32x4 __attribute__((ext_vector_type(4)));
typedef unsigned u32x4 __attribute__((ext_vector_type(4)));
constexpr int BM = 256, BK = 64, HALF = 128, HTB = HALF * BK * 2  , STAGE_BYTES = 8 * HTB, NXCD = 8, WGM = 4;

__host__ __device__ __forceinline__ int lds_byte(int r, int c) { const int st = (r >> 4) * 2 + (c >> 5), rr = r & 15, cc = c & 31, ob = rr * 64 + cc * 2; return st * 1024 + (ob ^ (((ob >> 9) & 1) << 5)); }
__host__ __device__ __forceinline__ void stage_rc(int b, int& R, int& C) { const int st = b / 1024, sb = b % 1024, swz = sb ^ (((sb >> 9) & 1) << 5); R = (st >> 1) * 16 + swz / 64; C = (st & 1) * 32 + (swz % 64) / 2; }
__host__ __device__ __forceinline__ int perm32(int rho) { const int n = rho >> 4, i = rho & 15; return 8 * (i >> 2) + 4 * n + (i & 3); }

struct Unit { int pm, pn; };
struct Gemm { const bf16_t* A; const bf16_t* Bt; int lda, ldb, K; };

struct StaticOrder {
    int nM, nN, nwg, G, c;
    __host__ __device__ void init(int M, int N, int G_, int c_) { nM = M / BM; nN = N / BM; nwg = nM * nN; G = G_; c = c_; }
    __host__ __device__ bool next(int i, Unit& u) const {
        const long L = (long)i * G + c; if (L >= nwg) return false;
        int wgid = (int)L; { const int q = nwg / NXCD, r = nwg % NXCD, xcd = wgid % NXCD, off = wgid / NXCD; wgid = (xcd < r ? xcd * (q + 1) : r * (q + 1) + (xcd - r) * q) + off; }
        const int nig = WGM * nN, gid = wgid / nig, fm = gid * WGM, gsz = (nM - fm) < WGM ? (nM - fm) : WGM;
        u.pm = fm + ((wgid % nig) % gsz); u.pn = (wgid % nig) / gsz; return true;
    }
    __device__ __forceinline__ void a_ready(const Unit&) const {}
    __device__ __forceinline__ void done(const Unit&) const {}
};
struct GroupOrder {
    int nunits, per, G, c;
    __device__ bool next(int i, Unit& u) const { const int L = i * G + c; if (L >= nunits) return false; u.pm = L; u.pn = L / per; return true; }
    __device__ __forceinline__ void a_ready(const Unit&) const {}
    __device__ __forceinline__ void done(const Unit&) const {}
};

struct PairOrder {
    int nM, c;
    __device__ bool next(int i, Unit& u) const { if (i * 16 >= nM) return false; const int xcd = c & 7, j = c >> 3; u.pm = 16 * i + 4 * (xcd >> 1) + (j & 3); u.pn = (xcd & 1) * 8 + (j >> 2); return true; }
    __device__ __forceinline__ void a_ready(const Unit&) const {}
    __device__ __forceinline__ void done(const Unit&) const {}
};

__device__ __forceinline__ unsigned cvt_pk_bf16(float lo, float hi) { unsigned r; asm volatile("v_cvt_pk_bf16_f32 %0, %1, %2" : "=v"(r) : "v"(lo), "v"(hi)); return r; }
__device__ __forceinline__ u32x4 pack8(const f32x4 a, const f32x4 b) { u32x4 w; w.x = cvt_pk_bf16(a[0], a[1]); w.y = cvt_pk_bf16(a[2], a[3]); w.z = cvt_pk_bf16(b[0], b[1]); w.w = cvt_pk_bf16(b[2], b[3]); return w; }
__device__ __forceinline__ float bflo(unsigned w) { return __uint_as_float(w << 16); }
__device__ __forceinline__ float bfhi(unsigned w) { return __uint_as_float(w & 0xffff0000u); }
__device__ __forceinline__ float sigm(float x) { return __builtin_amdgcn_rcpf(1.0f + __builtin_amdgcn_exp2f(-1.4426950408889634f * x)); }
__device__ __forceinline__ float gelu_tanh(float y) { return y * sigm(1.5957691216057308f * (y + 0.044715f * y * y * y)); }
__device__ __forceinline__ float sumsq8(const f32x4 a, const f32x4 b) { return (a[0] * a[0] + a[1] * a[1]) + (a[2] * a[2] + a[3] * a[3]) + (b[0] * b[0] + b[1] * b[1]) + (b[2] * b[2] + b[3] * b[3]); }

struct EpiIn {
    static constexpr bool PERM = true, AFTER_DRAIN = false;
    bf16_t* qraw; float* ckvraw; float* krraw; bf16_t* UH; bf16_t* ga; bf16_t* gb; float* qstat; float* kvstat;
    __device__ __forceinline__ void operator()(const f32x4 (&acc)[2][2][4][2], const Unit& u, int wr, int wc, int fr, int fq) const {
        asm volatile("" : "+v"(fr), "+v"(fq));
        const int row0 = u.pm * BM + wr * 64 + fr, colL = wc * 32 + 8 * fq, pn = u.pn;
        if (pn < 4) {
#pragma unroll
            for (int ai = 0; ai < 2; ++ai)
#pragma unroll
                for (int m = 0; m < 4; ++m) { const int row = row0 + ai * HALF + m * 16; float ss = 0.f;
#pragma unroll
                    for (int bj = 0; bj < 2; ++bj) { const f32x4 a = acc[ai][bj][m][0], b = acc[ai][bj][m][1]; ss += sumsq8(a, b);
                        *(u32x4*)(qraw + (size_t)row * 1024 + pn * 256 + bj * HALF + colL) = pack8(a, b); }
                    ss += __shfl_xor(ss, 16); ss += __shfl_xor(ss, 32);
                    if (fq == 0) qstat[row * 16 + pn * 4 + wc] = ss; }
        } else if (pn < 6) {
            const int t = pn - 4;
#pragma unroll
            for (int ai = 0; ai < 2; ++ai)
#pragma unroll
                for (int m = 0; m < 4; ++m) { const int row = row0 + ai * HALF + m * 16; float ss = 0.f;
#pragma unroll
                    for (int bj = 0; bj < 2; ++bj) { const f32x4 a = acc[ai][bj][m][0], b = acc[ai][bj][m][1]; ss += sumsq8(a, b);
                        float* p = ckvraw + (size_t)row * 512 + t * 256 + bj * HALF + colL; *(f32x4*)p = a; *(f32x4*)(p + 4) = b; }
                    ss += __shfl_xor(ss, 16); ss += __shfl_xor(ss, 32);
                    if (fq == 0) kvstat[row * 8 + t * 4 + wc] = ss; }
        } else if (pn < 14) {
            const int t = pn - 6;
#pragma unroll
            for (int ai = 0; ai < 2; ++ai)
#pragma unroll
                for (int m = 0; m < 4; ++m) { const int row = row0 + ai * HALF + m * 16;
#pragma unroll
                    for (int bj = 0; bj < 2; ++bj) { const int col = t * 256 + bj * HALF + colL, g = col >> 4, j0 = col & 15;
                        *(u32x4*)(UH + ((size_t)g * 1536 + (row >> 4)) * 512 + (row & 15) * 16 + j0) = pack8(acc[ai][bj][m][0], acc[ai][bj][m][1]); } }
        } else if (pn < 46) {
            bf16_t* dst = pn < 30 ? ga + (pn - 14) * 256 : gb + (pn - 30) * 256;
#pragma unroll
            for (int ai = 0; ai < 2; ++ai)
#pragma unroll
                for (int m = 0; m < 4; ++m) { const int row = row0 + ai * HALF + m * 16;
#pragma unroll
                    for (int bj = 0; bj < 2; ++bj) *(u32x4*)(dst + (size_t)row * 4096 + bj * HALF + colL) = pack8(acc[ai][bj][m][0], acc[ai][bj][m][1]); }
        } else {
            if (wc < 2) {
#pragma unroll
                for (int ai = 0; ai < 2; ++ai)
#pragma unroll
                    for (int m = 0; m < 4; ++m) { const int row = row0 + ai * HALF + m * 16; float* p = krraw + (size_t)row * 64 + colL;
                        *(f32x4*)p = acc[ai][0][m][0]; *(f32x4*)(p + 4) = acc[ai][0][m][1]; }
            }
        }
    }
};
struct EpiBf {
    static constexpr bool PERM = true, AFTER_DRAIN = false;
    bf16_t* O; int ldc;
    __device__ __forceinline__ void operator()(const f32x4 (&acc)[2][2][4][2], const Unit& u, int wr, int wc, int fr, int fq) const {
        asm volatile("" : "+v"(fr), "+v"(fq));
        const int row0 = u.pm * BM + wr * 64 + fr, col0 = u.pn * BM + wc * 32 + 8 * fq;
#pragma unroll
        for (int ai = 0; ai < 2; ++ai)
#pragma unroll
            for (int m = 0; m < 4; ++m) { bf16_t* rowp = O + (size_t)(row0 + ai * HALF + m * 16) * ldc + col0;
#pragma unroll
                for (int bj = 0; bj < 2; ++bj) *(u32x4*)(rowp + bj * HALF) = pack8(acc[ai][bj][m][0], acc[ai][bj][m][1]); }
    }
};
struct EpiQ {
    static constexpr bool PERM = true, AFTER_DRAIN = false;
    bf16_t* Q; const float* tab; float c2;
    __device__ __forceinline__ void operator()(const f32x4 (&acc)[2][2][4][2], const Unit& u, int wr, int wc, int fr, int fq) const {
        asm volatile("" : "+v"(fr), "+v"(fq));
        const int row0 = u.pm * BM + wr * 64 + fr, col0 = u.pn * BM + wc * 32 + 8 * fq;
        const bool rope = (u.pn >= 16) && (u.pm >= 32);
#pragma unroll
        for (int ai = 0; ai < 2; ++ai)
#pragma unroll
            for (int m = 0; m < 4; ++m) { const int row = row0 + ai * HALF + m * 16; bf16_t* rowp = Q + (size_t)row * 6144 + col0;
#pragma unroll
                for (int bj = 0; bj < 2; ++bj) { f32x4 a = acc[ai][bj][m][0], b = acc[ai][bj][m][1];
                    if (rope) { const int t = (row - 8192) & 4095, p0 = ((col0 + bj * HALF - 4096) & 63) >> 1;
                        const f32x4 cs0 = *(const f32x4*)(tab + ((size_t)t * 32 + p0) * 2), cs1 = *(const f32x4*)(tab + ((size_t)t * 32 + p0 + 2) * 2);
                        f32x4 ra, rb;
                        ra[0] = a[0] * cs0[0] - a[1] * cs0[1]; ra[1] = a[1] * cs0[0] + a[0] * cs0[1]; ra[2] = a[2] * cs0[2] - a[3] * cs0[3]; ra[3] = a[3] * cs0[2] + a[2] * cs0[3];
                        rb[0] = b[0] * cs1[0] - b[1] * cs1[1]; rb[1] = b[1] * cs1[0] + b[0] * cs1[1]; rb[2] = b[2] * cs1[2] - b[3] * cs1[3]; rb[3] = b[3] * cs1[2] + b[2] * cs1[3];
                        a = ra; b = rb; }
                    *(u32x4*)(rowp + bj * HALF) = pack8(a * c2, b * c2); } }
    }
};
struct EpiS {
    static constexpr bool PERM = false, AFTER_DRAIN = false;
    float* S;
    __device__ __forceinline__ void operator()(const f32x4 (&acc)[2][2][4][2], const Unit& u, int wr, int wc, int fr, int fq) const {
        asm volatile("" : "+v"(fr), "+v"(fq));
        const int row0 = u.pm * BM + wr * 64 + fr, col0 = wc * 32 + 4 * fq;
#pragma unroll
        for (int ai = 0; ai < 2; ++ai)
#pragma unroll
            for (int m = 0; m < 4; ++m) { float* rowp = S + (size_t)(row0 + ai * HALF + m * 16) * 256 + col0;
#pragma unroll
                for (int bj = 0; bj < 2; ++bj)
#pragma unroll
                    for (int n = 0; n < 2; ++n) *(f32x4*)(rowp + bj * HALF + n * 16) = acc[ai][bj][m][n]; }
    }
};
struct EpiY {
    static constexpr bool PERM = true, AFTER_DRAIN = false;
    bf16_t* Yg;
    __device__ __forceinline__ void operator()(const f32x4 (&acc)[2][2][4][2], const Unit& u, int wr, int wc, int fr, int fq) const {
        asm volatile("" : "+v"(fr), "+v"(fq));
        const int g = u.pn, c0 = (u.pm - 6 * g) * BM + wr * 64 + fr, n0 = wc * 32 + 8 * fq;
#pragma unroll
        for (int ai = 0; ai < 2; ++ai)
#pragma unroll
            for (int m = 0; m < 4; ++m) { const int c = c0 + ai * HALF + m * 16;
#pragma unroll
                for (int bj = 0; bj < 2; ++bj) { const int nn = bj * HALF + n0, tau = nn >> 4, j0 = nn & 15; f32x4 a = acc[ai][bj][m][0], b = acc[ai][bj][m][1];
#pragma unroll
                    for (int e = 0; e < 4; ++e) { a[e] = gelu_tanh(a[e]); b[e] = gelu_tanh(b[e]); }
                    *(u32x4*)(Yg + (size_t)(c * 16 + tau) * 2048 + g * 16 + j0) = pack8(a, b); } }
    }
};
struct EpiGlu {
    static constexpr bool PERM = true, AFTER_DRAIN = false;
    bf16_t* M; const bf16_t* gb;
    __device__ __forceinline__ void operator()(const f32x4 (&acc)[2][2][4][2], const Unit& u, int wr, int wc, int fr, int fq) const {
        asm volatile("" : "+v"(fr), "+v"(fq));
        const int row0 = u.pm * BM + wr * 64 + fr, col0 = u.pn * HALF + wc * 32 + 8 * fq;
#pragma unroll
        for (int ai = 0; ai < 2; ++ai)
#pragma unroll
            for (int m = 0; m < 4; ++m) { const size_t off = (size_t)(row0 + ai * HALF + m * 16) * 4096 + col0;
                const u32x4 gv = *(const u32x4*)(gb + off), mv = *(const u32x4*)(M + off); f32x4 o0, o1;
#pragma unroll
                for (int e = 0; e < 4; ++e) { const unsigned gw = gv[e >> 1], mw = mv[e >> 1];
                    const float g = (e & 1) ? bfhi(gw) : bflo(gw), ma = (e & 1) ? bfhi(mw) : bflo(mw);
                    o0[e] = sigm(g) * (acc[ai][0][m][0][e] * sigm(acc[ai][1][m][0][e])) + ma; }
#pragma unroll
                for (int e = 0; e < 4; ++e) { const unsigned gw = gv[2 + (e >> 1)], mw = mv[2 + (e >> 1)];
                    const float g = (e & 1) ? bfhi(gw) : bflo(gw), ma = (e & 1) ? bfhi(mw) : bflo(mw);
                    o1[e] = sigm(g) * (acc[ai][0][m][1][e] * sigm(acc[ai][1][m][1][e])) + ma; }
                *(u32x4*)(M + off) = pack8(o0, o1); }
    }
};
struct EpiStat {
    static constexpr bool PERM = true, AFTER_DRAIN = false;
    bf16_t* O; float* stat;
    __device__ __forceinline__ void operator()(const f32x4 (&acc)[2][2][4][2], const Unit& u, int wr, int wc, int fr, int fq) const {
        asm volatile("" : "+v"(fr), "+v"(fq));
        const int row0 = u.pm * BM + wr * 64 + fr, col0 = u.pn * BM + wc * 32 + 8 * fq;
#pragma unroll
        for (int ai = 0; ai < 2; ++ai)
#pragma unroll
            for (int m = 0; m < 4; ++m) { const int row = row0 + ai * HALF + m * 16; float ss = 0.f;
#pragma unroll
                for (int bj = 0; bj < 2; ++bj) { const f32x4 a = acc[ai][bj][m][0], b = acc[ai][bj][m][1]; ss += sumsq8(a, b);
                    *(u32x4*)(O + (size_t)row * 4096 + col0 + bj * HALF) = pack8(a, b); }
                ss += __shfl_xor(ss, 16); ss += __shfl_xor(ss, 32);
                if (fq == 0) stat[row * 64 + u.pn * 4 + wc] = ss; }
    }
};
struct EpiRelu2 {
    static constexpr bool PERM = true, AFTER_DRAIN = false;
    bf16_t* O;
    __device__ __forceinline__ void operator()(const f32x4 (&acc)[2][2][4][2], const Unit& u, int wr, int wc, int fr, int fq) const {
        asm volatile("" : "+v"(fr), "+v"(fq));
        const int row0 = u.pm * BM + wr * 64 + fr, col0 = u.pn * BM + wc * 32 + 8 * fq;
#pragma unroll
        for (int ai = 0; ai < 2; ++ai)
#pragma unroll
            for (int m = 0; m < 4; ++m) { bf16_t* rowp = O + (size_t)(row0 + ai * HALF + m * 16) * 16384 + col0;
#pragma unroll
                for (int bj = 0; bj < 2; ++bj) { f32x4 a = acc[ai][bj][m][0], b = acc[ai][bj][m][1];
#pragma unroll
                    for (int e = 0; e < 4; ++e) { const float x = fmaxf(a[e], 0.f), y = fmaxf(b[e], 0.f); a[e] = x * x; b[e] = y * y; }
                    *(u32x4*)(rowp + bj * HALF) = pack8(a, b); } }
    }
};

template <class Epi, class Sched, bool ALIGN_EPI = false, bool SP2 = false>
__device__ __forceinline__ void gemm_phase(PG8_LAS unsigned char* lds, const Gemm g, const Sched& S, const Epi& E) {
    int tid_ = threadIdx.x; asm volatile("" : "+v"(tid_));
    const int tid = tid_, wid = __builtin_amdgcn_readfirstlane(tid >> 6), lane = tid & 63, wr = wid >> 2, wc = wid & 3, fr = lane & 15, fq = lane >> 4;
    const int K = g.K, nt = K / BK, lda = g.lda, ldb = g.ldb;
    unsigned voffA[2], voffB[2];
#pragma unroll
    for (int i = 0; i < 2; ++i) { int R, C; stage_rc(tid * 16 + i * 8192, R, C); const int Rb = Epi::PERM ? ((R & ~31) + perm32(R & 31)) : R;
        voffA[i] = (unsigned)(R * lda + C) * 2u; voffB[i] = (unsigned)(Rb * ldb + C) * 2u; }
    const size_t kstep = (size_t)(BK * 2);
    const size_t hstepA = (size_t)HALF * lda * 2, hstepB = (size_t)HALF * ldb * 2;
    const size_t tstepA = 2 * hstepA, tstepB = 2 * hstepB;
    const unsigned ldsw = (unsigned)wid * 1024u;
    const int aoff = lds_byte(wr * 64 + fr, fq * 8), boff = lds_byte(wc * 32 + fr, fq * 8);
#define PG8_SA(b, h) (((b) * 2 + (h)) * HTB)
#define PG8_SB(b, h) ((4 + (b) * 2 + (h)) * HTB)
#define PG8_STAGE(bufoff, gbase, voff) do { _Pragma("unroll") for (int _i = 0; _i < 2; ++_i) \
        __builtin_amdgcn_global_load_lds((const unsigned*)((const char*)(gbase) + (voff)[_i]), (PG8_LAS unsigned*)(lds + (bufoff) + ldsw + _i * 8192), 16, 0, 0); } while (0)
#define PG8_LDA(dst, b, h) do { _Pragma("unroll") for (int m = 0; m < 4; ++m) _Pragma("unroll") for (int k = 0; k < 2; ++k) dst[m][k] = *(const PG8_LAS bf16x8*)(lds + PG8_SA(b, h) + aoff + m * 2048 + k * 1024); } while (0)
#define PG8_LDB(dst, b, h) do { _Pragma("unroll") for (int n = 0; n < 2; ++n) _Pragma("unroll") for (int k = 0; k < 2; ++k) dst[n][k] = *(const PG8_LAS bf16x8*)(lds + PG8_SB(b, h) + boff + n * 2048 + k * 1024); } while (0)
#define PG8_MMA(ai, bj, At, Bt) do { __builtin_amdgcn_s_setprio(1); _Pragma("unroll") for (int m = 0; m < 4; ++m) _Pragma("unroll") for (int n = 0; n < 2; ++n) _Pragma("unroll") for (int k = 0; k < 2; ++k) \
        acc[ai][bj][m][n] = __builtin_amdgcn_mfma_f32_16x16x32_bf16(Bt[n][k], At[m][k], acc[ai][bj][m][n], 0, 0, 0); __builtin_amdgcn_s_setprio(0); } while (0)
#define PG8_WAIT_V(n) asm volatile("s_waitcnt vmcnt(" #n ")" ::: "memory")
#define PG8_WAIT_L(n) asm volatile("s_waitcnt lgkmcnt(" #n ")" ::: "memory")
#define PG8_BAR __builtin_amdgcn_s_barrier()
#define PG8_SCHED __builtin_amdgcn_sched_barrier(0)
    Unit cur, nxt; int ui = 0;
    if (!S.next(0, cur)) return;
    f32x4 acc[2][2][4][2];
#pragma unroll
    for (int a = 0; a < 2; ++a)
#pragma unroll
        for (int b = 0; b < 2; ++b)
#pragma unroll
            for (int m = 0; m < 4; ++m)
#pragma unroll
                for (int n = 0; n < 2; ++n) acc[a][b][m][n] = (f32x4){0.f, 0.f, 0.f, 0.f};
    bf16x8 At[4][2], B0[2][2], B1[2][2];
    const char* cA = (const char*)g.A + (size_t)cur.pm * tstepA; const char* cB = (const char*)g.Bt + (size_t)cur.pn * tstepB;
    S.a_ready(cur);
    if constexpr (SP2) {
        PG8_STAGE(PG8_SB(0, 0), cB, voffB); PG8_STAGE(PG8_SB(0, 1), cB + hstepB, voffB); PG8_STAGE(PG8_SA(0, 0), cA, voffA); PG8_STAGE(PG8_SA(0, 1), cA + hstepA, voffA);
        if (wr == 1) PG8_BAR;
        PG8_WAIT_V(2); PG8_BAR;
        PG8_STAGE(PG8_SB(1, 0), cB + kstep, voffB); PG8_STAGE(PG8_SA(1, 0), cA + kstep, voffA); PG8_STAGE(PG8_SB(1, 1), cB + hstepB + kstep, voffB);
        PG8_WAIT_V(6); PG8_BAR;
    } else {
        PG8_STAGE(PG8_SB(0, 0), cB, voffB); PG8_STAGE(PG8_SA(0, 0), cA, voffA); PG8_STAGE(PG8_SB(0, 1), cB + hstepB, voffB); PG8_STAGE(PG8_SA(0, 1), cA + hstepA, voffA);
        if (wr == 1) PG8_BAR;
        PG8_WAIT_V(4); PG8_BAR;
        PG8_STAGE(PG8_SB(1, 0), cB + kstep, voffB); PG8_STAGE(PG8_SA(1, 0), cA + kstep, voffA); PG8_STAGE(PG8_SB(1, 1), cB + hstepB + kstep, voffB);
        PG8_WAIT_V(6); PG8_BAR;
    }
    for (;;) {
        const bool has_next = S.next(ui + 1, nxt);
        const char* nA = has_next ? (const char*)g.A + (size_t)nxt.pm * tstepA : cA; const char* nB = has_next ? (const char*)g.Bt + (size_t)nxt.pn * tstepB : cB;
        for (int t = 0; t < nt; t += 2) {
            const bool last = (t == nt - 2);
            const char* a1 = cA + (size_t)(t + 1) * kstep;
            const char* a2 = last ? nA : cA + (size_t)(t + 2) * kstep; const char* b2 = last ? nB : cB + (size_t)(t + 2) * kstep;
            const char* a3 = a2 + kstep; const char* b3 = b2 + kstep;
            if (last && has_next) S.a_ready(nxt);
            if constexpr (SP2) {
            PG8_LDB(B0, 0, 0); PG8_LDB(B1, 0, 1); PG8_SCHED; PG8_LDA(At, 0, 0); PG8_STAGE(PG8_SA(1, 1), a1 + hstepA, voffA);
            PG8_WAIT_V(8); PG8_WAIT_L(0); PG8_BAR; PG8_MMA(0, 0, At, B0); PG8_MMA(0, 1, At, B1); PG8_BAR; PG8_SCHED;
            PG8_LDA(At, 0, 1); PG8_STAGE(PG8_SB(0, 0), b2, voffB); PG8_STAGE(PG8_SB(0, 1), b2 + hstepB, voffB); PG8_STAGE(PG8_SA(0, 0), a2, voffA);
            PG8_WAIT_V(8); PG8_WAIT_L(0); PG8_BAR; PG8_MMA(1, 0, At, B0); PG8_MMA(1, 1, At, B1); PG8_BAR; PG8_SCHED;
            PG8_LDB(B0, 1, 0); PG8_LDB(B1, 1, 1); PG8_SCHED; PG8_LDA(At, 1, 0); PG8_STAGE(PG8_SA(0, 1), a2 + hstepA, voffA);
            PG8_WAIT_V(8); PG8_WAIT_L(0); PG8_BAR; PG8_MMA(0, 0, At, B0); PG8_MMA(0, 1, At, B1); PG8_BAR; PG8_SCHED;
            PG8_LDA(At, 1, 1); PG8_STAGE(PG8_SB(1, 0), b3, voffB); PG8_STAGE(PG8_SB(1, 1), b3 + hstepB, voffB); PG8_STAGE(PG8_SA(1, 0), a3, voffA);
            PG8_WAIT_V(8); PG8_WAIT_L(0); PG8_BAR; PG8_MMA(1, 0, At, B0); PG8_MMA(1, 1, At, B1); PG8_BAR; PG8_SCHED;
            } else {
            PG8_LDB(B0, 0, 0); PG8_SCHED; PG8_LDA(At, 0, 0); PG8_STAGE(PG8_SA(1, 1), a1 + hstepA, voffA);
            PG8_WAIT_L(8); PG8_BAR; PG8_WAIT_L(0); PG8_MMA(0, 0, At, B0); PG8_BAR; PG8_SCHED;
            PG8_LDB(B1, 0, 1); PG8_STAGE(PG8_SB(0, 0), b2, voffB);
            PG8_BAR; PG8_WAIT_L(0); PG8_MMA(0, 1, At, B1); PG8_BAR;
            PG8_LDA(At, 0, 1); PG8_STAGE(PG8_SA(0, 0), a2, voffA);
            PG8_BAR; PG8_WAIT_L(0); PG8_MMA(1, 0, At, B0); PG8_BAR; PG8_SCHED;
            PG8_STAGE(PG8_SB(0, 1), b2 + hstepB, voffB);
            PG8_WAIT_V(6); PG8_BAR; PG8_MMA(1, 1, At, B1); PG8_BAR;
            PG8_LDB(B0, 1, 0); PG8_SCHED; PG8_LDA(At, 1, 0); PG8_STAGE(PG8_SA(0, 1), a2 + hstepA, voffA);
            PG8_WAIT_L(8); PG8_BAR; PG8_WAIT_L(0); PG8_MMA(0, 0, At, B0); PG8_BAR; PG8_SCHED;
            PG8_LDB(B1, 1, 1); PG8_STAGE(PG8_SB(1, 0), b3, voffB);
            PG8_BAR; PG8_WAIT_L(0); PG8_MMA(0, 1, At, B1); PG8_BAR;
            PG8_LDA(At, 1, 1); PG8_STAGE(PG8_SA(1, 0), a3, voffA);
            PG8_BAR; PG8_WAIT_L(0); PG8_MMA(1, 0, At, B0); PG8_BAR; PG8_SCHED;
            PG8_STAGE(PG8_SB(1, 1), b3 + hstepB, voffB);
            PG8_WAIT_V(6); PG8_BAR; PG8_MMA(1, 1, At, B1); PG8_BAR;
            }
        }
        if constexpr (ALIGN_EPI) { if (wr == 0) PG8_BAR; }
        if constexpr (!Epi::AFTER_DRAIN) { E(acc, cur, wr, wc, fr, fq); S.done(cur); }
        if (!has_next) break;
#pragma unroll
        for (int a = 0; a < 2; ++a)
#pragma unroll
            for (int b = 0; b < 2; ++b)
#pragma unroll
                for (int m = 0; m < 4; ++m)
#pragma unroll
                    for (int n = 0; n < 2; ++n) acc[a][b][m][n] = (f32x4){0.f, 0.f, 0.f, 0.f};
        cur = nxt; cA = nA; cB = nB; ++ui;
        if constexpr (ALIGN_EPI) { if (wr == 1) PG8_BAR; }
    }
    PG8_WAIT_V(0);
    if constexpr (!ALIGN_EPI) { if (wr == 0) PG8_BAR; }
    PG8_BAR;
    if constexpr (Epi::AFTER_DRAIN) { E.fused(acc, cur, wr, wc, fr, fq, lds, wid, lane); S.done(cur); }
#undef PG8_SA
#undef PG8_SB
#undef PG8_STAGE
#undef PG8_LDA
#undef PG8_LDB
#undef PG8_MMA
#undef PG8_WAIT_V
#undef PG8_WAIT_L
#undef PG8_BAR
#undef PG8_SCHED
}
}

namespace att {
using bf16x8 = __attribute__((ext_vector_type(8))) short;
using s16x4  = __attribute__((ext_vector_type(4))) short;
using f32x16 = __attribute__((ext_vector_type(16))) float;
using u32x4  = __attribute__((ext_vector_type(4))) unsigned;
typedef unsigned short bf16;
#ifndef ATT_SDEPTH
#define ATT_SDEPTH 1
#endif
constexpr int NW = 8, QBLK = 32, KVBLK = 64;
constexpr int SHM_V = 16384, SHM_K = 16384, SHM_R = 8192;
constexpr int OFF_V = 0, OFF_K = 2 * SHM_V, OFF_R = OFF_K + 2 * SHM_K, OFF_WS = OFF_R + 2 * SHM_R, ATT_LDS = OFF_WS + NW * 256;
constexpr int LDQ = 6144, LDK = 8192, LDR = 64, LDO = 4096;
constexpr float THR_L2 = 11.5415603f;
#define KSWZ(row, colB) ((row) * 256 + ((colB) ^ (((row) & 15) << 4)))
#define RSWZ(row, colB) ((row) * 128 + ((colB) ^ ((((row) >> 1) & 7) << 4)))
#define SBAR() __builtin_amdgcn_sched_barrier(0)
__device__ __forceinline__ int crow(int r, int hi) { return (r & 3) + 8 * (r >> 2) + 4 * hi; }
__device__ __forceinline__ unsigned cvtpk(float lo, float hi) { unsigned r; asm volatile("v_cvt_pk_bf16_f32 %0, %1, %2" : "=v"(r) : "v"(lo), "v"(hi)); return r; }
__device__ __forceinline__ bf16x8 ld8(const bf16* p) { return *reinterpret_cast<const bf16x8*>(p); }

__device__ __forceinline__ void partialSM(f32x16& p0, f32x16& p1, float& m_reg, float& mn, float& alpha) {
  float pmax = p0[0];
#pragma unroll
  for (int r = 1; r < 16; ++r) pmax = fmaxf(pmax, p0[r]);
#pragma unroll
  for (int r = 0; r < 16; ++r) pmax = fmaxf(pmax, p1[r]);
  { auto rr = __builtin_amdgcn_permlane32_swap(__float_as_uint(pmax), __float_as_uint(pmax), false, false);
    pmax = fmaxf(__uint_as_float(rr[0]), __uint_as_float(rr[1])); }
  if (__builtin_expect(__all(pmax - m_reg <= THR_L2), 1)) { mn = m_reg; alpha = 1.f; }
  else { mn = fmaxf(m_reg, pmax); alpha = __builtin_amdgcn_exp2f(m_reg - mn); m_reg = mn; }
#pragma unroll
  for (int r = 0; r < 16; ++r) p0[r] = p0[r] - mn;
#pragma unroll
  for (int r = 0; r < 16; ++r) p1[r] = p1[r] - mn;
#pragma unroll
  for (int r = 0; r < 16; ++r) p0[r] = __builtin_amdgcn_exp2f(p0[r]);
}
__device__ __forceinline__ void finishSM(f32x16& p0, f32x16& p1, float alpha, float& l_reg, bf16x8& pa0, bf16x8& pa1, bf16x8& pa2, bf16x8& pa3) {
#pragma unroll
  for (int r = 0; r < 16; ++r) p1[r] = __builtin_amdgcn_exp2f(p1[r]);
  float ps = 0;
#pragma unroll
  for (int r = 0; r < 16; ++r) ps += p0[r];
#pragma unroll
  for (int r = 0; r < 16; ++r) ps += p1[r];
  { auto rr = __builtin_amdgcn_permlane32_swap(__float_as_uint(ps), __float_as_uint(ps), false, false);
    ps = __uint_as_float(rr[0]) + __uint_as_float(rr[1]); }
  l_reg = l_reg * alpha + ps;
#define PK4(P, BASE, OUT) do { u32x4 w = {cvtpk(P[BASE + 0], P[BASE + 1]), cvtpk(P[BASE + 2], P[BASE + 3]), cvtpk(P[BASE + 4], P[BASE + 5]), cvtpk(P[BASE + 6], P[BASE + 7])}; OUT = *reinterpret_cast<bf16x8*>(&w); } while (0)
  PK4(p0, 0, pa0); PK4(p0, 8, pa1); PK4(p1, 0, pa2); PK4(p1, 8, pa3);
#undef PK4
}
__device__ __forceinline__ void qkt(f32x16& p0, f32x16& p1, const char* Ks, const char* Rs, const bf16x8* qn, const bf16x8* qr, int r32, int hi) {
  p0 = f32x16{}; p1 = f32x16{};
#pragma unroll
  for (int d0 = 0; d0 < 8; ++d0) { const int cb = (d0 * 16 + hi * 8) * 2;
    bf16x8 b0 = *reinterpret_cast<const bf16x8*>(Ks + KSWZ(r32, cb));
    bf16x8 b1 = *reinterpret_cast<const bf16x8*>(Ks + KSWZ(32 + r32, cb));
    p0 = __builtin_amdgcn_mfma_f32_32x32x16_bf16(b0, qn[d0], p0, 0, 0, 0);
    p1 = __builtin_amdgcn_mfma_f32_32x32x16_bf16(b1, qn[d0], p1, 0, 0, 0); }
#pragma unroll
  for (int d0 = 0; d0 < 4; ++d0) { const int cb = (d0 * 16 + hi * 8) * 2;
    bf16x8 b0 = *reinterpret_cast<const bf16x8*>(Rs + RSWZ(r32, cb));
    bf16x8 b1 = *reinterpret_cast<const bf16x8*>(Rs + RSWZ(32 + r32, cb));
    p0 = __builtin_amdgcn_mfma_f32_32x32x16_bf16(b0, qr[d0], p0, 0, 0, 0);
    p1 = __builtin_amdgcn_mfma_f32_32x32x16_bf16(b1, qr[d0], p1, 0, 0, 0); }
}
__device__ __forceinline__ int v_st(int k, int c) { const int kk = (k & ~0xC) | ((k & 4) << 1) | ((k & 8) >> 1); return ((kk >> 3) * 4 + (c >> 5)) * 512 + ((kk & 7) * 32 + (c & 31)) * 2; }
__device__ __forceinline__ int v_rd_base(int lane) { return ((lane & 3) << 3) | (((lane >> 2) & 3) << 6) | (((lane >> 4) & 1) << 5) | (((lane >> 5) & 1) << 8); }
constexpr int v_rd_off(int d0, int ks, int half) { return d0 * 512 + ks * 4096 + half * 2048; }
template <int OFF> __device__ __forceinline__ s16x4 tr_read(int vb) {
  s16x4 r; asm volatile("ds_read_b64_tr_b16 %0, %1 offset:%2" : "=&v"(r) : "v"(vb), "i"(OFF) : "memory"); return r;
}
template <int D0> __device__ __forceinline__ void pv_one(f32x16& od, int vb, bf16x8 pa0, bf16x8 pa1, bf16x8 pa2, bf16x8 pa3) {
  const s16x4 l0 = tr_read<v_rd_off(D0, 0, 0)>(vb), h0 = tr_read<v_rd_off(D0, 0, 1)>(vb), l1 = tr_read<v_rd_off(D0, 1, 0)>(vb), h1 = tr_read<v_rd_off(D0, 1, 1)>(vb);
  const s16x4 l2 = tr_read<v_rd_off(D0, 2, 0)>(vb), h2 = tr_read<v_rd_off(D0, 2, 1)>(vb), l3 = tr_read<v_rd_off(D0, 3, 0)>(vb), h3 = tr_read<v_rd_off(D0, 3, 1)>(vb);
  asm volatile("s_waitcnt lgkmcnt(0)" ::: "memory"); SBAR();
#define PK(L, H) (bf16x8){L[0], L[1], L[2], L[3], H[0], H[1], H[2], H[3]}
  od = __builtin_amdgcn_mfma_f32_32x32x16_bf16(pa0, PK(l0, h0), od, 0, 0, 0);
  od = __builtin_amdgcn_mfma_f32_32x32x16_bf16(pa1, PK(l1, h1), od, 0, 0, 0);
  od = __builtin_amdgcn_mfma_f32_32x32x16_bf16(pa2, PK(l2, h2), od, 0, 0, 0);
  od = __builtin_amdgcn_mfma_f32_32x32x16_bf16(pa3, PK(l3, h3), od, 0, 0, 0);
#undef PK
}
__device__ __forceinline__ void pv_d0(f32x16* o, int vb, bf16x8 pa0, bf16x8 pa1, bf16x8 pa2, bf16x8 pa3) {
  pv_one<0>(o[0], vb, pa0, pa1, pa2, pa3); pv_one<1>(o[1], vb, pa0, pa1, pa2, pa3); pv_one<2>(o[2], vb, pa0, pa1, pa2, pa3); pv_one<3>(o[3], vb, pa0, pa1, pa2, pa3);
}
__device__ __forceinline__ float sigm(float x) { return __builtin_amdgcn_rcpf(1.0f + __builtin_amdgcn_exp2f(-1.4426950408889634f * x)); }
__device__ __forceinline__ unsigned short f2bf(float f) { unsigned u = __float_as_uint(f); return (unsigned short)((u + 0x7fffu + ((u >> 16) & 1u)) >> 16); }

typedef __attribute__((address_space(3))) const char* lds_cptr;
typedef short v4i16_t __attribute__((ext_vector_type(4)));
typedef float f32x2_t __attribute__((ext_vector_type(2))); typedef __bf16 bf16x2_t __attribute__((ext_vector_type(2)));
__device__ __forceinline__ unsigned cvtpk_s(float lo, float hi) { f32x2_t v = {lo, hi}; bf16x2_t b = __builtin_convertvector(v, bf16x2_t); return __builtin_bit_cast(unsigned, b); }
__device__ __forceinline__ s16x4 vtr(lds_cptr p) { return __builtin_bit_cast(s16x4, __builtin_amdgcn_ds_read_tr16_b64_v4i16((__attribute__((address_space(3))) v4i16_t*)p)); }
#define EX2(x) __builtin_amdgcn_exp2f(x)
#define MFMA32(a, b, c) __builtin_amdgcn_mfma_f32_32x32x16_bf16(a, b, c, 0, 0, 0)
__device__ __forceinline__ void phaseA(f32x16& n0, f32x16& n1, const f32x16& q0, f32x16& q1, float alpha, float& l_reg, bf16x8& pa0, bf16x8& pa1, bf16x8& pa2, bf16x8& pa3,
                                       const char* Ks, const char* Rs, const bf16x8* qn, const bf16x8* qr, int kpre, int rpre, float ones_k0, float neg_m) {
  asm volatile("" : "+v"(kpre), "+v"(rpre));
  n0 = __builtin_amdgcn_mfma_f32_32x32x2f32(ones_k0, neg_m, f32x16{}, 0, 0, 0); n1 = __builtin_amdgcn_mfma_f32_32x32x2f32(ones_k0, neg_m, f32x16{}, 0, 0, 0);
  float s0 = 0.f, s1 = 0.f; unsigned ca0 = 0, ca1 = 0, cb0 = 0, cb1 = 0; float ps = 0.f;
#define PKA(P, B) do { ca0 = cvtpk_s(P[B + 0], P[B + 1]); ca1 = cvtpk_s(P[B + 2], P[B + 3]); } while (0)
#define PKB(P, B) do { cb0 = cvtpk_s(P[B + 4], P[B + 5]); cb1 = cvtpk_s(P[B + 6], P[B + 7]); } while (0)
#define PKS(OUT) do { u32x4 w_ = {ca0, ca1, cb0, cb1}; OUT = *reinterpret_cast<bf16x8*>(&w_); } while (0)
  constexpr int KPF = 2;
  bf16x8 kq0[KPF + 1], kq1[KPF + 1];
#define KFRAG(st) do { if ((st) < 8) { const int ad_ = kpre ^ ((st) * 32); kq0[(st) % (KPF + 1)] = *reinterpret_cast<const bf16x8*>(Ks + ad_); kq1[(st) % (KPF + 1)] = *reinterpret_cast<const bf16x8*>(Ks + ad_ + 8192); } \
    else { const int ad_ = rpre ^ (((st) - 8) * 32); kq0[(st) % (KPF + 1)] = *reinterpret_cast<const bf16x8*>(Rs + ad_); kq1[(st) % (KPF + 1)] = *reinterpret_cast<const bf16x8*>(Rs + ad_ + 4096); } } while (0)
#pragma unroll
  for (int s = 0; s < KPF; ++s) KFRAG(s);
#pragma unroll
  for (int s = 0; s < 12; ++s) {
    if (s + KPF < 12) KFRAG(s + KPF);
    const bf16x8 kb0 = kq0[s % (KPF + 1)], kb1 = kq1[s % (KPF + 1)];
    const bf16x8 qf = s < 8 ? qn[s < 8 ? s : 0] : qr[s >= 8 ? s - 8 : 0];
    n0 = MFMA32(kb0, qf, n0);
    if (s < 8) { q1[2 * s] = EX2(q1[2 * s]); s0 += q0[2 * s]; s0 += q0[2 * s + 1]; }
    if (s == 0) PKA(q0, 0); if (s == 1) PKS(pa0); if (s == 2) PKA(q0, 8); if (s == 3) PKS(pa1);
    if (s == 4) PKA(q1, 0); if (s == 5) PKS(pa2); if (s == 8) PKA(q1, 8); if (s == 9) PKS(pa3);
    if (s == 10) { ps = s0 + s1; auto rr = __builtin_amdgcn_permlane32_swap(__float_as_uint(ps), __float_as_uint(ps), false, false); ps = __uint_as_float(rr[0]) + __uint_as_float(rr[1]); }
    SBAR();
    n1 = MFMA32(kb1, qf, n1);
    if (s < 8) { q1[2 * s + 1] = EX2(q1[2 * s + 1]); }
    if (s >= 2 && s < 10) { s1 += q1[2 * (s - 2)]; s1 += q1[2 * (s - 2) + 1]; }
    if (s == 0) PKB(q0, 0); if (s == 2) PKB(q0, 8); if (s == 4) PKB(q1, 0); if (s == 8) PKB(q1, 8);
    if (s == 11) l_reg = l_reg * alpha + ps;
    SBAR();
  }
#undef KFRAG
#undef PKA
#undef PKB
#undef PKS
}
__device__ __forceinline__ void decide_rel(f32x16& p0, f32x16& p1, float& m_reg, float& alpha) {
  float a = fmaxf(fmaxf(p0[0], p0[1]), p1[0]), b = fmaxf(fmaxf(p0[2], p0[3]), p1[1]); a = fmaxf(fmaxf(a, p1[2]), p1[3]);
#pragma unroll
  for (int r = 4; r < 16; r += 4) { a = fmaxf(fmaxf(a, p0[r]), p0[r + 1]); b = fmaxf(fmaxf(b, p0[r + 2]), p0[r + 3]); a = fmaxf(fmaxf(a, p1[r]), p1[r + 1]); b = fmaxf(fmaxf(b, p1[r + 2]), p1[r + 3]); }
  float pmax = fmaxf(a, b);
  { auto rr = __builtin_amdgcn_permlane32_swap(__float_as_uint(pmax), __float_as_uint(pmax), false, false); pmax = fmaxf(__uint_as_float(rr[0]), __uint_as_float(rr[1])); }
  if (__builtin_expect(__all(pmax <= THR_L2), 1)) { alpha = 1.f; }
  else { const float d = fmaxf(pmax, 0.f); alpha = __builtin_amdgcn_exp2f(-d); m_reg += d;
#pragma unroll
    for (int r = 0; r < 16; ++r) { p0[r] -= d; p1[r] -= d; } }
}
__device__ __forceinline__ void decide(const f32x16& p0, const f32x16& p1, float& m_reg, float& mn, float& alpha) {
  float a = fmaxf(fmaxf(p0[0], p0[1]), p1[0]), b = fmaxf(fmaxf(p0[2], p0[3]), p1[1]); a = fmaxf(fmaxf(a, p1[2]), p1[3]);
#pragma unroll
  for (int r = 4; r < 16; r += 4) { a = fmaxf(fmaxf(a, p0[r]), p0[r + 1]); b = fmaxf(fmaxf(b, p0[r + 2]), p0[r + 3]); a = fmaxf(fmaxf(a, p1[r]), p1[r + 1]); b = fmaxf(fmaxf(b, p1[r + 2]), p1[r + 3]); }
  float pmax = fmaxf(a, b);
  { auto rr = __builtin_amdgcn_permlane32_swap(__float_as_uint(pmax), __float_as_uint(pmax), false, false); pmax = fmaxf(__uint_as_float(rr[0]), __uint_as_float(rr[1])); }
  mn = fmaxf(m_reg, pmax); alpha = __builtin_amdgcn_exp2f(m_reg - mn); m_reg = mn;
}
typedef __attribute__((address_space(3))) char* lds_ptr;
struct DmaArgs { const bf16* kt; const bf16* rt; const bf16* vt; int koff0, koff1, roff, voff0, voff1; int dk, dr, dv; lds_ptr l3; };
#define GLDS(src, dstoff) __builtin_amdgcn_global_load_lds((const unsigned*)(src), (__attribute__((address_space(3))) unsigned*)(D.l3 + (dstoff)), 16, 0, 0)
constexpr int VPF = 3;
__device__ __forceinline__ void phaseB_pre(s16x4 (&l)[VPF + 1], s16x4 (&h)[VPF + 1], lds_cptr vp) {
#pragma unroll
  for (int i = 0; i < VPF; ++i) { l[i] = vtr(vp + v_rd_off(i >> 2, i & 3, 0)); h[i] = vtr(vp + v_rd_off(i >> 2, i & 3, 1)); }
}
template <bool DOK, bool DOV> __device__ __forceinline__ void phaseB(f32x16* o, f32x16& n0, f32x16& n1, bf16x8 pa0, bf16x8 pa1, bf16x8 pa2, bf16x8 pa3, lds_cptr vp,
                                                                          s16x4 (&l)[VPF + 1], s16x4 (&h)[VPF + 1], const DmaArgs& D) {
  constexpr int PF = VPF;
#pragma unroll
  for (int i = 0; i < 16; ++i) { const int d0 = i >> 2, ks = i & 3;
    if (i + PF < 16) { l[(i + PF) % (PF + 1)] = vtr(vp + v_rd_off((i + PF) >> 2, (i + PF) & 3, 0)); h[(i + PF) % (PF + 1)] = vtr(vp + v_rd_off((i + PF) >> 2, (i + PF) & 3, 1)); }
    const s16x4 lc = l[i % (PF + 1)], hc = h[i % (PF + 1)];
    const bf16x8 vf = (bf16x8){lc[0], lc[1], lc[2], lc[3], hc[0], hc[1], hc[2], hc[3]};
    o[d0] = MFMA32(ks == 0 ? pa0 : ks == 1 ? pa1 : ks == 2 ? pa2 : pa3, vf, o[d0]);
    n0[i] = EX2(n0[i]);
    {
      if (DOV && i == 0) GLDS(D.vt + D.voff0, D.dv);
      if (DOV && i == 1) GLDS(D.vt + D.voff1, D.dv + 1024);
      if (DOK && i == 2) GLDS(D.kt + D.koff0, D.dk);
      if (DOK && i == 3) GLDS(D.kt + D.koff1, D.dk + 1024);
      if (DOK && i == 4) GLDS(D.rt + D.roff, D.dr); }
    SBAR(); }
}
#undef GLDS

__device__ __forceinline__ void attn_unit(const bf16* __restrict__ Qn, const bf16* __restrict__ Qr, const bf16* __restrict__ Kh, const bf16* __restrict__ Vh,
                                          const bf16* __restrict__ Kr, const bf16* __restrict__ Ga, bf16* __restrict__ Mo, int seq, char* lds) {
  int tid_ = threadIdx.x; asm volatile("" : "+v"(tid_));
  const int tid = tid_, lane = tid & 63, r32 = lane & 31, hi = lane >> 5; const int wid = __builtin_amdgcn_readfirstlane(tid >> 6);
  char* V_lds = lds + OFF_V; char* K_lds = lds + OFF_K; char* R_lds = lds + OFF_R;
  const lds_ptr l3 = (lds_ptr)lds;
  float* ws = (float*)(lds + OFF_WS) + wid * 64; float* li_l = ws; float* al_l = ws + 32;
  float m_reg = -1e30f, l_reg = 0; f32x16 o[4] = {}; bf16x8 qn[8], qr[4];
  int koff[2], voff[2], roff;
#pragma unroll
  for (int i = 0; i < 2; ++i) { const int bi = wid * 2 + i;
    { const int row = 4 * bi + (lane >> 4), lc = (lane & 15) ^ (row & 15); koff[i] = row * LDK + lc * 8; }
    { const int k = (bi >> 1) * 8 + ((lane & 31) >> 2), cc = (2 * (bi & 1) + (lane >> 5)) * 32 + (lane & 3) * 8; voff[i] = k * LDK + cc; } }
  { const int row = 8 * wid + (lane >> 3), lc = (lane & 7) ^ ((row >> 1) & 7); roff = row * LDR + lc * 8; }
#define GLDS(src, dstoff) __builtin_amdgcn_global_load_lds((const unsigned*)(src), (__attribute__((address_space(3))) unsigned*)(l3 + (dstoff)), 16, 0, 0)
#define DMA_K(t, b) do { const bf16* ks_ = Kh + (long)(t) * KVBLK * LDK; GLDS(ks_ + koff[0], OFF_K + (b) * SHM_K + (wid * 2) * 1024); GLDS(ks_ + koff[1], OFF_K + (b) * SHM_K + (wid * 2 + 1) * 1024); \
    GLDS(Kr + (long)(t) * KVBLK * LDR + roff, OFF_R + (b) * SHM_R + wid * 1024); } while (0)
#define DMA_V(t, b) do { const bf16* vs_ = Vh + (long)(t) * KVBLK * LDK; GLDS(vs_ + voff[0], OFF_V + (b) * SHM_V + (wid * 2) * 1024); GLDS(vs_ + voff[1], OFF_V + (b) * SHM_V + (wid * 2 + 1) * 1024); } while (0)
#define RESC(a) do { if (__any((a) < 1.f)) { if (hi == 0) al_l[r32] = (a); asm volatile("s_waitcnt lgkmcnt(0)" ::: "memory"); \
    _Pragma("unroll") for (int d = 0; d < 4; ++d) _Pragma("unroll") for (int r = 0; r < 16; ++r) o[d][r] *= al_l[crow(r, hi)]; } } while (0)
  const int NT = seq / KVBLK;
  DMA_K(0, 0);
  { const bf16* Qw = Qn + (long)(wid * QBLK + r32) * LDQ + hi * 8;
#pragma unroll
    for (int d0 = 0; d0 < 8; ++d0) qn[d0] = ld8(Qw + d0 * 16);
    const bf16* Rw = Qr + (long)(wid * QBLK + r32) * LDQ + hi * 8;
#pragma unroll
    for (int d0 = 0; d0 < 4; ++d0) qr[d0] = ld8(Rw + d0 * 16); }
  const lds_cptr vp0 = (lds_cptr)V_lds + v_rd_base(lane);
  const int kpre = (r32 * 256 + ((r32 & 15) << 4)) ^ (hi * 16), rpre = (r32 * 128 + (((r32 >> 1) & 7) << 4)) ^ (hi * 16);
  f32x16 pA0, pA1, pB0, pB1; float mnA, alA, alB; bf16x8 pa0, pa1, pa2, pa3;
  const float ones_k0 = hi ? 0.f : 1.f;
  __syncthreads();
  DMA_K(1, 1); DMA_V(0, 0);
  qkt(pA0, pA1, K_lds, R_lds, qn, qr, r32, hi); decide(pA0, pA1, m_reg, mnA, alA);
#pragma unroll
  for (int r = 0; r < 16; ++r) { pA0[r] = EX2(pA0[r] - mnA); pA1[r] = pA1[r] - mnA; }
  __syncthreads();
  s16x4 vl[VPF + 1], vh[VPF + 1];
  DmaArgs D; D.koff0 = koff[0]; D.koff1 = koff[1]; D.roff = roff; D.voff0 = voff[0]; D.voff1 = voff[1]; D.l3 = l3;
#define DSET(tk, bk, tv, bv) do { D.kt = Kh + (long)(tk) * KVBLK * LDK; D.rt = Kr + (long)(tk) * KVBLK * LDR; D.vt = Vh + (long)(tv) * KVBLK * LDK; \
    D.dk = OFF_K + (bk) * SHM_K + (wid * 2) * 1024; D.dr = OFF_R + (bk) * SHM_R + wid * 1024; D.dv = OFF_V + (bv) * SHM_V + (wid * 2) * 1024; } while (0)
  for (int j = 1; j + 1 < NT; j += 2) {
    DSET(j + 1, 0, j, 1);
    SBAR(); phaseA(pB0, pB1, pA0, pA1, alA, l_reg, pa0, pa1, pa2, pa3, K_lds + SHM_K, R_lds + SHM_R, qn, qr, kpre, rpre, ones_k0, -m_reg);
    phaseB_pre(vl, vh, vp0);
    decide_rel(pB0, pB1, m_reg, alB); SBAR();
    phaseB<true, true>(o, pB0, pB1, pa0, pa1, pa2, pa3, vp0, vl, vh, D);
    RESC(alB); __syncthreads();
    DSET(j + 2, 1, j + 1, 0);
    SBAR(); phaseA(pA0, pA1, pB0, pB1, alB, l_reg, pa0, pa1, pa2, pa3, K_lds, R_lds, qn, qr, kpre, rpre, ones_k0, -m_reg);
    phaseB_pre(vl, vh, vp0 + SHM_V);
    decide_rel(pA0, pA1, m_reg, alA); SBAR();
    phaseB<true, true>(o, pA0, pA1, pa0, pa1, pa2, pa3, vp0 + SHM_V, vl, vh, D);
    RESC(alA); __syncthreads();
  }
  DSET(NT - 1, 0, NT - 1, 1);
  SBAR(); phaseA(pB0, pB1, pA0, pA1, alA, l_reg, pa0, pa1, pa2, pa3, K_lds + SHM_K, R_lds + SHM_R, qn, qr, kpre, rpre, ones_k0, -m_reg);
  phaseB_pre(vl, vh, vp0);
  decide_rel(pB0, pB1, m_reg, alB); SBAR();
  phaseB<false, true>(o, pB0, pB1, pa0, pa1, pa2, pa3, vp0, vl, vh, D);
  RESC(alB); __syncthreads();
#undef DSET
  finishSM(pB0, pB1, alB, l_reg, pa0, pa1, pa2, pa3); SBAR();
  pv_d0(o, (int)(unsigned)(uintptr_t)V_lds + v_rd_base(lane) + SHM_V, pa0, pa1, pa2, pa3);
  if (hi == 0) li_l[r32] = l_reg; asm volatile("s_waitcnt lgkmcnt(0)" ::: "memory");
  float rli[16];
#pragma unroll
  for (int r = 0; r < 16; ++r) rli[r] = __builtin_amdgcn_rcpf(li_l[crow(r, hi)]);
  bf16* Ow = Mo + (long)(wid * QBLK) * LDO; const bf16* Gw = Ga + (long)(wid * QBLK) * LDO;
#pragma unroll
  for (int r = 0; r < 16; ++r) { const int orow = crow(r, hi);
#pragma unroll
    for (int d0 = 0; d0 < 4; ++d0) { const long off = (long)orow * LDO + d0 * 32 + r32;
      const float g = __uint_as_float((unsigned)Gw[off] << 16);
      Ow[off] = f2bf(o[d0][r] * rli[r] * sigm(g)); } }
  __syncthreads();
#undef GLDS
#undef DMA_K
#undef DMA_V
#undef RESC
}
#undef KSWZ
#undef RSWZ
#undef SBAR
}

constexpr int NWAVES = 8;
constexpr int DM = 4096, NPR = 8192, NROW = 24576;
constexpr int NKEY = 8192 + 4 * 4608;
constexpr int NIN = 12032;
constexpr int NCHUNK = NROW / 16;
constexpr float EPSN = 1e-6f;
constexpr float QSCALE = 0.07216878364870322f * 1.4426950408889634f;
constexpr size_t O_Y = 0, O_CKV = 100663296, O_KR = 104857600, O_S5 = 105381888, O_END = 106430464;

constexpr size_t MiB = 1u << 20;
constexpr size_t WS_CTL = 0, CTL_ZERO_BYTES = 1 * MiB;
constexpr size_t WS_PAR = 1 * MiB;
constexpr size_t WS_TAB = 2 * MiB;
constexpr size_t WS_QSTAT = 3 * MiB;
constexpr size_t WS_KVSTAT = 5 * MiB;
constexpr size_t WS_OSTAT = 6 * MiB;
constexpr size_t WS_MODPART = 12 * MiB;
constexpr size_t WS_WGLU = 28 * MiB, WS_WOUT = 60 * MiB, WS_WUQ = 92 * MiB, WS_WUKV = 104 * MiB;
constexpr size_t WS_GA = 112 * MiB, WS_GB = 304 * MiB;
constexpr size_t WS_WFF1 = 112 * MiB, WS_WFF2 = 240 * MiB;
constexpr size_t WS_A = 496 * MiB;
constexpr size_t WS_X = 688 * MiB;
constexpr size_t WS_WIN = WS_X, WS_MSTATE = WS_X + 94 * MiB, WS_MCAT = WS_X + 110 * MiB, WS_QRAW = WS_X + 142 * MiB, WS_CKVRAW = WS_X + 190 * MiB,
                 WS_KRRAW = WS_X + 238 * MiB, WS_UH = WS_X + 244 * MiB;
constexpr size_t WS_Q = WS_X, WS_KV = WS_X + 288 * MiB;
constexpr size_t WS_OUTB = WS_X;
constexpr size_t WS_A1 = WS_X;
constexpr size_t WS_QN = 1392 * MiB, WS_CKVN = 1440 * MiB, WS_KR = 1466 * MiB, WS_YG = 1470 * MiB, WS_END = 1566 * MiB;
static_assert(WS_WIN + (size_t)NIN * 4096 * 2 <= WS_MSTATE && WS_UH + (size_t)128 * 1536 * 512 * 2 <= WS_QN && WS_KV + (size_t)NKEY * 8192 * 2 <= WS_QN, "arena");
static_assert(WS_KR + (size_t)NKEY * 64 * 2 <= WS_YG && WS_CKVN + (size_t)NKEY * 512 * 2 <= WS_KR && WS_A1 + (size_t)NROW * 16384 * 2 <= WS_END, "arena 2");
constexpr int CW_TMO = 0, CW_CODE = 1, CW_BAR = 4096;

constexpr int RING_OFF = 0, RING_BYTES = 131072;
constexpr int LDSCTL_OFF = RING_BYTES, MISC_OFF = LDSCTL_OFF + 320;
constexpr int LDS_BYTES = 147456;
static_assert(att::ATT_LDS <= RING_BYTES, "attention LDS");

#define GAS __attribute__((address_space(1)))
#define LAS __attribute__((address_space(3)))
typedef unsigned short bf16;
typedef unsigned v4u __attribute__((ext_vector_type(4)));
typedef float f32x4 __attribute__((ext_vector_type(4)));
typedef short bf16x8 __attribute__((ext_vector_type(8)));
typedef GAS unsigned gu32;
typedef GAS unsigned long long gu64;
#define RLX_AGENT __ATOMIC_RELAXED, __HIP_MEMORY_SCOPE_AGENT
#define LDS_WAIT() asm volatile("s_waitcnt lgkmcnt(0)" ::: "memory")
#define VM_WAIT() asm volatile("s_waitcnt vmcnt(0)" ::: "memory")
__device__ __forceinline__ unsigned long long rt() { return __builtin_amdgcn_s_memrealtime(); }
__device__ __forceinline__ unsigned f2bf(float f) { unsigned u = __builtin_bit_cast(unsigned, f); return (u + 0x7fffu + ((u >> 16) & 1u)) >> 16; }
__device__ __forceinline__ unsigned pk2(float lo, float hi) { return f2bf(lo) | (f2bf(hi) << 16); }

#define XB_TMO      128
#define XB_XCNT(j)  (256  + 64 * (j))
#define XB_XSUB(j)  (1280 + 64 * (j))
#define XB_XGEN(j)  (2304 + 64 * (j))
#define XB_TOP      3328
#define XB_TOPGEN   3392
#define XCD_BAR_WORDS 3456
#define XB_SPIN_CAP (1u << 18)

__device__ __forceinline__ unsigned xb_ld(unsigned* p)              { return __hip_atomic_load(p, __ATOMIC_RELAXED, __HIP_MEMORY_SCOPE_AGENT); }
__device__ __forceinline__ unsigned xb_add(unsigned* p, unsigned v) { return __hip_atomic_fetch_add(p, v, __ATOMIC_RELAXED, __HIP_MEMORY_SCOPE_AGENT); }
__device__ __forceinline__ unsigned xb_xcc_id() { return (unsigned)__builtin_amdgcn_s_getreg((3 << 11) | 20) & 0xFu; }
#define XB_SPIN(cond, bar) do { unsigned _sp = 0; while (cond) { __builtin_amdgcn_s_sleep(1); \
    if ((++_sp & 255u) == 0u) { if (xb_ld(&(bar)[XB_TMO])) break; if (_sp > XB_SPIN_CAP) { atomicAdd(&(bar)[XB_TMO], 1u); break; } } } } while (0)

struct XcdBarrier {
    unsigned* bar; unsigned x;
    volatile LAS unsigned* st;
};

__device__ __forceinline__ XcdBarrier xcd_barrier_post(unsigned* bar, volatile LAS unsigned* st) {
    XcdBarrier b; b.bar = bar; b.x = xb_xcc_id(); b.st = st;
    if (threadIdx.x == 0) (void)xb_add(&bar[XB_XCNT(b.x)], 1u);
    return b;
}
__device__ __forceinline__ void xcd_barrier_complete(unsigned* bar, unsigned x, unsigned& nloc, unsigned& nx) {
    const unsigned G = gridDim.x * gridDim.y * gridDim.z;
    unsigned sum, cnt, mine, sp = 0u;
    for (;;) {
        sum = 0u; cnt = 0u; mine = 0u;
#pragma unroll
        for (unsigned j = 0; j < 16; ++j) { const unsigned c = xb_ld(&bar[XB_XCNT(j)]); sum += c; cnt += (c > 0u) ? 1u : 0u; mine = (j == x) ? c : mine; }
        if (sum == G) break;
        __builtin_amdgcn_s_sleep(1);
        if ((++sp & 255u) == 0u) { if (xb_ld(&bar[XB_TMO])) break; if (sp > XB_SPIN_CAP) { atomicAdd(&bar[XB_TMO], 1u); break; } }
    }
    nloc = mine > 0u ? mine : 1u; nx = cnt > 0u ? cnt : 1u;
}

__device__ __forceinline__ void xcd_barrier(const XcdBarrier& b) {
    asm volatile("s_waitcnt vmcnt(0)" ::: "memory");
    __syncthreads();
    if (threadIdx.x == 0) {
        unsigned* bar = b.bar;
        __builtin_amdgcn_s_waitcnt(0);
        unsigned nloc = b.st[0], nx = b.st[1];
        if (nloc == 0u) { xcd_barrier_complete(bar, b.x, nloc, nx); b.st[0] = nloc; b.st[1] = nx; }
        const unsigned old = xb_add(&bar[XB_XSUB(b.x)], 1u);
        const unsigned gen = old / nloc;
        if (old + 1u == (gen + 1u) * nloc) {
            __builtin_amdgcn_fence(__ATOMIC_RELEASE, "agent");
            asm volatile("s_waitcnt vmcnt(0)" ::: "memory");
            const unsigned og = xb_add(&bar[XB_TOP], 1u);
            const unsigned tg = og / nx;
            if (og + 1u == (tg + 1u) * nx) xb_add(&bar[XB_TOPGEN], 1u);
            else XB_SPIN(xb_ld(&bar[XB_TOPGEN]) == tg, bar);
            __builtin_amdgcn_fence(__ATOMIC_ACQUIRE, "agent");
            xb_add(&bar[XB_XGEN(b.x)], 1u);
            asm volatile("s_waitcnt vmcnt(0)" ::: "memory");
        } else {
            XB_SPIN(xb_ld(&bar[XB_XGEN(b.x)]) == gen, bar);
            __builtin_amdgcn_fence(__ATOMIC_ACQUIRE, "agent");
            asm volatile("s_waitcnt vmcnt(0)" ::: "memory");
        }
    }
    __syncthreads();
}


typedef float f32x2 __attribute__((ext_vector_type(2)));
typedef unsigned u32x2 __attribute__((ext_vector_type(2)));
struct Frame {
    LAS unsigned char* lds;
    volatile LAS unsigned* MISC;
    gu32* ctl;
    int tid, lane, wave;
    int vcu, G;
    float* out; unsigned char* ws;
};
typedef const float* cfp_t;
typedef __attribute__((address_space(4))) const cfp_t* kargp_t;
__device__ __forceinline__ const float* inp(int k) { kargp_t p = (kargp_t)__builtin_amdgcn_kernarg_segment_ptr(); asm volatile("" : "+s"(p)); return p[k]; }
__device__ __forceinline__ float wave_sum(float v) {
#pragma unroll
    for (int o = 1; o < 64; o <<= 1) v += __shfl_xor(v, o);
    return v;
}
__device__ __forceinline__ float bf2f(unsigned short h) { return __uint_as_float((unsigned)h << 16); }
__device__ __forceinline__ float sigmf(float x) { return __builtin_amdgcn_rcpf(1.0f + __builtin_amdgcn_exp2f(-1.4426950408889634f * x)); }

__device__ __forceinline__ int mapcol(int code, int n) {
    if (code == 1) return n < 1536 ? n : (n < 11776 ? n + 64 : (n < 11840 ? n - 11776 + 1536 : -1));
    if (code == 2) { if (n < 4096) return (n >> 7) * 192 + (n & 127); const int m = n - 4096, h = m >> 6, i = m & 63; return h * 192 + 128 + (i >> 1) + 32 * (i & 1); }
    if (code == 3) { const int t = n >> 8, r = n & 255; return r < 128 ? t * 128 + r : 4096 + t * 128 + (r - 128); }
    return n;
}
__device__ __forceinline__ void transpose_item(const float* W, int K, int Nsrc, int Ndst, int code, bf16* WT, LAS float* scr, int item, int lane) {
    const int nblk = Ndst / 32, kb = item / nblk, nb = item - kb * nblk, k0 = 64 * kb, n0 = 32 * nb;
    const int sc = mapcol(code, n0 + (lane & 31));
#pragma unroll 8
    for (int i = 0; i < 32; ++i) { const int kk = 2 * i + (lane >> 5); scr[kk * 33 + (lane & 31)] = sc >= 0 ? W[(size_t)(k0 + kk) * Nsrc + sc] : 0.f; }
    LDS_WAIT(); asm volatile("" ::: "memory");
    const int c = lane & 7;
#pragma unroll
    for (int j = 0; j < 4; ++j) { const int n = (lane >> 3) + 8 * j; const LAS float* s = scr + (8 * c) * 33 + n;
        v4u o; o.x = pk2(s[0 * 33], s[1 * 33]); o.y = pk2(s[2 * 33], s[3 * 33]); o.z = pk2(s[4 * 33], s[5 * 33]); o.w = pk2(s[6 * 33], s[7 * 33]);
        *(GAS v4u*)(WT + (size_t)(n0 + n) * K + k0 + 8 * c) = o; }
    LDS_WAIT(); asm volatile("" ::: "memory");
}

struct ConvJob { const float* W; bf16* WT; int K, Nsrc, Ndst, code, item; };
__device__ __forceinline__ void conv_item_kn(const ConvJob& j, int& kb, int& nb) {
    const int nblk = j.Ndst / 32;
    if (j.code == 0 && j.K >= 4096 && (nblk & 31) == 0) { const int r = j.item & 2047, q = j.item >> 11, kg = j.K / 4096; kb = (q % kg) * 64 + (r >> 5); nb = (q / kg) * 32 + (r & 31); }
    else { kb = j.item / nblk; nb = j.item - kb * nblk; }
}
__device__ __forceinline__ void conv_load(const ConvJob& j, int lane, f32x4 (&v)[8]) {
    int kb, nb; conv_item_kn(j, kb, nb); const int k0 = 64 * kb, n0 = 32 * nb, c4 = lane & 7, r8 = lane >> 3;
    const int sc = mapcol(j.code, n0 + c4 * 4);
    if (sc >= 0) {
#pragma unroll
        for (int i = 0; i < 8; ++i) v[i] = __builtin_nontemporal_load((const GAS f32x4*)(j.W + (size_t)(k0 + i * 8 + r8) * j.Nsrc + sc));
    } else {
#pragma unroll
        for (int i = 0; i < 8; ++i) v[i] = (f32x4){0.f, 0.f, 0.f, 0.f};
    }
}
__device__ __forceinline__ void conv_lds_write(LAS float* scr, int lane, const f32x4 (&v)[8]) {
    const int c4 = lane & 7, r8 = lane >> 3;
#pragma unroll
    for (int i = 0; i < 8; ++i) { LAS float* d = scr + (i * 8 + r8) * 33 + c4 * 4; d[0] = v[i].x; d[1] = v[i].y; d[2] = v[i].z; d[3] = v[i].w; }
}
__device__ __forceinline__ void conv_store(const ConvJob& j, LAS float* scr, int lane) {
    int kb, nb; conv_item_kn(j, kb, nb); const int k0 = 64 * kb, n0 = 32 * nb, c = lane & 7;
#pragma unroll
    for (int jj = 0; jj < 4; ++jj) { const int n = (lane >> 3) + 8 * jj; const LAS float* s = scr + (8 * c) * 33 + n;
        v4u o; o.x = pk2(s[0 * 33], s[1 * 33]); o.y = pk2(s[2 * 33], s[3 * 33]); o.z = pk2(s[4 * 33], s[5 * 33]); o.w = pk2(s[6 * 33], s[7 * 33]);
        *(GAS v4u*)(j.WT + (size_t)(n0 + n) * j.K + k0 + 8 * c) = o; }
}
template <int MODE>
__device__ __forceinline__ ConvJob conv_resolve(int r, const float* w0, const float* w1, const float* w2, const float* w3, unsigned char* ws) {
    ConvJob j;
    if (MODE == 0) {
        constexpr int I_IN = (4096 / 64) * (NIN / 32), I_UKV = (512 / 64) * (8192 / 32), I_GLU = (2048 / 64) * (8192 / 32);
        if (r < I_IN) { j.W = w0; j.WT = (bf16*)(ws + WS_WIN); j.K = 4096; j.Nsrc = 11840; j.Ndst = NIN; j.code = 1; j.item = r; }
        else if (r < I_IN + I_UKV) { j.W = w1; j.WT = (bf16*)(ws + WS_WUKV); j.K = 512; j.Nsrc = 8192; j.Ndst = 8192; j.code = 0; j.item = r - I_IN; }
        else if (r < I_IN + I_UKV + I_GLU) { j.W = w2; j.WT = (bf16*)(ws + WS_WGLU); j.K = 2048; j.Nsrc = 8192; j.Ndst = 8192; j.code = 3; j.item = r - I_IN - I_UKV; }
        else { j.W = w3; j.WT = (bf16*)(ws + WS_WOUT); j.K = 4096; j.Nsrc = 4096; j.Ndst = 4096; j.code = 0; j.item = r - I_IN - I_UKV - I_GLU; }
    } else {
        constexpr int I_F1 = (4096 / 64) * (16384 / 32);
        if (r < I_F1) { j.W = w0; j.WT = (bf16*)(ws + WS_WFF1); j.K = 4096; j.Nsrc = 16384; j.Ndst = 16384; j.code = 0; j.item = r; }
        else { j.W = w1; j.WT = (bf16*)(ws + WS_WFF2); j.K = 16384; j.Nsrc = 4096; j.Ndst = 4096; j.code = 0; j.item = r - I_F1; }
    }
    return j;
}
template <int MODE>
__device__ __forceinline__ void conv_run(const float* w0, const float* w1, const float* w2, const float* w3, unsigned char* ws, int total, int gw, int NGW, LAS float* scr, int lane, int first = 0) {
    int it = first + gw; if (it >= total) return;
    ConvJob cur = conv_resolve<MODE>(it, w0, w1, w2, w3, ws); f32x4 v[8]; conv_load(cur, lane, v);
    for (;;) {
        conv_lds_write(scr, lane, v);
        const int nit = it + NGW; const bool more = nit < total;
        if (more) { const ConvJob nxt = conv_resolve<MODE>(nit, w0, w1, w2, w3, ws); conv_load(nxt, lane, v); }
        LDS_WAIT(); asm volatile("" ::: "memory");
        conv_store(cur, scr, lane);
        LDS_WAIT(); asm volatile("" ::: "memory");
        if (!more) break;
        it = nit; cur = conv_resolve<MODE>(it, w0, w1, w2, w3, ws);
    }
}

__device__ __forceinline__ void adaln_unit(Frame& F, int id) {
    const int slab = id >> 5, ks = id & 31, k0 = ks * 128, col0 = slab * 1024;
    LAS float* sl = (LAS float*)(F.lds);
    LAS f32x4* red = (LAS f32x4*)(F.lds + 4096);
    for (int i = F.tid; i < 640; i += 512) { const int j = i >> 7, k = i & 127; const float v = (j == 0) ? inp(6)[k0 + k] : inp(2)[(j - 1) * 4096 + k0 + k];
        sl[i] = v / (1.0f + expf(-v)); }
    __syncthreads();
    const int c4 = F.tid & 255, kh = F.tid >> 8;
    f32x4 acc[5];
#pragma unroll
    for (int j = 0; j < 5; ++j) acc[j] = (f32x4){0.f, 0.f, 0.f, 0.f};
    const float* wp = inp(7) + (size_t)(k0 + kh * 64) * 24576 + col0 + c4 * 4;
#pragma unroll 8
    for (int kk = 0; kk < 64; ++kk) { const f32x4 w = *(const GAS f32x4*)(wp + (size_t)kk * 24576);
#pragma unroll
        for (int j = 0; j < 5; ++j) acc[j] += sl[j * 128 + kh * 64 + kk] * w; }
    if (kh == 1) {
#pragma unroll
        for (int j = 0; j < 5; ++j) red[j * 256 + c4] = acc[j]; }
    __syncthreads();
    if (kh == 0) { float* mp = (float*)(F.ws + WS_MODPART);
#pragma unroll
        for (int j = 0; j < 5; ++j) { const f32x4 v = acc[j] + red[j * 256 + c4]; *(GAS f32x4*)(mp + (size_t)(ks * 5 + j) * 24576 + col0 + c4 * 4) = v; } }
    __syncthreads();
}

__device__ __forceinline__ void s5_task(Frame& F, int g) {
    LAS f32x2* pw = (LAS f32x2*)(F.lds);
    LAS f32x2* coef = (LAS f32x2*)(F.lds + 17408);
    LAS f32x2* Bb = (LAS f32x2*)(F.lds + 18432);
    LAS f32x2* Cc = (LAS f32x2*)(F.lds + 34816);
    LAS float* Kt = (LAS float*)(F.lds + 51200);
    const int tid = F.tid;
    if (tid < 128) { const int dir = tid >> 6, p = tid & 63, idx = (dir * 128 + g) * 64 + p;
        const double lr = (double)inp(15)[idx], li = (double)inp(16)[idx], dt = exp((double)inp(17)[dir * 128 + g]);
        const double zr = lr * dt, zi = li * dt, er = exp(zr), ar = er * cos(zi), ai = er * sin(zi);
        const double nr = ar - 1.0, ni = ai, den = lr * lr + li * li;
        coef[dir * 64 + p] = (f32x2){(float)((nr * lr + ni * li) / den), (float)((ni * lr - nr * li) / den)};
        double pr = 1.0, pi = 0.0;
        for (int d = 0; d <= 16; ++d) { pw[(dir * 17 + d) * 64 + p] = (f32x2){(float)pr, (float)pi}; const double t = pr * ar - pi * ai; pi = pr * ai + pi * ar; pr = t; }
        const f32x2 a16 = pw[(dir * 17 + 16) * 64 + p];
        ((f32x2*)(F.ws + WS_PAR + 512 * 1024))[(dir * 128 + g) * 64 + p] = a16; }
    __syncthreads();
    for (int i = tid; i < 2048; i += 512) { const int dir = i >> 10, p = (i >> 4) & 63, j = i & 15; const size_t gi = ((size_t)(dir * 128 + g) * 64 + p) * 16 + j;
        const float br = inp(18)[gi], bi = inp(19)[gi]; const f32x2 cf = coef[dir * 64 + p];
        Bb[i] = (f32x2){cf.x * br - cf.y * bi, cf.x * bi + cf.y * br}; }
    for (int i = tid; i < 2048; i += 512) { const int dir = i >> 10; const size_t gi = (size_t)(dir * 128 + g) * 1024 + (i & 1023);
        Cc[i] = (f32x2){inp(20)[gi], inp(21)[gi]}; }
    __syncthreads();
    { const int dir = tid >> 8, jj = tid & 255, j = jj >> 4, jp = jj & 15; float acc[16];
#pragma unroll
        for (int d = 0; d < 16; ++d) acc[d] = 0.f;
        for (int p = 0; p < 64; ++p) { const f32x2 c = Cc[(dir * 16 + j) * 64 + p], b = Bb[(dir * 64 + p) * 16 + jp]; const float Pr = c.x * b.x - c.y * b.y, Pi = c.x * b.y + c.y * b.x;
#pragma unroll
            for (int d = 0; d < 16; ++d) { const f32x2 w = pw[(dir * 17 + d) * 64 + p]; acc[d] += Pr * w.x - Pi * w.y; } }
#pragma unroll
        for (int d = 0; d < 16; ++d) Kt[(dir * 16 + d) * 256 + jj] = acc[d]; }
    __syncthreads();
    bf16* Mcat = (bf16*)(F.ws + WS_MCAT) + (size_t)g * 256 * 512; bf16* Mst = (bf16*)(F.ws + WS_MSTATE) + (size_t)g * 256 * 256;
    for (int it = 0; it < 32; ++it) { const int idx = tid + 512 * it, n = idx >> 6, k8 = (idx & 63) * 8, tau = n >> 4, j = n & 15; float v[8];
        if (k8 < 256) { const int sg = k8 >> 4, j0 = k8 & 15;
#pragma unroll
            for (int e = 0; e < 8; ++e) { const int jp = j0 + e; float x = 0.f;
                if (sg <= tau) x += Kt[(0 * 16 + (tau - sg)) * 256 + j * 16 + jp];
                if (sg >= tau) x += Kt[(1 * 16 + (sg - tau)) * 256 + j * 16 + jp];
                if (sg == tau && j == jp) x += inp(22)[g * 16 + j];
                v[e] = x; }
        } else { const int kk = k8 - 256, dir = kk >> 7, part = (kk >> 6) & 1, p0 = kk & 63, ep = dir == 0 ? tau + 1 : 16 - tau;
#pragma unroll
            for (int e = 0; e < 8; ++e) { const f32x2 w = pw[(dir * 17 + ep) * 64 + p0 + e], c = Cc[(dir * 16 + j) * 64 + p0 + e];
                v[e] = part == 0 ? (c.x * w.x - c.y * w.y) : -(c.x * w.y + c.y * w.x); } }
        v4u o; o.x = pk2(v[0], v[1]); o.y = pk2(v[2], v[3]); o.z = pk2(v[4], v[5]); o.w = pk2(v[6], v[7]);
        *(GAS v4u*)(Mcat + (size_t)n * 512 + k8) = o; }
    for (int it = 0; it < 16; ++it) { const int idx = tid + 512 * it, n = idx >> 5, k8 = (idx & 31) * 8, dir = n >> 7, part = (n >> 6) & 1, p = n & 63, sg = k8 >> 4, j0 = k8 & 15, ep = dir == 0 ? 15 - sg : sg;
        const f32x2 w = pw[(dir * 17 + ep) * 64 + p]; float v[8];
#pragma unroll
        for (int e = 0; e < 8; ++e) { const f32x2 b = Bb[(dir * 64 + p) * 16 + j0 + e]; v[e] = part == 0 ? (w.x * b.x - w.y * b.y) : (w.x * b.y + w.y * b.x); }
        v4u o; o.x = pk2(v[0], v[1]); o.y = pk2(v[2], v[3]); o.z = pk2(v[4], v[5]); o.w = pk2(v[6], v[7]);
        *(GAS v4u*)(Mst + (size_t)n * 256 + k8) = o; }
    __syncthreads();
}

__device__ __forceinline__ void p0_prologue(Frame& F) {
    for (int id = F.vcu; id < 768; id += F.G) adaln_unit(F, id);
    for (int g = F.vcu; g < 128; g += F.G) s5_task(F, g);
    { float* tab = (float*)(F.ws + WS_TAB);
      for (int idx = F.vcu * 512 + F.tid; idx < 4096 * 32; idx += F.G * 512) { const int t = idx >> 5, p = idx & 31, pos = p < 16 ? (t >> 6) : (t & 63), f = p & 15;
        const double inv = exp(-(double)f * (9.210340371976184 / 16.0)), ang = (double)pos * inv;
        *(GAS f32x2*)(tab + (size_t)idx * 2) = (f32x2){(float)cos(ang), (float)sin(ang)}; } }
    LAS float* scr = (LAS float*)(F.lds + RING_OFF + F.wave * 16384);
    const int gw = F.vcu * NWAVES + F.wave, NGW = F.G * NWAVES;
    constexpr int I_IN = (4096 / 64) * (NIN / 32), I_UQ = (1024 / 64) * (6144 / 32), I_UKV = (512 / 64) * (8192 / 32), I_GLU = (2048 / 64) * (8192 / 32), I_OUT = (4096 / 64) * (4096 / 32);
    { constexpr int I_ALL = I_IN + I_UKV + I_GLU + I_OUT;
      if (F.G == 256) { constexpr int I_EVEN = (I_ALL * 3 / 4) & ~2047;
          conv_run<0>(inp(10), inp(14), inp(23), inp(24), F.ws, I_EVEN, gw, NGW, scr, F.lane);
          if (F.vcu >= 128) conv_run<0>(inp(10), inp(14), inp(23), inp(24), F.ws, I_ALL, gw - 128 * NWAVES, 128 * NWAVES, scr, F.lane, I_EVEN); }
      else conv_run<0>(inp(10), inp(14), inp(23), inp(24), F.ws, I_ALL, gw, NGW, scr, F.lane); }
    { const float* w_uq = inp(13);
      for (int it = gw; it < I_UQ; it += NGW) transpose_item(w_uq, 1024, 6144, 6144, 2, (bf16*)(F.ws + WS_WUQ), scr, it, F.lane); }
}
__device__ __forceinline__ void p0b_modreduce(Frame& F) {
    const float* mp = (const float*)(F.ws + WS_MODPART); float* par = (float*)(F.ws + WS_PAR);
    for (int idx = F.vcu * 512 + F.tid; idx < 5 * 4096; idx += F.G * 512) { const int j = idx >> 12, k = idx & 4095; float m[6];
#pragma unroll
        for (int i = 0; i < 6; ++i) { const int n = i * 4096 + k; float s = inp(8)[n];
            for (int ks = 0; ks < 32; ++ks) s += mp[(size_t)(ks * 5 + j) * 24576 + n];
            m[i] = s; }
        par[0 * 20480 + idx] = inp(9)[k] * (1.0f + m[1]); par[1 * 20480 + idx] = m[0]; par[2 * 20480 + idx] = m[2] * inp(25)[k];
        par[3 * 20480 + idx] = inp(26)[k] * (1.0f + m[4]); par[4 * 20480 + idx] = m[3]; par[5 * 20480 + idx] = m[5] * inp(29)[k]; }
}
__device__ __forceinline__ int cond_of_row(int m) { return m < NPR ? 0 : 1 + ((m - NPR) >> 12); }
__device__ __forceinline__ const float* xrow_of(const Frame& F, int m) { return m < NPR ? inp(0) + (size_t)m * DM : inp(1) + (size_t)(m - NPR) * DM; }
__device__ __forceinline__ void p1_modnorm(Frame& F) {
    const int gw = F.vcu * NWAVES + F.wave, NGW = F.G * NWAVES; const float* par = (const float*)(F.ws + WS_PAR); bf16* H = (bf16*)(F.ws + WS_A);
    for (int m = gw; m < NROW; m += NGW) { const int cd = cond_of_row(m); const GAS f32x4* xr = (const GAS f32x4*)xrow_of(F, m) + F.lane;
        const GAS f32x4* A = (const GAS f32x4*)(par + 0 * 20480 + cd * 4096) + F.lane; const GAS f32x4* B = (const GAS f32x4*)(par + 1 * 20480 + cd * 4096) + F.lane;
        f32x4 v[16]; float s = 0.f;
#pragma unroll
        for (int j = 0; j < 16; ++j) { v[j] = xr[64 * j]; s += (v[j].x * v[j].x + v[j].y * v[j].y) + (v[j].z * v[j].z + v[j].w * v[j].w); }
        const float rinv = 1.0f / sqrtf(wave_sum(s) * (1.0f / DM) + EPSN);
        GAS u32x2* o8 = (GAS u32x2*)(H + (size_t)m * DM) + F.lane;
#pragma unroll
        for (int j = 0; j < 16; ++j) { const f32x4 a = A[64 * j], b = B[64 * j]; const f32x4 y = v[j] * rinv * a + b; o8[64 * j] = (u32x2){pk2(y.x, y.y), pk2(y.z, y.w)}; } }
}
__device__ __forceinline__ void p3_rowpass(Frame& F) {
    const int gw = F.vcu * NWAVES + F.wave, NGW = F.G * NWAVES, lane = F.lane;
    const bf16* qraw = (const bf16*)(F.ws + WS_QRAW); const float* ckvraw = (const float*)(F.ws + WS_CKVRAW); const float* krraw = (const float*)(F.ws + WS_KRRAW);
    const float* qstat = (const float*)(F.ws + WS_QSTAT); const float* kvstat = (const float*)(F.ws + WS_KVSTAT); const float* tab = (const float*)(F.ws + WS_TAB);
    bf16* qn = (bf16*)(F.ws + WS_QN); bf16* ckvn = (bf16*)(F.ws + WS_CKVN); bf16* Kr = (bf16*)(F.ws + WS_KR);
    for (int m = gw; m < NROW + 2048; m += NGW) {
        if (m < NROW) {
            const int keyrow = m < NPR ? m : NPR + ((m - NPR) >> 12) * 4608 + 512 + ((m - NPR) & 4095);
            const float qs = wave_sum(lane < 16 ? qstat[m * 16 + lane] : 0.f), ks = wave_sum(lane < 8 ? kvstat[m * 8 + lane] : 0.f);
            const float rq = 1.0f / sqrtf(qs * (1.0f / 1024.f) + EPSN), rk = 1.0f / sqrtf(ks * (1.0f / 512.f) + EPSN);
#pragma unroll
            for (int hh = 0; hh < 2; ++hh) { const int k0 = hh * 512 + lane * 8; const v4u w = *(const GAS v4u*)(qraw + (size_t)m * 1024 + k0);
                const f32x4 g0 = *(const GAS f32x4*)(inp(11) + k0), g1 = *(const GAS f32x4*)(inp(11) + k0 + 4); v4u o;
                o.x = pk2(__uint_as_float(w.x << 16) * rq * g0.x, __uint_as_float(w.x & 0xffff0000u) * rq * g0.y); o.y = pk2(__uint_as_float(w.y << 16) * rq * g0.z, __uint_as_float(w.y & 0xffff0000u) * rq * g0.w);
                o.z = pk2(__uint_as_float(w.z << 16) * rq * g1.x, __uint_as_float(w.z & 0xffff0000u) * rq * g1.y); o.w = pk2(__uint_as_float(w.w << 16) * rq * g1.z, __uint_as_float(w.w & 0xffff0000u) * rq * g1.w);
                *(GAS v4u*)(qn + (size_t)m * 1024 + k0) = o; }
            { const int k0 = lane * 8; const f32x4 a = *(const GAS f32x4*)(ckvraw + (size_t)m * 512 + k0), b = *(const GAS f32x4*)(ckvraw + (size_t)m * 512 + k0 + 4);
              const f32x4 g0 = *(const GAS f32x4*)(inp(12) + k0), g1 = *(const GAS f32x4*)(inp(12) + k0 + 4); const f32x4 ya = a * rk * g0, yb = b * rk * g1;
              v4u o; o.x = pk2(ya.x, ya.y); o.y = pk2(ya.z, ya.w); o.z = pk2(yb.x, yb.y); o.w = pk2(yb.z, yb.w);
              *(GAS v4u*)(ckvn + (size_t)keyrow * 512 + k0) = o;
              if (m < NPR) { float* oc = F.out + O_CKV + (size_t)m * 512 + k0; *(GAS f32x4*)oc = ya; *(GAS f32x4*)(oc + 4) = yb; } }
            if (lane < 32) { float lo = krraw[(size_t)m * 64 + lane], hi = krraw[(size_t)m * 64 + lane + 32];
                if (m < NPR) { F.out[O_KR + (size_t)m * 64 + lane] = lo; F.out[O_KR + (size_t)m * 64 + lane + 32] = hi; }
                else { const int t = (m - NPR) & 4095; const f32x2 cs = *(const GAS f32x2*)(tab + ((size_t)t * 32 + lane) * 2); const float l2 = lo * cs.x - hi * cs.y, h2 = hi * cs.x + lo * cs.y; lo = l2; hi = h2; }
                *(GAS unsigned*)(Kr + (size_t)keyrow * 64 + 2 * lane) = pk2(lo, hi); }
        } else {
            const int idx = m - NROW, b = idx >> 9, s = idx & 511, keyrow = NPR + b * 4608 + s, k0 = lane * 8;
            const f32x4 a = *(const GAS f32x4*)(inp(3) + (size_t)idx * 512 + k0), bb = *(const GAS f32x4*)(inp(3) + (size_t)idx * 512 + k0 + 4);
            v4u o; o.x = pk2(a.x, a.y); o.y = pk2(a.z, a.w); o.z = pk2(bb.x, bb.y); o.w = pk2(bb.z, bb.w);
            *(GAS v4u*)(ckvn + (size_t)keyrow * 512 + k0) = o;
            if (lane < 32) *(GAS unsigned*)(Kr + (size_t)keyrow * 64 + 2 * lane) = pk2(inp(4)[(size_t)idx * 64 + lane], inp(4)[(size_t)idx * 64 + lane + 32]);
        }
    }
}
__device__ __forceinline__ void scan_task(Frame& F, int seq, int g, int dir) {
    const int lane = F.lane; const bool prompt = seq < 32; const int nc = prompt ? 16 : 256, cbase = prompt ? seq * 16 : 512 + (seq - 32) * 256;
    const f32x2 aT = ((const f32x2*)(F.ws + WS_PAR + 512 * 1024))[(dir * 128 + g) * 64 + lane];
    float hr = 0.f, hi = 0.f;
    if (!prompt) { const size_t si = ((size_t)((seq - 32) * 2 + dir) * 2) * 8192 + g * 64 + lane; hr = inp(5)[si]; hi = inp(5)[si + 8192]; }
    const float* S = (const float*)(F.ws + WS_A) + ((size_t)g * NCHUNK + cbase) * 256 + dir * 128 + lane;
    bf16* Hb = (bf16*)(F.ws + WS_UH) + ((size_t)g * NCHUNK + cbase) * 512 + 256 + dir * 128 + lane;
    for (int c0 = 0; c0 < nc; c0 += 8) { float sr[8], si[8];
#pragma unroll
        for (int e = 0; e < 8; ++e) { const int c = dir == 0 ? c0 + e : nc - 1 - (c0 + e); sr[e] = S[(size_t)c * 256]; si[e] = S[(size_t)c * 256 + 64]; }
#pragma unroll
        for (int e = 0; e < 8; ++e) { const int c = dir == 0 ? c0 + e : nc - 1 - (c0 + e);
            Hb[(size_t)c * 512] = (bf16)f2bf(hr); Hb[(size_t)c * 512 + 64] = (bf16)f2bf(hi);
            const float nr = aT.x * hr - aT.y * hi + sr[e], ni = aT.x * hi + aT.y * hr + si[e]; hr = nr; hi = ni; } }
    if (prompt) { float* o = F.out + O_S5 + ((size_t)(seq * 2 + dir) * 2) * 8192 + g * 64 + lane; o[0] = hr; o[8192] = hi; }
}
__device__ __forceinline__ void p4b_scan(Frame& F) {
    const int gw = F.vcu * NWAVES + F.wave, NGW = F.G * NWAVES;
    for (int t = gw; t < 2048; t += NGW) {
        if (t < 1024) scan_task(F, 32 + (t >> 8), (t >> 1) & 127, t & 1);
        else { const int base = (t - 1024) * 8; for (int e = 0; e < 8; ++e) { const int q = base + e; scan_task(F, q >> 8, (q >> 1) & 127, q & 1); } }
    }
}
__device__ __forceinline__ void p9_rowpass(Frame& F) {
    const int gw = F.vcu * NWAVES + F.wave, NGW = F.G * NWAVES, lane = F.lane; const float* par = (const float*)(F.ws + WS_PAR);
    const bf16* ob = (const bf16*)(F.ws + WS_OUTB); const float* ostat = (const float*)(F.ws + WS_OSTAT); bf16* H2 = (bf16*)(F.ws + WS_A);
    for (int m = gw; m < NROW; m += NGW) { const int cd = cond_of_row(m); const GAS f32x4* xr = (const GAS f32x4*)xrow_of(F, m) + lane;
        const float r1 = 1.0f / sqrtf(wave_sum(ostat[(size_t)m * 64 + lane]) * (1.0f / DM) + EPSN);
        const GAS f32x4* P2 = (const GAS f32x4*)(par + 2 * 20480 + cd * 4096) + lane; const GAS u32x2* o2 = (const GAS u32x2*)(ob + (size_t)m * DM) + lane;
        GAS u32x2* xo = (GAS u32x2*)(F.out + O_Y + (size_t)m * DM + DM / 2) + lane;
        f32x4 v[16]; float s = 0.f;
#pragma unroll
        for (int j = 0; j < 16; ++j) { const u32x2 w = o2[64 * j]; const f32x4 o = (f32x4){__uint_as_float(w.x << 16), __uint_as_float(w.x & 0xffff0000u), __uint_as_float(w.y << 16), __uint_as_float(w.y & 0xffff0000u)};
            v[j] = xr[64 * j] + P2[64 * j] * o * r1; xo[64 * j] = (u32x2){pk2(v[j].x, v[j].y), pk2(v[j].z, v[j].w)}; s += (v[j].x * v[j].x + v[j].y * v[j].y) + (v[j].z * v[j].z + v[j].w * v[j].w); }
        const float r2 = 1.0f / sqrtf(wave_sum(s) * (1.0f / DM) + EPSN);
        const GAS f32x4* A = (const GAS f32x4*)(par + 3 * 20480 + cd * 4096) + lane; const GAS f32x4* B = (const GAS f32x4*)(par + 4 * 20480 + cd * 4096) + lane;
        GAS u32x2* o8 = (GAS u32x2*)(H2 + (size_t)m * DM) + lane;
#pragma unroll
        for (int j = 0; j < 16; ++j) { const f32x4 y = v[j] * r2 * A[64 * j] + B[64 * j]; o8[64 * j] = (u32x2){pk2(y.x, y.y), pk2(y.z, y.w)}; } }
    LAS float* scr = (LAS float*)(F.lds + RING_OFF + F.wave * 16384);
    constexpr int I_F1 = (4096 / 64) * (16384 / 32), I_F2 = (16384 / 64) * (4096 / 32);
    conv_run<1>(inp(27), inp(28), nullptr, nullptr, F.ws, I_F1 + I_F2, gw, NGW, scr, lane);
}
__device__ __forceinline__ void p12_rowpass(Frame& F) {
    const int gw = F.vcu * NWAVES + F.wave, NGW = F.G * NWAVES, lane = F.lane; const float* par = (const float*)(F.ws + WS_PAR);
    const bf16* ab = (const bf16*)(F.ws + WS_A); const float* ostat = (const float*)(F.ws + WS_OSTAT);
    for (int m = gw; m < NROW; m += NGW) { const int cd = cond_of_row(m);
        const float r1 = 1.0f / sqrtf(wave_sum(ostat[(size_t)m * 64 + lane]) * (1.0f / DM) + EPSN);
        const GAS f32x4* P5 = (const GAS f32x4*)(par + 5 * 20480 + cd * 4096) + lane; const GAS u32x2* o2 = (const GAS u32x2*)(ab + (size_t)m * DM) + lane;
        GAS f32x4* yo = (GAS f32x4*)(F.out + O_Y + (size_t)m * DM) + lane; const GAS u32x2* xo = (const GAS u32x2*)(F.out + O_Y + (size_t)m * DM + DM / 2) + lane;
        u32x2 xw[16], aw[16];
#pragma unroll
        for (int j = 0; j < 16; ++j) { xw[j] = xo[64 * j]; aw[j] = o2[64 * j]; }
        asm volatile("s_waitcnt vmcnt(0)" ::: "memory");
#pragma unroll
        for (int j = 0; j < 16; ++j) { const u32x2 w = aw[j], x = xw[j];
            const f32x4 o = (f32x4){__uint_as_float(w.x << 16), __uint_as_float(w.x & 0xffff0000u), __uint_as_float(w.y << 16), __uint_as_float(w.y & 0xffff0000u)};
            const f32x4 x1 = (f32x4){__uint_as_float(x.x << 16), __uint_as_float(x.x & 0xffff0000u), __uint_as_float(x.y << 16), __uint_as_float(x.y & 0xffff0000u)};
            yo[64 * j] = x1 + P5[64 * j] * o * r1; } }
}

struct Args { const float* in[30]; float* out; unsigned char* ws; };
__global__ void __launch_bounds__(NWAVES * 64, 2) mk_fwd(Args args) {
    extern __shared__ __attribute__((aligned(16))) unsigned char lds[];
    Frame F;
    F.lds = (LAS unsigned char*)lds;
    F.MISC = (volatile LAS unsigned*)(F.lds + MISC_OFF);
    F.tid = threadIdx.x; F.lane = F.tid & 63; F.wave = __builtin_amdgcn_readfirstlane(F.tid >> 6);
    F.G = gridDim.x; { const int bx = blockIdx.x; F.vcu = (F.G % 8 == 0) ? (bx % 8) * (F.G / 8) + bx / 8 : bx; }
    F.out = args.out; F.ws = args.ws;
    unsigned char* ws = args.ws;
    F.ctl = (gu32*)(ws + WS_CTL);
    for (int u = F.tid; u < (LDS_BYTES - LDSCTL_OFF) / 4; u += NWAVES * 64) ((LAS unsigned*)(F.lds + LDSCTL_OFF))[u] = 0u;
    __syncthreads();
    XcdBarrier bar = xcd_barrier_post((unsigned*)(F.ctl + CW_BAR), F.MISC + 8);
#define REFRESH() do { int t_ = threadIdx.x; asm volatile("" : "+v"(t_)); F.tid = t_; F.lane = t_ & 63; } while (0)
#define GRID_BAR() do { xcd_barrier(bar); REFRESH(); } while (0)
    typedef pg8::bf16_t bt;
    const int bx = (int)blockIdx.x;

    p0_prologue(F); GRID_BAR();
    p0b_modreduce(F); GRID_BAR();
    p1_modnorm(F); GRID_BAR();
    { pg8::Gemm g{(const bt*)(ws + WS_A), (const bt*)(ws + WS_WIN), 4096, 4096, 4096}; pg8::StaticOrder S; S.init(NROW, NIN, F.G, bx);
      pg8::EpiIn E{(bt*)(ws + WS_QRAW), (float*)(ws + WS_CKVRAW), (float*)(ws + WS_KRRAW), (bt*)(ws + WS_UH), (bt*)(ws + WS_GA), (bt*)(ws + WS_GB), (float*)(ws + WS_QSTAT), (float*)(ws + WS_KVSTAT)};
      pg8::gemm_phase<pg8::EpiIn, pg8::StaticOrder, true, true>(F.lds + RING_OFF, g, S, E); }
    GRID_BAR();
    p3_rowpass(F); __syncthreads(); REFRESH();
    { pg8::Gemm g{(const bt*)(ws + WS_UH), (const bt*)(ws + WS_MSTATE), 512, 256, 256}; pg8::GroupOrder S{768, 6, F.G, bx};
      pg8::EpiS E{(float*)(ws + WS_A)};
      pg8::gemm_phase<pg8::EpiS, pg8::GroupOrder, true, true>(F.lds + RING_OFF, g, S, E); }
    GRID_BAR();
    p4b_scan(F); GRID_BAR();
    { pg8::Gemm g{(const bt*)(ws + WS_UH), (const bt*)(ws + WS_MCAT), 512, 512, 512}; pg8::GroupOrder S{768, 6, F.G, bx};
      pg8::EpiY E{(bt*)(ws + WS_YG)};
      pg8::gemm_phase<pg8::EpiY, pg8::GroupOrder, true, true>(F.lds + RING_OFF, g, S, E); }
    GRID_BAR();
    { pg8::Gemm g{(const bt*)(ws + WS_QN), (const bt*)(ws + WS_WUQ), 1024, 1024, 1024}; pg8::StaticOrder S; S.init(NROW, 6144, F.G, bx);
      pg8::EpiQ E{(bt*)(ws + WS_Q), (const float*)(ws + WS_TAB), QSCALE};
      pg8::gemm_phase<pg8::EpiQ, pg8::StaticOrder, true, true>(F.lds + RING_OFF, g, S, E); }
    { pg8::Gemm g{(const bt*)(ws + WS_CKVN), (const bt*)(ws + WS_WUKV), 512, 512, 512}; pg8::StaticOrder S; S.init(NKEY, 8192, F.G, bx);
      pg8::EpiBf E{(bt*)(ws + WS_KV), 8192};
      pg8::gemm_phase<pg8::EpiBf, pg8::StaticOrder, true, true>(F.lds + RING_OFF, g, S, E); }
    GRID_BAR();
    { const att::bf16* Q = (const att::bf16*)(ws + WS_Q); const att::bf16* KV = (const att::bf16*)(ws + WS_KV); const att::bf16* KR = (const att::bf16*)(ws + WS_KR);
      const att::bf16* GA = (const att::bf16*)(ws + WS_GA); att::bf16* MO = (att::bf16*)(ws + WS_A);
      for (int u = F.vcu; u < 3072; u += F.G) {
          int h, qrow0, krow0, seq;
          if (u < 2048) { const int bh = u >> 4, qb = u & 15, b = bh >> 5; h = bh & 31; qrow0 = NPR + b * 4096 + qb * 256; krow0 = NPR + b * 4608; seq = 4608; }
          else { const int v = u - 2048, b = v >> 5; h = v & 31; qrow0 = b * 256; krow0 = b * 256; seq = 256; }
          att::attn_unit(Q + (size_t)qrow0 * 6144 + h * 128, Q + (size_t)qrow0 * 6144 + 4096 + h * 64, KV + (size_t)krow0 * 8192 + h * 256, KV + (size_t)krow0 * 8192 + h * 256 + 128,
                         KR + (size_t)krow0 * 64, GA + (size_t)qrow0 * 4096 + h * 128, MO + (size_t)qrow0 * 4096 + h * 128, seq, (char*)lds + RING_OFF);
      }
      }
    GRID_BAR();
    { pg8::Gemm g{(const bt*)(ws + WS_YG), (const bt*)(ws + WS_WGLU), 2048, 2048, 2048}; pg8::StaticOrder S; S.init(NROW, 8192, F.G, bx);
      pg8::EpiGlu E{(bt*)(ws + WS_A), (const bt*)(ws + WS_GB)};
      pg8::gemm_phase<pg8::EpiGlu, pg8::StaticOrder, true, true>(F.lds + RING_OFF, g, S, E); }
    GRID_BAR();
    { pg8::Gemm g{(const bt*)(ws + WS_A), (const bt*)(ws + WS_WOUT), 4096, 4096, 4096}; pg8::StaticOrder S; S.init(NROW, 4096, F.G, bx);
      pg8::EpiStat E{(bt*)(ws + WS_OUTB), (float*)(ws + WS_OSTAT)};
      pg8::gemm_phase<pg8::EpiStat, pg8::StaticOrder, true, true>(F.lds + RING_OFF, g, S, E); }
    GRID_BAR();
    p9_rowpass(F); GRID_BAR();
    { pg8::Gemm g{(const bt*)(ws + WS_A), (const bt*)(ws + WS_WFF1), 4096, 4096, 4096}; pg8::StaticOrder S; S.init(NROW, 16384, F.G, bx);
      pg8::EpiRelu2 E{(bt*)(ws + WS_A1)};
      pg8::gemm_phase<pg8::EpiRelu2, pg8::StaticOrder, true, true>(F.lds + RING_OFF, g, S, E);
    }
    GRID_BAR();
    { pg8::Gemm g{(const bt*)(ws + WS_A1), (const bt*)(ws + WS_WFF2), 16384, 16384, 16384}; pg8::StaticOrder S; S.init(NROW, 4096, F.G, bx);
      pg8::EpiStat E{(bt*)(ws + WS_A), (float*)(ws + WS_OSTAT)};
      if (F.G == 256) { pg8::PairOrder P{NROW / 256, bx}; pg8::gemm_phase<pg8::EpiStat, pg8::PairOrder, true, true>(F.lds + RING_OFF, g, P, E); }
      else pg8::gemm_phase<pg8::EpiStat, pg8::StaticOrder, true, true>(F.lds + RING_OFF, g, S, E); }
    GRID_BAR();
    p12_rowpass(F);
#undef GRID_BAR
#undef REFRESH
}

extern "C" void kernel_launch(void* const* d_in, const int* in_sizes, int n_in, void* d_out, int out_size, void* d_ws, size_t ws_size, hipStream_t stream) {
    static int grid = 0;
    if (grid == 0) {
        if (n_in != 30 || in_sizes[0] != NPR * DM || out_size != (int)O_END || ws_size < WS_END) { fprintf(stderr, "kernel_launch: shape mismatch (n_in %d, in0 %d, out %d, ws %zu; need ws >= %zu); nothing launched\n", n_in, n_in > 0 ? in_sizes[0] : -1, out_size, ws_size, (size_t)WS_END); grid = -1; return; }
        int dev = 0, cus = 0, per_cu = 0;
        if (hipGetDevice(&dev) != hipSuccess || hipDeviceGetAttribute(&cus, hipDeviceAttributeMultiprocessorCount, dev) != hipSuccess) { grid = -1; return; }
        if (hipFuncSetAttribute((const void*)mk_fwd, hipFuncAttributeMaxDynamicSharedMemorySize, LDS_BYTES) != hipSuccess) { fprintf(stderr, "kernel_launch: hipFuncSetAttribute failed\n"); grid = -1; return; }
        if (hipOccupancyMaxActiveBlocksPerMultiprocessor(&per_cu, (const void*)mk_fwd, NWAVES * 64, LDS_BYTES) != hipSuccess || per_cu < 1) { fprintf(stderr, "kernel_launch: occupancy query reports %d workgroups per CU\n", per_cu); }
        (void)hipGetLastError();
        grid = cus;
    }
    if (grid < 0) return;
    if (hipMemsetAsync((char*)d_ws + WS_CTL, 0, CTL_ZERO_BYTES, stream) != hipSuccess) return;
    Args a{};
    for (int i = 0; i < 30; ++i) a.in[i] = (const float*)d_in[i];
    a.out = (float*)d_out; a.ws = (unsigned char*)d_ws;
    hipLaunchKernelGGL(mk_fwd, dim3(grid), dim3(NWAVES * 64), LDS_BYTES, stream, a);
    const hipError_t le = hipPeekAtLastError();
    if (le != hipSuccess) fprintf(stderr, "kernel_launch: launch failed: %s\n", hipGetErrorName(le));
}
```

```cpp
#include <hip/hip_runtime.h>
#include <cstdio>
#include <cstdint>
namespace pg8 {
#define PG8_LAS __attribute__((address_space(3)))
typedef unsigned short bf16_t;
typedef short bf16x8 __attribute__((ext_vector_type(8)));
typedef float f32x4 __attribute__((ext_vector_type(4)));
typedef unsigned u32x4 __attribute__((ext_vector_type(4)));
constexpr int BM = 256, BK = 64, HALF = 128, HTB = HALF * BK * 2  , STAGE_BYTES = 8 * HTB, NXCD = 8, WGM = 4;

__host__ __device__ __forceinline__ int lds_byte(int r, int c) { const int st = (r >> 4) * 2 + (c >> 5), rr = r & 15, cc = c & 31, ob = rr * 64 + cc * 2; return st * 1024 + (ob ^ (((ob >> 9) & 1) << 5)); }
__host__ __device__ __forceinline__ void stage_rc(int b, int& R, int& C) { const int st = b / 1024, sb = b % 1024, swz = sb ^ (((sb >> 9) & 1) << 5); R = (st >> 1) * 16 + swz / 64; C = (st & 1) * 32 + (swz % 64) / 2; }
__host__ __device__ __forceinline__ int perm32(int rho) { const int n = rho >> 4, i = rho & 15; return 8 * (i >> 2) + 4 * n + (i & 3); }

struct Unit { int pm, pn; };
struct Gemm { const bf16_t* A; const bf16_t* Bt; int lda, ldb, K; };

struct StaticOrder {
    int nM, nN, nwg, G, c;
    __host__ __device__ void init(int M, int N, int G_, int c_) { nM = M / BM; nN = N / BM; nwg = nM * nN; G = G_; c = c_; }
    __host__ __device__ bool next(int i, Unit& u) const {
        const long L = (long)i * G + c; if (L >= nwg) return false;
        int wgid = (int)L; { const int q = nwg / NXCD, r = nwg % NXCD, xcd = wgid % NXCD, off = wgid / NXCD; wgid = (xcd < r ? xcd * (q + 1) : r * (q + 1) + (xcd - r) * q) + off; }
        const int nig = WGM * nN, gid = wgid / nig, fm = gid * WGM, gsz = (nM - fm) < WGM ? (nM - fm) : WGM;
        u.pm = fm + ((wgid % nig) % gsz); u.pn = (wgid % nig) / gsz; return true;
    }
    __device__ __forceinline__ void a_ready(const Unit&) const {}
    __device__ __forceinline__ void done(const Unit&) const {}
};
struct GroupOrder {
    int nunits, per, G, c;
    __device__ bool next(int i, Unit& u) const { const int L = i * G + c; if (L >= nunits) return false; u.pm = L; u.pn = L / per; return true; }
    __device__ __forceinline__ void a_ready(const Unit&) const {}
    __device__ __forceinline__ void done(const Unit&) const {}
};

struct ShareOrder {
    int nM, c, share;
    __device__ bool next(int i, Unit& u) const { const int rpr = 32 / share; if (i * rpr >= nM) return false;
        const int xcd = c & 7, j = c >> 3; u.pm = rpr * i + 4 * (xcd / share) + (j & 3); u.pn = (xcd % share) * 8 + (j >> 2); return true; }
    __device__ __forceinline__ void a_ready(const Unit&) const {}
    __device__ __forceinline__ void done(const Unit&) const {}
};

__device__ __forceinline__ unsigned cvt_pk_bf16(float lo, float hi) { unsigned r; asm volatile("v_cvt_pk_bf16_f32 %0, %1, %2" : "=v"(r) : "v"(lo), "v"(hi)); return r; }
__device__ __forceinline__ u32x4 pack8(const f32x4 a, const f32x4 b) { u32x4 w; w.x = cvt_pk_bf16(a[0], a[1]); w.y = cvt_pk_bf16(a[2], a[3]); w.z = cvt_pk_bf16(b[0], b[1]); w.w = cvt_pk_bf16(b[2], b[3]); return w; }
__device__ __forceinline__ float bflo(unsigned w) { return __uint_as_float(w << 16); }
__device__ __forceinline__ float bfhi(unsigned w) { return __uint_as_float(w & 0xffff0000u); }
__device__ __forceinline__ float sigm(float x) { return __builtin_amdgcn_rcpf(1.0f + __builtin_amdgcn_exp2f(-1.4426950408889634f * x)); }
__device__ __forceinline__ float gelu_tanh(float y) { return y * sigm(1.5957691216057308f * (y + 0.044715f * y * y * y)); }
__device__ __forceinline__ float sumsq8(const f32x4 a, const f32x4 b) { return (a[0] * a[0] + a[1] * a[1]) + (a[2] * a[2] + a[3] * a[3]) + (b[0] * b[0] + b[1] * b[1]) + (b[2] * b[2] + b[3] * b[3]); }

struct EpiIn {
    static constexpr bool PERM = true, AFTER_DRAIN = false;
    bf16_t* qraw; float* ckvraw; float* krraw; bf16_t* UH; bf16_t* ga; bf16_t* gb; float* qstat; float* kvstat;
    __device__ __forceinline__ void operator()(const f32x4 (&acc)[2][2][4][2], const Unit& u, int wr, int wc, int fr, int fq) const {
        asm volatile("" : "+v"(fr), "+v"(fq));
        const int row0 = u.pm * BM + wr * 64 + fr, colL = wc * 32 + 8 * fq, pn = u.pn;
        if (pn < 4) {
#pragma unroll
            for (int ai = 0; ai < 2; ++ai)
#pragma unroll
                for (int m = 0; m < 4; ++m) { const int row = row0 + ai * HALF + m * 16; float ss = 0.f;
#pragma unroll
                    for (int bj = 0; bj < 2; ++bj) { const f32x4 a = acc[ai][bj][m][0], b = acc[ai][bj][m][1]; ss += sumsq8(a, b);
                        *(u32x4*)(qraw + (size_t)row * 1024 + pn * 256 + bj * HALF + colL) = pack8(a, b); }
                    ss += __shfl_xor(ss, 16); ss += __shfl_xor(ss, 32);
                    if (fq == 0) qstat[row * 16 + pn * 4 + wc] = ss; }
        } else if (pn < 6) {
            const int t = pn - 4;
#pragma unroll
            for (int ai = 0; ai < 2; ++ai)
#pragma unroll
                for (int m = 0; m < 4; ++m) { const int row = row0 + ai * HALF + m * 16; float ss = 0.f;
#pragma unroll
                    for (int bj = 0; bj < 2; ++bj) { const f32x4 a = acc[ai][bj][m][0], b = acc[ai][bj][m][1]; ss += sumsq8(a, b);
                        float* p = ckvraw + (size_t)row * 512 + t * 256 + bj * HALF + colL; *(f32x4*)p = a; *(f32x4*)(p + 4) = b; }
                    ss += __shfl_xor(ss, 16); ss += __shfl_xor(ss, 32);
                    if (fq == 0) kvstat[row * 8 + t * 4 + wc] = ss; }
        } else if (pn < 14) {
            const int t = pn - 6;
#pragma unroll
            for (int ai = 0; ai < 2; ++ai)
#pragma unroll
                for (int m = 0; m < 4; ++m) { const int row = row0 + ai * HALF + m * 16;
#pragma unroll
                    for (int bj = 0; bj < 2; ++bj) { const int col = t * 256 + bj * HALF + colL, g = col >> 4, j0 = col & 15;
                        *(u32x4*)(UH + ((size_t)g * 1536 + (row >> 4)) * 512 + (row & 15) * 16 + j0) = pack8(acc[ai][bj][m][0], acc[ai][bj][m][1]); } }
        } else if (pn < 46) {
            bf16_t* dst = pn < 30 ? ga + (pn - 14) * 256 : gb + (pn - 30) * 256;
#pragma unroll
            for (int ai = 0; ai < 2; ++ai)
#pragma unroll
                for (int m = 0; m < 4; ++m) { const int row = row0 + ai * HALF + m * 16;
#pragma unroll
                    for (int bj = 0; bj < 2; ++bj) *(u32x4*)(dst + (size_t)row * 4096 + bj * HALF + colL) = pack8(acc[ai][bj][m][0], acc[ai][bj][m][1]); }
        } else {
            if (wc < 2) {
#pragma unroll
                for (int ai = 0; ai < 2; ++ai)
#pragma unroll
                    for (int m = 0; m < 4; ++m) { const int row = row0 + ai * HALF + m * 16; float* p = krraw + (size_t)row * 64 + colL;
                        *(f32x4*)p = acc[ai][0][m][0]; *(f32x4*)(p + 4) = acc[ai][0][m][1]; }
            }
        }
    }
};
struct EpiBf {
    static constexpr bool PERM = true, AFTER_DRAIN = false;
    bf16_t* O; int ldc;
    __device__ __forceinline__ void operator()(const f32x4 (&acc)[2][2][4][2], const Unit& u, int wr, int wc, int fr, int fq) const {
        asm volatile("" : "+v"(fr), "+v"(fq));
        const int row0 = u.pm * BM + wr * 64 + fr, col0 = u.pn * BM + wc * 32 + 8 * fq;
#pragma unroll
        for (int ai = 0; ai < 2; ++ai)
#pragma unroll
            for (int m = 0; m < 4; ++m) { bf16_t* rowp = O + (size_t)(row0 + ai * HALF + m * 16) * ldc + col0;
#pragma unroll
                for (int bj = 0; bj < 2; ++bj) *(u32x4*)(rowp + bj * HALF) = pack8(acc[ai][bj][m][0], acc[ai][bj][m][1]); }
    }
};
struct EpiQ {
    static constexpr bool PERM = true, AFTER_DRAIN = false;
    bf16_t* Q; const float* tab; float c2;
    __device__ __forceinline__ void operator()(const f32x4 (&acc)[2][2][4][2], const Unit& u, int wr, int wc, int fr, int fq) const {
        asm volatile("" : "+v"(fr), "+v"(fq));
        const int row0 = u.pm * BM + wr * 64 + fr, col0 = u.pn * BM + wc * 32 + 8 * fq;
        const bool rope = (u.pn >= 16) && (u.pm >= 32);
#pragma unroll
        for (int ai = 0; ai < 2; ++ai)
#pragma unroll
            for (int m = 0; m < 4; ++m) { const int row = row0 + ai * HALF + m * 16; bf16_t* rowp = Q + (size_t)row * 6144 + col0;
#pragma unroll
                for (int bj = 0; bj < 2; ++bj) { f32x4 a = acc[ai][bj][m][0], b = acc[ai][bj][m][1];
                    if (rope) { const int t = (row - 8192) & 4095, p0 = ((col0 + bj * HALF - 4096) & 63) >> 1;
                        const f32x4 cs0 = *(const f32x4*)(tab + ((size_t)t * 32 + p0) * 2), cs1 = *(const f32x4*)(tab + ((size_t)t * 32 + p0 + 2) * 2);
                        f32x4 ra, rb;
                        ra[0] = a[0] * cs0[0] - a[1] * cs0[1]; ra[1] = a[1] * cs0[0] + a[0] * cs0[1]; ra[2] = a[2] * cs0[2] - a[3] * cs0[3]; ra[3] = a[3] * cs0[2] + a[2] * cs0[3];
                        rb[0] = b[0] * cs1[0] - b[1] * cs1[1]; rb[1] = b[1] * cs1[0] + b[0] * cs1[1]; rb[2] = b[2] * cs1[2] - b[3] * cs1[3]; rb[3] = b[3] * cs1[2] + b[2] * cs1[3];
                        a = ra; b = rb; }
                    *(u32x4*)(rowp + bj * HALF) = pack8(a * c2, b * c2); } }
    }
};
struct EpiS {
    static constexpr bool PERM = false, AFTER_DRAIN = false;
    float* S;
    __device__ __forceinline__ void operator()(const f32x4 (&acc)[2][2][4][2], const Unit& u, int wr, int wc, int fr, int fq) const {
        asm volatile("" : "+v"(fr), "+v"(fq));
        const int row0 = u.pm * BM + wr * 64 + fr, col0 = wc * 32 + 4 * fq;
#pragma unroll
        for (int ai = 0; ai < 2; ++ai)
#pragma unroll
            for (int m = 0; m < 4; ++m) { float* rowp = S + (size_t)(row0 + ai * HALF + m * 16) * 256 + col0;
#pragma unroll
                for (int bj = 0; bj < 2; ++bj)
#pragma unroll
                    for (int n = 0; n < 2; ++n) *(f32x4*)(rowp + bj * HALF + n * 16) = acc[ai][bj][m][n]; }
    }
};
struct EpiY {
    static constexpr bool PERM = true, AFTER_DRAIN = false;
    bf16_t* Yg;
    __device__ __forceinline__ void operator()(const f32x4 (&acc)[2][2][4][2], const Unit& u, int wr, int wc, int fr, int fq) const {
        asm volatile("" : "+v"(fr), "+v"(fq));
        const int g = u.pn, c0 = (u.pm - 6 * g) * BM + wr * 64 + fr, n0 = wc * 32 + 8 * fq;
#pragma unroll
        for (int ai = 0; ai < 2; ++ai)
#pragma unroll
            for (int m = 0; m < 4; ++m) { const int c = c0 + ai * HALF + m * 16;
#pragma unroll
                for (int bj = 0; bj < 2; ++bj) { const int nn = bj * HALF + n0, tau = nn >> 4, j0 = nn & 15; f32x4 a = acc[ai][bj][m][0], b = acc[ai][bj][m][1];
#pragma unroll
                    for (int e = 0; e < 4; ++e) { a[e] = gelu_tanh(a[e]); b[e] = gelu_tanh(b[e]); }
                    *(u32x4*)(Yg + (size_t)(c * 16 + tau) * 2048 + g * 16 + j0) = pack8(a, b); } }
    }
};
struct EpiGlu {
    static constexpr bool PERM = true, AFTER_DRAIN = false;
    bf16_t* M; const bf16_t* gb;
    __device__ __forceinline__ void operator()(const f32x4 (&acc)[2][2][4][2], const Unit& u, int wr, int wc, int fr, int fq) const {
        asm volatile("" : "+v"(fr), "+v"(fq));
        const int row0 = u.pm * BM + wr * 64 + fr, col0 = u.pn * HALF + wc * 32 + 8 * fq;
#pragma unroll
        for (int ai = 0; ai < 2; ++ai)
#pragma unroll
            for (int m = 0; m < 4; ++m) { const size_t off = (size_t)(row0 + ai * HALF + m * 16) * 4096 + col0;
                const u32x4 gv = *(const u32x4*)(gb + off), mv = *(const u32x4*)(M + off); f32x4 o0, o1;
#pragma unroll
                for (int e = 0; e < 4; ++e) { const unsigned gw = gv[e >> 1], mw = mv[e >> 1];
                    const float g = (e & 1) ? bfhi(gw) : bflo(gw), ma = (e & 1) ? bfhi(mw) : bflo(mw);
                    o0[e] = sigm(g) * (acc[ai][0][m][0][e] * sigm(acc[ai][1][m][0][e])) + ma; }
#pragma unroll
                for (int e = 0; e < 4; ++e) { const unsigned gw = gv[2 + (e >> 1)], mw = mv[2 + (e >> 1)];
                    const float g = (e & 1) ? bfhi(gw) : bflo(gw), ma = (e & 1) ? bfhi(mw) : bflo(mw);
                    o1[e] = sigm(g) * (acc[ai][0][m][1][e] * sigm(acc[ai][1][m][1][e])) + ma; }
                *(u32x4*)(M + off) = pack8(o0, o1); }
    }
};
struct EpiStat {
    static constexpr bool PERM = true, AFTER_DRAIN = false;
    bf16_t* O; float* stat;
    __device__ __forceinline__ void operator()(const f32x4 (&acc)[2][2][4][2], const Unit& u, int wr, int wc, int fr, int fq) const {
        asm volatile("" : "+v"(fr), "+v"(fq));
        const int row0 = u.pm * BM + wr * 64 + fr, col0 = u.pn * BM + wc * 32 + 8 * fq;
#pragma unroll
        for (int ai = 0; ai < 2; ++ai)
#pragma unroll
            for (int m = 0; m < 4; ++m) { const int row = row0 + ai * HALF + m * 16; float ss = 0.f;
#pragma unroll
                for (int bj = 0; bj < 2; ++bj) { const f32x4 a = acc[ai][bj][m][0], b = acc[ai][bj][m][1]; ss += sumsq8(a, b);
                    *(u32x4*)(O + (size_t)row * 4096 + col0 + bj * HALF) = pack8(a, b); }
                ss += __shfl_xor(ss, 16); ss += __shfl_xor(ss, 32);
                if (fq == 0) stat[row * 64 + u.pn * 4 + wc] = ss; }
    }
};
struct EpiRelu2 {
    static constexpr bool PERM = true, AFTER_DRAIN = false;
    bf16_t* O;
    __device__ __forceinline__ void operator()(const f32x4 (&acc)[2][2][4][2], const Unit& u, int wr, int wc, int fr, int fq) const {
        asm volatile("" : "+v"(fr), "+v"(fq));
        const int row0 = u.pm * BM + wr * 64 + fr, col0 = u.pn * BM + wc * 32 + 8 * fq;
#pragma unroll
        for (int ai = 0; ai < 2; ++ai)
#pragma unroll
            for (int m = 0; m < 4; ++m) { bf16_t* rowp = O + (size_t)(row0 + ai * HALF + m * 16) * 16384 + col0;
#pragma unroll
                for (int bj = 0; bj < 2; ++bj) { f32x4 a = acc[ai][bj][m][0], b = acc[ai][bj][m][1];
#pragma unroll
                    for (int e = 0; e < 4; ++e) { const float x = fmaxf(a[e], 0.f), y = fmaxf(b[e], 0.f); a[e] = x * x; b[e] = y * y; }
                    *(u32x4*)(rowp + bj * HALF) = pack8(a, b); } }
    }
};

template <class Epi, class Sched, bool ALIGN_EPI = false, bool SP2 = false>
__device__ __forceinline__ void gemm_phase(PG8_LAS unsigned char* lds, const Gemm g, const Sched& S, const Epi& E) {
    int tid_ = threadIdx.x; asm volatile("" : "+v"(tid_));
    const int tid = tid_, wid = __builtin_amdgcn_readfirstlane(tid >> 6), lane = tid & 63, wr = wid >> 2, wc = wid & 3, fr = lane & 15, fq = lane >> 4;
    const int K = g.K, nt = K / BK, lda = g.lda, ldb = g.ldb;
    unsigned voffA[2], voffB[2];
#pragma unroll
    for (int i = 0; i < 2; ++i) { int R, C; stage_rc(tid * 16 + i * 8192, R, C); const int Rb = Epi::PERM ? ((R & ~31) + perm32(R & 31)) : R;
        voffA[i] = (unsigned)(R * lda + C) * 2u; voffB[i] = (unsigned)(Rb * ldb + C) * 2u; }
    const size_t kstep = (size_t)(BK * 2);
    const size_t hstepA = (size_t)HALF * lda * 2, hstepB = (size_t)HALF * ldb * 2;
    const size_t tstepA = 2 * hstepA, tstepB = 2 * hstepB;
    const unsigned ldsw = (unsigned)wid * 1024u;
    const int aoff = lds_byte(wr * 64 + fr, fq * 8), boff = lds_byte(wc * 32 + fr, fq * 8);
#define PG8_SA(b, h) (((b) * 2 + (h)) * HTB)
#define PG8_SB(b, h) ((4 + (b) * 2 + (h)) * HTB)
#define PG8_STAGE(bufoff, gbase, voff) do { _Pragma("unroll") for (int _i = 0; _i < 2; ++_i) \
        __builtin_amdgcn_global_load_lds((const unsigned*)((const char*)(gbase) + (voff)[_i]), (PG8_LAS unsigned*)(lds + (bufoff) + ldsw + _i * 8192), 16, 0, 0); } while (0)
#define PG8_LDA(dst, b, h) do { _Pragma("unroll") for (int m = 0; m < 4; ++m) _Pragma("unroll") for (int k = 0; k < 2; ++k) dst[m][k] = *(const PG8_LAS bf16x8*)(lds + PG8_SA(b, h) + aoff + m * 2048 + k * 1024); } while (0)
#define PG8_LDB(dst, b, h) do { _Pragma("unroll") for (int n = 0; n < 2; ++n) _Pragma("unroll") for (int k = 0; k < 2; ++k) dst[n][k] = *(const PG8_LAS bf16x8*)(lds + PG8_SB(b, h) + boff + n * 2048 + k * 1024); } while (0)
#define PG8_MMA(ai, bj, At, Bt) do { __builtin_amdgcn_s_setprio(1); _Pragma("unroll") for (int m = 0; m < 4; ++m) _Pragma("unroll") for (int n = 0; n < 2; ++n) _Pragma("unroll") for (int k = 0; k < 2; ++k) \
        acc[ai][bj][m][n] = __builtin_amdgcn_mfma_f32_16x16x32_bf16(Bt[n][k], At[m][k], acc[ai][bj][m][n], 0, 0, 0); __builtin_amdgcn_s_setprio(0); } while (0)
#define PG8_WAIT_V(n) asm volatile("s_waitcnt vmcnt(" #n ")" ::: "memory")
#define PG8_WAIT_L(n) asm volatile("s_waitcnt lgkmcnt(" #n ")" ::: "memory")
#define PG8_BAR __builtin_amdgcn_s_barrier()
#define PG8_SCHED __builtin_amdgcn_sched_barrier(0)
    Unit cur, nxt; int ui = 0;
    if (!S.next(0, cur)) return;
    f32x4 acc[2][2][4][2];
#pragma unroll
    for (int a = 0; a < 2; ++a)
#pragma unroll
        for (int b = 0; b < 2; ++b)
#pragma unroll
            for (int m = 0; m < 4; ++m)
#pragma unroll
                for (int n = 0; n < 2; ++n) acc[a][b][m][n] = (f32x4){0.f, 0.f, 0.f, 0.f};
    bf16x8 At[4][2], B0[2][2], B1[2][2];
    const char* cA = (const char*)g.A + (size_t)cur.pm * tstepA; const char* cB = (const char*)g.Bt + (size_t)cur.pn * tstepB;
    S.a_ready(cur);
    if constexpr (SP2) {
        PG8_STAGE(PG8_SB(0, 0), cB, voffB); PG8_STAGE(PG8_SB(0, 1), cB + hstepB, voffB); PG8_STAGE(PG8_SA(0, 0), cA, voffA); PG8_STAGE(PG8_SA(0, 1), cA + hstepA, voffA);
        if (wr == 1) PG8_BAR;
        PG8_WAIT_V(2); PG8_BAR;
        PG8_STAGE(PG8_SB(1, 0), cB + kstep, voffB); PG8_STAGE(PG8_SA(1, 0), cA + kstep, voffA); PG8_STAGE(PG8_SB(1, 1), cB + hstepB + kstep, voffB);
        PG8_WAIT_V(6); PG8_BAR;
    } else {
        PG8_STAGE(PG8_SB(0, 0), cB, voffB); PG8_STAGE(PG8_SA(0, 0), cA, voffA); PG8_STAGE(PG8_SB(0, 1), cB + hstepB, voffB); PG8_STAGE(PG8_SA(0, 1), cA + hstepA, voffA);
        if (wr == 1) PG8_BAR;
        PG8_WAIT_V(4); PG8_BAR;
        PG8_STAGE(PG8_SB(1, 0), cB + kstep, voffB); PG8_STAGE(PG8_SA(1, 0), cA + kstep, voffA); PG8_STAGE(PG8_SB(1, 1), cB + hstepB + kstep, voffB);
        PG8_WAIT_V(6); PG8_BAR;
    }
    for (;;) {
        const bool has_next = S.next(ui + 1, nxt);
        const char* nA = has_next ? (const char*)g.A + (size_t)nxt.pm * tstepA : cA; const char* nB = has_next ? (const char*)g.Bt + (size_t)nxt.pn * tstepB : cB;
        for (int t = 0; t < nt; t += 2) {
            const bool last = (t == nt - 2);
            const char* a1 = cA + (size_t)(t + 1) * kstep;
            const char* a2 = last ? nA : cA + (size_t)(t + 2) * kstep; const char* b2 = last ? nB : cB + (size_t)(t + 2) * kstep;
            const char* a3 = a2 + kstep; const char* b3 = b2 + kstep;
            if (last && has_next) S.a_ready(nxt);
            if constexpr (SP2) {
            PG8_LDB(B0, 0, 0); PG8_LDB(B1, 0, 1); PG8_SCHED; PG8_LDA(At, 0, 0); PG8_STAGE(PG8_SA(1, 1), a1 + hstepA, voffA);
            PG8_WAIT_V(8); PG8_WAIT_L(0); PG8_BAR; PG8_MMA(0, 0, At, B0); PG8_MMA(0, 1, At, B1); PG8_BAR; PG8_SCHED;
            PG8_LDA(At, 0, 1); PG8_STAGE(PG8_SB(0, 0), b2, voffB); PG8_STAGE(PG8_SB(0, 1), b2 + hstepB, voffB); PG8_STAGE(PG8_SA(0, 0), a2, voffA);
            PG8_WAIT_V(8); PG8_WAIT_L(0); PG8_BAR; PG8_MMA(1, 0, At, B0); PG8_MMA(1, 1, At, B1); PG8_BAR; PG8_SCHED;
            PG8_LDB(B0, 1, 0); PG8_LDB(B1, 1, 1); PG8_SCHED; PG8_LDA(At, 1, 0); PG8_STAGE(PG8_SA(0, 1), a2 + hstepA, voffA);
            PG8_WAIT_V(8); PG8_WAIT_L(0); PG8_BAR; PG8_MMA(0, 0, At, B0); PG8_MMA(0, 1, At, B1); PG8_BAR; PG8_SCHED;
            PG8_LDA(At, 1, 1); PG8_STAGE(PG8_SB(1, 0), b3, voffB); PG8_STAGE(PG8_SB(1, 1), b3 + hstepB, voffB); PG8_STAGE(PG8_SA(1, 0), a3, voffA);
            PG8_WAIT_V(8); PG8_WAIT_L(0); PG8_BAR; PG8_MMA(1, 0, At, B0); PG8_MMA(1, 1, At, B1); PG8_BAR; PG8_SCHED;
            } else {
            PG8_LDB(B0, 0, 0); PG8_SCHED; PG8_LDA(At, 0, 0); PG8_STAGE(PG8_SA(1, 1), a1 + hstepA, voffA);
            PG8_WAIT_L(8); PG8_BAR; PG8_WAIT_L(0); PG8_MMA(0, 0, At, B0); PG8_BAR; PG8_SCHED;
            PG8_LDB(B1, 0, 1); PG8_STAGE(PG8_SB(0, 0), b2, voffB);
            PG8_BAR; PG8_WAIT_L(0); PG8_MMA(0, 1, At, B1); PG8_BAR;
            PG8_LDA(At, 0, 1); PG8_STAGE(PG8_SA(0, 0), a2, voffA);
            PG8_BAR; PG8_WAIT_L(0); PG8_MMA(1, 0, At, B0); PG8_BAR; PG8_SCHED;
            PG8_STAGE(PG8_SB(0, 1), b2 + hstepB, voffB);
            PG8_WAIT_V(6); PG8_BAR; PG8_MMA(1, 1, At, B1); PG8_BAR;
            PG8_LDB(B0, 1, 0); PG8_SCHED; PG8_LDA(At, 1, 0); PG8_STAGE(PG8_SA(0, 1), a2 + hstepA, voffA);
            PG8_WAIT_L(8); PG8_BAR; PG8_WAIT_L(0); PG8_MMA(0, 0, At, B0); PG8_BAR; PG8_SCHED;
            PG8_LDB(B1, 1, 1); PG8_STAGE(PG8_SB(1, 0), b3, voffB);
            PG8_BAR; PG8_WAIT_L(0); PG8_MMA(0, 1, At, B1); PG8_BAR;
            PG8_LDA(At, 1, 1); PG8_STAGE(PG8_SA(1, 0), a3, voffA);
            PG8_BAR; PG8_WAIT_L(0); PG8_MMA(1, 0, At, B0); PG8_BAR; PG8_SCHED;
            PG8_STAGE(PG8_SB(1, 1), b3 + hstepB, voffB);
            PG8_WAIT_V(6); PG8_BAR; PG8_MMA(1, 1, At, B1); PG8_BAR;
            }
        }
        if constexpr (ALIGN_EPI) { if (wr == 0) PG8_BAR; }
        if constexpr (!Epi::AFTER_DRAIN) { E(acc, cur, wr, wc, fr, fq); S.done(cur); }
        if (!has_next) break;
#pragma unroll
        for (int a = 0; a < 2; ++a)
#pragma unroll
            for (int b = 0; b < 2; ++b)
#pragma unroll
                for (int m = 0; m < 4; ++m)
#pragma unroll
                    for (int n = 0; n < 2; ++n) acc[a][b][m][n] = (f32x4){0.f, 0.f, 0.f, 0.f};
        cur = nxt; cA = nA; cB = nB; ++ui;
        if constexpr (ALIGN_EPI) { if (wr == 1) PG8_BAR; }
    }
    PG8_WAIT_V(0);
    if constexpr (!ALIGN_EPI) { if (wr == 0) PG8_BAR; }
    PG8_BAR;
    if constexpr (Epi::AFTER_DRAIN) { E.fused(acc, cur, wr, wc, fr, fq, lds, wid, lane); S.done(cur); }
#undef PG8_SA
#undef PG8_SB
#undef PG8_STAGE
#undef PG8_LDA
#undef PG8_LDB
#undef PG8_MMA
#undef PG8_WAIT_V
#undef PG8_WAIT_L
#undef PG8_BAR
#undef PG8_SCHED
}
}

namespace att {
using bf16x8 = __attribute__((ext_vector_type(8))) short;
using s16x4  = __attribute__((ext_vector_type(4))) short;
using f32x16 = __attribute__((ext_vector_type(16))) float;
using u32x4  = __attribute__((ext_vector_type(4))) unsigned;
typedef unsigned short bf16;
#ifndef ATT_SDEPTH
#define ATT_SDEPTH 1
#endif
constexpr int NW = 8, QBLK = 32, KVBLK = 64;
constexpr int SHM_V = 16384, SHM_K = 16384, SHM_R = 8192;
constexpr int OFF_V = 0, OFF_K = 2 * SHM_V, OFF_R = OFF_K + 2 * SHM_K, OFF_WS = OFF_R + 2 * SHM_R, ATT_LDS = OFF_WS + NW * 256;
constexpr int LDQ = 6144, LDK = 8192, LDR = 64, LDO = 4096;
constexpr float THR_L2 = 11.5415603f;
#define KSWZ(row, colB) ((row) * 256 + ((colB) ^ (((row) & 15) << 4)))
#define RSWZ(row, colB) ((row) * 128 + ((colB) ^ ((((row) >> 1) & 7) << 4)))
#define SBAR() __builtin_amdgcn_sched_barrier(0)
__device__ __forceinline__ int crow(int r, int hi) { return (r & 3) + 8 * (r >> 2) + 4 * hi; }
__device__ __forceinline__ unsigned cvtpk(float lo, float hi) { unsigned r; asm volatile("v_cvt_pk_bf16_f32 %0, %1, %2" : "=v"(r) : "v"(lo), "v"(hi)); return r; }
__device__ __forceinline__ bf16x8 ld8(const bf16* p) { return *reinterpret_cast<const bf16x8*>(p); }

__device__ __forceinline__ void partialSM(f32x16& p0, f32x16& p1, float& m_reg, float& mn, float& alpha) {
  float pmax = p0[0];
#pragma unroll
  for (int r = 1; r < 16; ++r) pmax = fmaxf(pmax, p0[r]);
#pragma unroll
  for (int r = 0; r < 16; ++r) pmax = fmaxf(pmax, p1[r]);
  { auto rr = __builtin_amdgcn_permlane32_swap(__float_as_uint(pmax), __float_as_uint(pmax), false, false);
    pmax = fmaxf(__uint_as_float(rr[0]), __uint_as_float(rr[1])); }
  if (__builtin_expect(__all(pmax - m_reg <= THR_L2), 1)) { mn = m_reg; alpha = 1.f; }
  else { mn = fmaxf(m_reg, pmax); alpha = __builtin_amdgcn_exp2f(m_reg - mn); m_reg = mn; }
#pragma unroll
  for (int r = 0; r < 16; ++r) p0[r] = p0[r] - mn;
#pragma unroll
  for (int r = 0; r < 16; ++r) p1[r] = p1[r] - mn;
#pragma unroll
  for (int r = 0; r < 16; ++r) p0[r] = __builtin_amdgcn_exp2f(p0[r]);
}
__device__ __forceinline__ void finishSM(f32x16& p0, f32x16& p1, float alpha, float& l_reg, bf16x8& pa0, bf16x8& pa1, bf16x8& pa2, bf16x8& pa3) {
#pragma unroll
  for (int r = 0; r < 16; ++r) p1[r] = __builtin_amdgcn_exp2f(p1[r]);
  float ps = 0;
#pragma unroll
  for (int r = 0; r < 16; ++r) ps += p0[r];
#pragma unroll
  for (int r = 0; r < 16; ++r) ps += p1[r];
  { auto rr = __builtin_amdgcn_permlane32_swap(__float_as_uint(ps), __float_as_uint(ps), false, false);
    ps = __uint_as_float(rr[0]) + __uint_as_float(rr[1]); }
  l_reg = l_reg * alpha + ps;
#define PK4(P, BASE, OUT) do { u32x4 w = {cvtpk(P[BASE + 0], P[BASE + 1]), cvtpk(P[BASE + 2], P[BASE + 3]), cvtpk(P[BASE + 4], P[BASE + 5]), cvtpk(P[BASE + 6], P[BASE + 7])}; OUT = *reinterpret_cast<bf16x8*>(&w); } while (0)
  PK4(p0, 0, pa0); PK4(p0, 8, pa1); PK4(p1, 0, pa2); PK4(p1, 8, pa3);
#undef PK4
}
__device__ __forceinline__ void qkt(f32x16& p0, f32x16& p1, const char* Ks, const char* Rs, const bf16x8* qn, const bf16x8* qr, int r32, int hi) {
  p0 = f32x16{}; p1 = f32x16{};
#pragma unroll
  for (int d0 = 0; d0 < 8; ++d0) { const int cb = (d0 * 16 + hi * 8) * 2;
    bf16x8 b0 = *reinterpret_cast<const bf16x8*>(Ks + KSWZ(r32, cb));
    bf16x8 b1 = *reinterpret_cast<const bf16x8*>(Ks + KSWZ(32 + r32, cb));
    p0 = __builtin_amdgcn_mfma_f32_32x32x16_bf16(b0, qn[d0], p0, 0, 0, 0);
    p1 = __builtin_amdgcn_mfma_f32_32x32x16_bf16(b1, qn[d0], p1, 0, 0, 0); }
#pragma unroll
  for (int d0 = 0; d0 < 4; ++d0) { const int cb = (d0 * 16 + hi * 8) * 2;
    bf16x8 b0 = *reinterpret_cast<const bf16x8*>(Rs + RSWZ(r32, cb));
    bf16x8 b1 = *reinterpret_cast<const bf16x8*>(Rs + RSWZ(32 + r32, cb));
    p0 = __builtin_amdgcn_mfma_f32_32x32x16_bf16(b0, qr[d0], p0, 0, 0, 0);
    p1 = __builtin_amdgcn_mfma_f32_32x32x16_bf16(b1, qr[d0], p1, 0, 0, 0); }
}
__device__ __forceinline__ int v_st(int k, int c) { const int kk = (k & ~0xC) | ((k & 4) << 1) | ((k & 8) >> 1); return ((kk >> 3) * 4 + (c >> 5)) * 512 + ((kk & 7) * 32 + (c & 31)) * 2; }
__device__ __forceinline__ int v_rd_base(int lane) { return ((lane & 3) << 3) | (((lane >> 2) & 3) << 6) | (((lane >> 4) & 1) << 5) | (((lane >> 5) & 1) << 8); }
constexpr int v_rd_off(int d0, int ks, int half) { return d0 * 512 + ks * 4096 + half * 2048; }
template <int OFF> __device__ __forceinline__ s16x4 tr_read(int vb) {
  s16x4 r; asm volatile("ds_read_b64_tr_b16 %0, %1 offset:%2" : "=&v"(r) : "v"(vb), "i"(OFF) : "memory"); return r;
}
template <int D0> __device__ __forceinline__ void pv_one(f32x16& od, int vb, bf16x8 pa0, bf16x8 pa1, bf16x8 pa2, bf16x8 pa3) {
  const s16x4 l0 = tr_read<v_rd_off(D0, 0, 0)>(vb), h0 = tr_read<v_rd_off(D0, 0, 1)>(vb), l1 = tr_read<v_rd_off(D0, 1, 0)>(vb), h1 = tr_read<v_rd_off(D0, 1, 1)>(vb);
  const s16x4 l2 = tr_read<v_rd_off(D0, 2, 0)>(vb), h2 = tr_read<v_rd_off(D0, 2, 1)>(vb), l3 = tr_read<v_rd_off(D0, 3, 0)>(vb), h3 = tr_read<v_rd_off(D0, 3, 1)>(vb);
  asm volatile("s_waitcnt lgkmcnt(0)" ::: "memory"); SBAR();
#define PK(L, H) (bf16x8){L[0], L[1], L[2], L[3], H[0], H[1], H[2], H[3]}
  od = __builtin_amdgcn_mfma_f32_32x32x16_bf16(pa0, PK(l0, h0), od, 0, 0, 0);
  od = __builtin_amdgcn_mfma_f32_32x32x16_bf16(pa1, PK(l1, h1), od, 0, 0, 0);
  od = __builtin_amdgcn_mfma_f32_32x32x16_bf16(pa2, PK(l2, h2), od, 0, 0, 0);
  od = __builtin_amdgcn_mfma_f32_32x32x16_bf16(pa3, PK(l3, h3), od, 0, 0, 0);
#undef PK
}
__device__ __forceinline__ void pv_d0(f32x16* o, int vb, bf16x8 pa0, bf16x8 pa1, bf16x8 pa2, bf16x8 pa3) {
  pv_one<0>(o[0], vb, pa0, pa1, pa2, pa3); pv_one<1>(o[1], vb, pa0, pa1, pa2, pa3); pv_one<2>(o[2], vb, pa0, pa1, pa2, pa3); pv_one<3>(o[3], vb, pa0, pa1, pa2, pa3);
}
__device__ __forceinline__ float sigm(float x) { return __builtin_amdgcn_rcpf(1.0f + __builtin_amdgcn_exp2f(-1.4426950408889634f * x)); }
__device__ __forceinline__ unsigned short f2bf(float f) { unsigned u = __float_as_uint(f); return (unsigned short)((u + 0x7fffu + ((u >> 16) & 1u)) >> 16); }

typedef __attribute__((address_space(3))) const char* lds_cptr;
typedef short v4i16_t __attribute__((ext_vector_type(4)));
typedef float f32x2_t __attribute__((ext_vector_type(2))); typedef __bf16 bf16x2_t __attribute__((ext_vector_type(2)));
__device__ __forceinline__ unsigned cvtpk_s(float lo, float hi) { f32x2_t v = {lo, hi}; bf16x2_t b = __builtin_convertvector(v, bf16x2_t); return __builtin_bit_cast(unsigned, b); }
__device__ __forceinline__ s16x4 vtr(lds_cptr p) { return __builtin_bit_cast(s16x4, __builtin_amdgcn_ds_read_tr16_b64_v4i16((__attribute__((address_space(3))) v4i16_t*)p)); }
#define EX2(x) __builtin_amdgcn_exp2f(x)
#define MFMA32(a, b, c) __builtin_amdgcn_mfma_f32_32x32x16_bf16(a, b, c, 0, 0, 0)
__device__ __forceinline__ void phaseA(f32x16& n0, f32x16& n1, const f32x16& q0, f32x16& q1, float alpha, float& l_reg, bf16x8& pa0, bf16x8& pa1, bf16x8& pa2, bf16x8& pa3,
                                       const char* Ks, const char* Rs, const bf16x8* qn, const bf16x8* qr, int kpre, int rpre, float ones_k0, float neg_m) {
  asm volatile("" : "+v"(kpre), "+v"(rpre));
  n0 = __builtin_amdgcn_mfma_f32_32x32x2f32(ones_k0, neg_m, f32x16{}, 0, 0, 0); n1 = __builtin_amdgcn_mfma_f32_32x32x2f32(ones_k0, neg_m, f32x16{}, 0, 0, 0);
  float s0 = 0.f, s1 = 0.f; unsigned ca0 = 0, ca1 = 0, cb0 = 0, cb1 = 0; float ps = 0.f;
#define PKA(P, B) do { ca0 = cvtpk_s(P[B + 0], P[B + 1]); ca1 = cvtpk_s(P[B + 2], P[B + 3]); } while (0)
#define PKB(P, B) do { cb0 = cvtpk_s(P[B + 4], P[B + 5]); cb1 = cvtpk_s(P[B + 6], P[B + 7]); } while (0)
#define PKS(OUT) do { u32x4 w_ = {ca0, ca1, cb0, cb1}; OUT = *reinterpret_cast<bf16x8*>(&w_); } while (0)
  constexpr int KPF = 2;
  bf16x8 kq0[KPF + 1], kq1[KPF + 1];
#define KFRAG(st) do { if ((st) < 8) { const int ad_ = kpre ^ ((st) * 32); kq0[(st) % (KPF + 1)] = *reinterpret_cast<const bf16x8*>(Ks + ad_); kq1[(st) % (KPF + 1)] = *reinterpret_cast<const bf16x8*>(Ks + ad_ + 8192); } \
    else { const int ad_ = rpre ^ (((st) - 8) * 32); kq0[(st) % (KPF + 1)] = *reinterpret_cast<const bf16x8*>(Rs + ad_); kq1[(st) % (KPF + 1)] = *reinterpret_cast<const bf16x8*>(Rs + ad_ + 4096); } } while (0)
#pragma unroll
  for (int s = 0; s < KPF; ++s) KFRAG(s);
#pragma unroll
  for (int s = 0; s < 12; ++s) {
    if (s + KPF < 12) KFRAG(s + KPF);
    const bf16x8 kb0 = kq0[s % (KPF + 1)], kb1 = kq1[s % (KPF + 1)];
    const bf16x8 qf = s < 8 ? qn[s < 8 ? s : 0] : qr[s >= 8 ? s - 8 : 0];
    n0 = MFMA32(kb0, qf, n0);
    if (s < 8) { q1[2 * s] = EX2(q1[2 * s]); s0 += q0[2 * s]; s0 += q0[2 * s + 1]; }
    if (s == 0) PKA(q0, 0); if (s == 1) PKS(pa0); if (s == 2) PKA(q0, 8); if (s == 3) PKS(pa1);
    if (s == 4) PKA(q1, 0); if (s == 5) PKS(pa2); if (s == 8) PKA(q1, 8); if (s == 9) PKS(pa3);
    if (s == 10) { ps = s0 + s1; auto rr = __builtin_amdgcn_permlane32_swap(__float_as_uint(ps), __float_as_uint(ps), false, false); ps = __uint_as_float(rr[0]) + __uint_as_float(rr[1]); }
    SBAR();
    n1 = MFMA32(kb1, qf, n1);
    if (s < 8) { q1[2 * s + 1] = EX2(q1[2 * s + 1]); }
    if (s >= 2 && s < 10) { s1 += q1[2 * (s - 2)]; s1 += q1[2 * (s - 2) + 1]; }
    if (s == 0) PKB(q0, 0); if (s == 2) PKB(q0, 8); if (s == 4) PKB(q1, 0); if (s == 8) PKB(q1, 8);
    if (s == 11) l_reg = l_reg * alpha + ps;
    SBAR();
  }
#undef KFRAG
#undef PKA
#undef PKB
#undef PKS
}
__device__ __forceinline__ void decide_rel(f32x16& p0, f32x16& p1, float& m_reg, float& alpha) {
  float a = fmaxf(fmaxf(p0[0], p0[1]), p1[0]), b = fmaxf(fmaxf(p0[2], p0[3]), p1[1]); a = fmaxf(fmaxf(a, p1[2]), p1[3]);
#pragma unroll
  for (int r = 4; r < 16; r += 4) { a = fmaxf(fmaxf(a, p0[r]), p0[r + 1]); b = fmaxf(fmaxf(b, p0[r + 2]), p0[r + 3]); a = fmaxf(fmaxf(a, p1[r]), p1[r + 1]); b = fmaxf(fmaxf(b, p1[r + 2]), p1[r + 3]); }
  float pmax = fmaxf(a, b);
  { auto rr = __builtin_amdgcn_permlane32_swap(__float_as_uint(pmax), __float_as_uint(pmax), false, false); pmax = fmaxf(__uint_as_float(rr[0]), __uint_as_float(rr[1])); }
  if (__builtin_expect(__all(pmax <= THR_L2), 1)) { alpha = 1.f; }
  else { const float d = fmaxf(pmax, 0.f); alpha = __builtin_amdgcn_exp2f(-d); m_reg += d;
#pragma unroll
    for (int r = 0; r < 16; ++r) { p0[r] -= d; p1[r] -= d; } }
}
__device__ __forceinline__ void decide(const f32x16& p0, const f32x16& p1, float& m_reg, float& mn, float& alpha) {
  float a = fmaxf(fmaxf(p0[0], p0[1]), p1[0]), b = fmaxf(fmaxf(p0[2], p0[3]), p1[1]); a = fmaxf(fmaxf(a, p1[2]), p1[3]);
#pragma unroll
  for (int r = 4; r < 16; r += 4) { a = fmaxf(fmaxf(a, p0[r]), p0[r + 1]); b = fmaxf(fmaxf(b, p0[r + 2]), p0[r + 3]); a = fmaxf(fmaxf(a, p1[r]), p1[r + 1]); b = fmaxf(fmaxf(b, p1[r + 2]), p1[r + 3]); }
  float pmax = fmaxf(a, b);
  { auto rr = __builtin_amdgcn_permlane32_swap(__float_as_uint(pmax), __float_as_uint(pmax), false, false); pmax = fmaxf(__uint_as_float(rr[0]), __uint_as_float(rr[1])); }
  mn = fmaxf(m_reg, pmax); alpha = __builtin_amdgcn_exp2f(m_reg - mn); m_reg = mn;
}
typedef __attribute__((address_space(3))) char* lds_ptr;
struct DmaArgs { const bf16* kt; const bf16* rt; const bf16* vt; int koff0, koff1, roff, voff0, voff1; int dk, dr, dv; lds_ptr l3; };
#define GLDS(src, dstoff) __builtin_amdgcn_global_load_lds((const unsigned*)(src), (__attribute__((address_space(3))) unsigned*)(D.l3 + (dstoff)), 16, 0, 0)
constexpr int VPF = 3;
__device__ __forceinline__ void phaseB_pre(s16x4 (&l)[VPF + 1], s16x4 (&h)[VPF + 1], lds_cptr vp) {
#pragma unroll
  for (int i = 0; i < VPF; ++i) { l[i] = vtr(vp + v_rd_off(i >> 2, i & 3, 0)); h[i] = vtr(vp + v_rd_off(i >> 2, i & 3, 1)); }
}
template <bool DOK, bool DOV> __device__ __forceinline__ void phaseB(f32x16* o, f32x16& n0, f32x16& n1, bf16x8 pa0, bf16x8 pa1, bf16x8 pa2, bf16x8 pa3, lds_cptr vp,
                                                                          s16x4 (&l)[VPF + 1], s16x4 (&h)[VPF + 1], const DmaArgs& D) {
  constexpr int PF = VPF;
#pragma unroll
  for (int i = 0; i < 16; ++i) { const int d0 = i >> 2, ks = i & 3;
    if (i + PF < 16) { l[(i + PF) % (PF + 1)] = vtr(vp + v_rd_off((i + PF) >> 2, (i + PF) & 3, 0)); h[(i + PF) % (PF + 1)] = vtr(vp + v_rd_off((i + PF) >> 2, (i + PF) & 3, 1)); }
    const s16x4 lc = l[i % (PF + 1)], hc = h[i % (PF + 1)];
    const bf16x8 vf = (bf16x8){lc[0], lc[1], lc[2], lc[3], hc[0], hc[1], hc[2], hc[3]};
    o[d0] = MFMA32(ks == 0 ? pa0 : ks == 1 ? pa1 : ks == 2 ? pa2 : pa3, vf, o[d0]);
    n0[i] = EX2(n0[i]);
    {
      if (DOV && i == 0) GLDS(D.vt + D.voff0, D.dv);
      if (DOV && i == 1) GLDS(D.vt + D.voff1, D.dv + 1024);
      if (DOK && i == 2) GLDS(D.kt + D.koff0, D.dk);
      if (DOK && i == 3) GLDS(D.kt + D.koff1, D.dk + 1024);
      if (DOK && i == 4) GLDS(D.rt + D.roff, D.dr); }
    SBAR(); }
}
#undef GLDS

__device__ __forceinline__ void attn_unit(const bf16* __restrict__ Qn, const bf16* __restrict__ Qr, const bf16* __restrict__ Kh, const bf16* __restrict__ Vh,
                                          const bf16* __restrict__ Kr, const bf16* __restrict__ Ga, bf16* __restrict__ Mo, int seq, char* lds) {
  int tid_ = threadIdx.x; asm volatile("" : "+v"(tid_));
  const int tid = tid_, lane = tid & 63, r32 = lane & 31, hi = lane >> 5; const int wid = __builtin_amdgcn_readfirstlane(tid >> 6);
  char* V_lds = lds + OFF_V; char* K_lds = lds + OFF_K; char* R_lds = lds + OFF_R;
  const lds_ptr l3 = (lds_ptr)lds;
  float* ws = (float*)(lds + OFF_WS) + wid * 64; float* li_l = ws; float* al_l = ws + 32;
  float m_reg = -1e30f, l_reg = 0; f32x16 o[4] = {}; bf16x8 qn[8], qr[4];
  int koff[2], voff[2], roff;
#pragma unroll
  for (int i = 0; i < 2; ++i) { const int bi = wid * 2 + i;
    { const int row = 4 * bi + (lane >> 4), lc = (lane & 15) ^ (row & 15); koff[i] = row * LDK + lc * 8; }
    { const int k = (bi >> 1) * 8 + ((lane & 31) >> 2), cc = (2 * (bi & 1) + (lane >> 5)) * 32 + (lane & 3) * 8; voff[i] = k * LDK + cc; } }
  { const int row = 8 * wid + (lane >> 3), lc = (lane & 7) ^ ((row >> 1) & 7); roff = row * LDR + lc * 8; }
#define GLDS(src, dstoff) __builtin_amdgcn_global_load_lds((const unsigned*)(src), (__attribute__((address_space(3))) unsigned*)(l3 + (dstoff)), 16, 0, 0)
#define DMA_K(t, b) do { const bf16* ks_ = Kh + (long)(t) * KVBLK * LDK; GLDS(ks_ + koff[0], OFF_K + (b) * SHM_K + (wid * 2) * 1024); GLDS(ks_ + koff[1], OFF_K + (b) * SHM_K + (wid * 2 + 1) * 1024); \
    GLDS(Kr + (long)(t) * KVBLK * LDR + roff, OFF_R + (b) * SHM_R + wid * 1024); } while (0)
#define DMA_V(t, b) do { const bf16* vs_ = Vh + (long)(t) * KVBLK * LDK; GLDS(vs_ + voff[0], OFF_V + (b) * SHM_V + (wid * 2) * 1024); GLDS(vs_ + voff[1], OFF_V + (b) * SHM_V + (wid * 2 + 1) * 1024); } while (0)
#define RESC(a) do { if (__any((a) < 1.f)) { if (hi == 0) al_l[r32] = (a); asm volatile("s_waitcnt lgkmcnt(0)" ::: "memory"); \
    _Pragma("unroll") for (int d = 0; d < 4; ++d) _Pragma("unroll") for (int r = 0; r < 16; ++r) o[d][r] *= al_l[crow(r, hi)]; } } while (0)
  const int NT = seq / KVBLK;
  DMA_K(0, 0);
  { const bf16* Qw = Qn + (long)(wid * QBLK + r32) * LDQ + hi * 8;
#pragma unroll
    for (int d0 = 0; d0 < 8; ++d0) qn[d0] = ld8(Qw + d0 * 16);
    const bf16* Rw = Qr + (long)(wid * QBLK + r32) * LDQ + hi * 8;
#pragma unroll
    for (int d0 = 0; d0 < 4; ++d0) qr[d0] = ld8(Rw + d0 * 16); }
  const lds_cptr vp0 = (lds_cptr)V_lds + v_rd_base(lane);
  const int kpre = (r32 * 256 + ((r32 & 15) << 4)) ^ (hi * 16), rpre = (r32 * 128 + (((r32 >> 1) & 7) << 4)) ^ (hi * 16);
  f32x16 pA0, pA1, pB0, pB1; float mnA, alA, alB; bf16x8 pa0, pa1, pa2, pa3;
  const float ones_k0 = hi ? 0.f : 1.f;
  __syncthreads();
  DMA_K(1, 1); DMA_V(0, 0);
  qkt(pA0, pA1, K_lds, R_lds, qn, qr, r32, hi); decide(pA0, pA1, m_reg, mnA, alA);
#pragma unroll
  for (int r = 0; r < 16; ++r) { pA0[r] = EX2(pA0[r] - mnA); pA1[r] = pA1[r] - mnA; }
  __syncthreads();
  s16x4 vl[VPF + 1], vh[VPF + 1];
  DmaArgs D; D.koff0 = koff[0]; D.koff1 = koff[1]; D.roff = roff; D.voff0 = voff[0]; D.voff1 = voff[1]; D.l3 = l3;
#define DSET(tk, bk, tv, bv) do { D.kt = Kh + (long)(tk) * KVBLK * LDK; D.rt = Kr + (long)(tk) * KVBLK * LDR; D.vt = Vh + (long)(tv) * KVBLK * LDK; \
    D.dk = OFF_K + (bk) * SHM_K + (wid * 2) * 1024; D.dr = OFF_R + (bk) * SHM_R + wid * 1024; D.dv = OFF_V + (bv) * SHM_V + (wid * 2) * 1024; } while (0)
  for (int j = 1; j + 1 < NT; j += 2) {
    DSET(j + 1, 0, j, 1);
    SBAR(); phaseA(pB0, pB1, pA0, pA1, alA, l_reg, pa0, pa1, pa2, pa3, K_lds + SHM_K, R_lds + SHM_R, qn, qr, kpre, rpre, ones_k0, -m_reg);
    phaseB_pre(vl, vh, vp0);
    decide_rel(pB0, pB1, m_reg, alB); SBAR();
    phaseB<true, true>(o, pB0, pB1, pa0, pa1, pa2, pa3, vp0, vl, vh, D);
    RESC(alB); __syncthreads();
    DSET(j + 2, 1, j + 1, 0);
    SBAR(); phaseA(pA0, pA1, pB0, pB1, alB, l_reg, pa0, pa1, pa2, pa3, K_lds, R_lds, qn, qr, kpre, rpre, ones_k0, -m_reg);
    phaseB_pre(vl, vh, vp0 + SHM_V);
    decide_rel(pA0, pA1, m_reg, alA); SBAR();
    phaseB<true, true>(o, pA0, pA1, pa0, pa1, pa2, pa3, vp0 + SHM_V, vl, vh, D);
    RESC(alA); __syncthreads();
  }
  DSET(NT - 1, 0, NT - 1, 1);
  SBAR(); phaseA(pB0, pB1, pA0, pA1, alA, l_reg, pa0, pa1, pa2, pa3, K_lds + SHM_K, R_lds + SHM_R, qn, qr, kpre, rpre, ones_k0, -m_reg);
  phaseB_pre(vl, vh, vp0);
  decide_rel(pB0, pB1, m_reg, alB); SBAR();
  phaseB<false, true>(o, pB0, pB1, pa0, pa1, pa2, pa3, vp0, vl, vh, D);
  RESC(alB); __syncthreads();
#undef DSET
  finishSM(pB0, pB1, alB, l_reg, pa0, pa1, pa2, pa3); SBAR();
  pv_d0(o, (int)(unsigned)(uintptr_t)V_lds + v_rd_base(lane) + SHM_V, pa0, pa1, pa2, pa3);
  if (hi == 0) li_l[r32] = l_reg; asm volatile("s_waitcnt lgkmcnt(0)" ::: "memory");
  float rli[16];
#pragma unroll
  for (int r = 0; r < 16; ++r) rli[r] = __builtin_amdgcn_rcpf(li_l[crow(r, hi)]);
  bf16* Ow = Mo + (long)(wid * QBLK) * LDO; const bf16* Gw = Ga + (long)(wid * QBLK) * LDO;
#pragma unroll
  for (int r = 0; r < 16; ++r) { const int orow = crow(r, hi);
#pragma unroll
    for (int d0 = 0; d0 < 4; ++d0) { const long off = (long)orow * LDO + d0 * 32 + r32;
      const float g = __uint_as_float((unsigned)Gw[off] << 16);
      Ow[off] = f2bf(o[d0][r] * rli[r] * sigm(g)); } }
  __syncthreads();
#undef GLDS
#undef DMA_K
#undef DMA_V
#undef RESC
}
#undef KSWZ
#undef RSWZ
#undef SBAR
}

constexpr int NWAVES = 8;
constexpr int DM = 4096, NPR = 8192, NROW = 24576;
constexpr int NKEY = 8192 + 4 * 4608;
constexpr int NIN = 12032;
constexpr int NCHUNK = NROW / 16;
constexpr float EPSN = 1e-6f;
constexpr float QSCALE = 0.07216878364870322f * 1.4426950408889634f;
constexpr size_t O_Y = 0, O_CKV = 100663296, O_KR = 104857600, O_S5 = 105381888, O_END = 106430464;

constexpr size_t MiB = 1u << 20;
constexpr size_t WS_CTL = 0, CTL_ZERO_BYTES = 1 * MiB;
constexpr size_t WS_PAR = 1 * MiB;
constexpr size_t WS_TAB = 2 * MiB;
constexpr size_t WS_QSTAT = 3 * MiB;
constexpr size_t WS_KVSTAT = 5 * MiB;
constexpr size_t WS_OSTAT = 6 * MiB;
constexpr size_t WS_MODPART = 12 * MiB;
constexpr size_t WS_WGLU = 28 * MiB, WS_WOUT = 60 * MiB, WS_WUQ = 92 * MiB, WS_WUKV = 104 * MiB;
constexpr size_t WS_GA = 112 * MiB, WS_GB = 304 * MiB;
constexpr size_t WS_WFF1 = 112 * MiB, WS_WFF2 = 240 * MiB;
constexpr size_t WS_A = 496 * MiB;
constexpr size_t WS_X = 688 * MiB;
constexpr size_t WS_WIN = WS_X, WS_MSTATE = WS_X + 94 * MiB, WS_MCAT = WS_X + 110 * MiB, WS_QRAW = WS_X + 142 * MiB, WS_CKVRAW = WS_X + 190 * MiB,
                 WS_KRRAW = WS_X + 238 * MiB, WS_UH = WS_X + 244 * MiB;
constexpr size_t WS_Q = WS_X, WS_KV = WS_X + 288 * MiB;
constexpr size_t WS_OUTB = WS_X;
constexpr size_t WS_A1 = WS_X;
constexpr size_t WS_QN = 1392 * MiB, WS_CKVN = 1440 * MiB, WS_KR = 1466 * MiB, WS_YG = 1470 * MiB, WS_END = 1566 * MiB;
static_assert(WS_WIN + (size_t)NIN * 4096 * 2 <= WS_MSTATE && WS_UH + (size_t)128 * 1536 * 512 * 2 <= WS_QN && WS_KV + (size_t)NKEY * 8192 * 2 <= WS_QN, "arena");
static_assert(WS_KR + (size_t)NKEY * 64 * 2 <= WS_YG && WS_CKVN + (size_t)NKEY * 512 * 2 <= WS_KR && WS_A1 + (size_t)NROW * 16384 * 2 <= WS_END, "arena 2");
constexpr int CW_TMO = 0, CW_CODE = 1, CW_BAR = 4096;

constexpr int RING_OFF = 0, RING_BYTES = 131072;
constexpr int LDSCTL_OFF = RING_BYTES, MISC_OFF = LDSCTL_OFF + 320;
constexpr int LDS_BYTES = 147456;
static_assert(att::ATT_LDS <= RING_BYTES, "attention LDS");

#define GAS __attribute__((address_space(1)))
#define LAS __attribute__((address_space(3)))
typedef unsigned short bf16;
typedef unsigned v4u __attribute__((ext_vector_type(4)));
typedef float f32x4 __attribute__((ext_vector_type(4)));
typedef short bf16x8 __attribute__((ext_vector_type(8)));
typedef GAS unsigned gu32;
typedef GAS unsigned long long gu64;
#define RLX_AGENT __ATOMIC_RELAXED, __HIP_MEMORY_SCOPE_AGENT
#define LDS_WAIT() asm volatile("s_waitcnt lgkmcnt(0)" ::: "memory")
#define VM_WAIT() asm volatile("s_waitcnt vmcnt(0)" ::: "memory")
__device__ __forceinline__ unsigned long long rt() { return __builtin_amdgcn_s_memrealtime(); }
__device__ __forceinline__ unsigned f2bf(float f) { unsigned u = __builtin_bit_cast(unsigned, f); return (u + 0x7fffu + ((u >> 16) & 1u)) >> 16; }
__device__ __forceinline__ unsigned pk2(float lo, float hi) { return f2bf(lo) | (f2bf(hi) << 16); }

#define XB_TMO      128
#define XB_XCNT(j)  (256  + 64 * (j))
#define XB_XSUB(j)  (1280 + 64 * (j))
#define XB_XGEN(j)  (2304 + 64 * (j))
#define XB_TOP      3328
#define XB_TOPGEN   3392
#define XCD_BAR_WORDS 3456
#define XB_SPIN_CAP (1u << 18)

__device__ __forceinline__ unsigned xb_ld(unsigned* p)              { return __hip_atomic_load(p, __ATOMIC_RELAXED, __HIP_MEMORY_SCOPE_AGENT); }
__device__ __forceinline__ unsigned xb_add(unsigned* p, unsigned v) { return __hip_atomic_fetch_add(p, v, __ATOMIC_RELAXED, __HIP_MEMORY_SCOPE_AGENT); }
__device__ __forceinline__ unsigned xb_xcc_id() { return (unsigned)__builtin_amdgcn_s_getreg((3 << 11) | 20) & 0xFu; }
#define XB_SPIN(cond, bar) do { unsigned _sp = 0; while (cond) { __builtin_amdgcn_s_sleep(1); \
    if ((++_sp & 255u) == 0u) { if (xb_ld(&(bar)[XB_TMO])) break; if (_sp > XB_SPIN_CAP) { atomicAdd(&(bar)[XB_TMO], 1u); break; } } } } while (0)

struct XcdBarrier {
    unsigned* bar; unsigned x;
    volatile LAS unsigned* st;
};

__device__ __forceinline__ XcdBarrier xcd_barrier_post(unsigned* bar, volatile LAS unsigned* st) {
    XcdBarrier b; b.bar = bar; b.x = xb_xcc_id(); b.st = st;
    if (threadIdx.x == 0) (void)xb_add(&bar[XB_XCNT(b.x)], 1u);
    return b;
}
__device__ __forceinline__ void xcd_barrier_complete(unsigned* bar, unsigned x, unsigned& nloc, unsigned& nx) {
    const unsigned G = gridDim.x * gridDim.y * gridDim.z;
    unsigned sum, cnt, mine, sp = 0u;
    for (;;) {
        sum = 0u; cnt = 0u; mine = 0u;
#pragma unroll
        for (unsigned j = 0; j < 16; ++j) { const unsigned c = xb_ld(&bar[XB_XCNT(j)]); sum += c; cnt += (c > 0u) ? 1u : 0u; mine = (j == x) ? c : mine; }
        if (sum == G) break;
        __builtin_amdgcn_s_sleep(1);
        if ((++sp & 255u) == 0u) { if (xb_ld(&bar[XB_TMO])) break; if (sp > XB_SPIN_CAP) { atomicAdd(&bar[XB_TMO], 1u); break; } }
    }
    nloc = mine > 0u ? mine : 1u; nx = cnt > 0u ? cnt : 1u;
}

__device__ __forceinline__ void xcd_barrier(const XcdBarrier& b) {
    asm volatile("s_waitcnt vmcnt(0)" ::: "memory");
    __syncthreads();
    if (threadIdx.x == 0) {
        unsigned* bar = b.bar;
        __builtin_amdgcn_s_waitcnt(0);
        unsigned nloc = b.st[0], nx = b.st[1];
        if (nloc == 0u) { xcd_barrier_complete(bar, b.x, nloc, nx); b.st[0] = nloc; b.st[1] = nx; }
        const unsigned old = xb_add(&bar[XB_XSUB(b.x)], 1u);
        const unsigned gen = old / nloc;
        if (old + 1u == (gen + 1u) * nloc) {
            __builtin_amdgcn_fence(__ATOMIC_RELEASE, "agent");
            asm volatile("s_waitcnt vmcnt(0)" ::: "memory");
            const unsigned og = xb_add(&bar[XB_TOP], 1u);
            const unsigned tg = og / nx;
            if (og + 1u == (tg + 1u) * nx) xb_add(&bar[XB_TOPGEN], 1u);
            else XB_SPIN(xb_ld(&bar[XB_TOPGEN]) == tg, bar);
            __builtin_amdgcn_fence(__ATOMIC_ACQUIRE, "agent");
            xb_add(&bar[XB_XGEN(b.x)], 1u);
            asm volatile("s_waitcnt vmcnt(0)" ::: "memory");
        } else {
            XB_SPIN(xb_ld(&bar[XB_XGEN(b.x)]) == gen, bar);
            __builtin_amdgcn_fence(__ATOMIC_ACQUIRE, "agent");
            asm volatile("s_waitcnt vmcnt(0)" ::: "memory");
        }
    }
    __syncthreads();
}


typedef float f32x2 __attribute__((ext_vector_type(2)));
typedef unsigned u32x2 __attribute__((ext_vector_type(2)));
struct Frame {
    LAS unsigned char* lds;
    volatile LAS unsigned* MISC;
    gu32* ctl;
    int tid, lane, wave;
    int vcu, G;
    float* out; unsigned char* ws;
};
typedef const float* cfp_t;
typedef __attribute__((address_space(4))) const cfp_t* kargp_t;
__device__ __forceinline__ const float* inp(int k) { kargp_t p = (kargp_t)__builtin_amdgcn_kernarg_segment_ptr(); asm volatile("" : "+s"(p)); return p[k]; }
__device__ __forceinline__ float wave_sum(float v) {
#pragma unroll
    for (int o = 1; o < 64; o <<= 1) v += __shfl_xor(v, o);
    return v;
}
__device__ __forceinline__ float bf2f(unsigned short h) { return __uint_as_float((unsigned)h << 16); }
__device__ __forceinline__ float sigmf(float x) { return __builtin_amdgcn_rcpf(1.0f + __builtin_amdgcn_exp2f(-1.4426950408889634f * x)); }

__device__ __forceinline__ int mapcol(int code, int n) {
    if (code == 1) return n < 1536 ? n : (n < 11776 ? n + 64 : (n < 11840 ? n - 11776 + 1536 : -1));
    if (code == 2) { if (n < 4096) return (n >> 7) * 192 + (n & 127); const int m = n - 4096, h = m >> 6, i = m & 63; return h * 192 + 128 + (i >> 1) + 32 * (i & 1); }
    if (code == 3) { const int t = n >> 8, r = n & 255; return r < 128 ? t * 128 + r : 4096 + t * 128 + (r - 128); }
    return n;
}
__device__ __forceinline__ void transpose_item(const float* W, int K, int Nsrc, int Ndst, int code, bf16* WT, LAS float* scr, int item, int lane) {
    const int nblk = Ndst / 32, kb = item / nblk, nb = item - kb * nblk, k0 = 64 * kb, n0 = 32 * nb;
    const int sc = mapcol(code, n0 + (lane & 31));
#pragma unroll 8
    for (int i = 0; i < 32; ++i) { const int kk = 2 * i + (lane >> 5); scr[kk * 33 + (lane & 31)] = sc >= 0 ? W[(size_t)(k0 + kk) * Nsrc + sc] : 0.f; }
    LDS_WAIT(); asm volatile("" ::: "memory");
    const int c = lane & 7;
#pragma unroll
    for (int j = 0; j < 4; ++j) { const int n = (lane >> 3) + 8 * j; const LAS float* s = scr + (8 * c) * 33 + n;
        v4u o; o.x = pk2(s[0 * 33], s[1 * 33]); o.y = pk2(s[2 * 33], s[3 * 33]); o.z = pk2(s[4 * 33], s[5 * 33]); o.w = pk2(s[6 * 33], s[7 * 33]);
        *(GAS v4u*)(WT + (size_t)(n0 + n) * K + k0 + 8 * c) = o; }
    LDS_WAIT(); asm volatile("" ::: "memory");
}

struct ConvJob { const float* W; bf16* WT; int K, Nsrc, Ndst, code, item; };
__device__ __forceinline__ void conv_item_kn(const ConvJob& j, int& kb, int& nb) {
    const int nblk = j.Ndst / 32;
    if (j.code == 0 && j.K >= 4096 && (nblk & 31) == 0) { const int r = j.item & 2047, q = j.item >> 11, kg = j.K / 4096; kb = (q % kg) * 64 + (r >> 5); nb = (q / kg) * 32 + (r & 31); }
    else { kb = j.item / nblk; nb = j.item - kb * nblk; }
}
__device__ __forceinline__ void conv_load(const ConvJob& j, int lane, f32x4 (&v)[8]) {
    int kb, nb; conv_item_kn(j, kb, nb); const int k0 = 64 * kb, n0 = 32 * nb, c4 = lane & 7, r8 = lane >> 3;
    const int sc = mapcol(j.code, n0 + c4 * 4);
    if (sc >= 0) {
#pragma unroll
        for (int i = 0; i < 8; ++i) v[i] = __builtin_nontemporal_load((const GAS f32x4*)(j.W + (size_t)(k0 + i * 8 + r8) * j.Nsrc + sc));
    } else {
#pragma unroll
        for (int i = 0; i < 8; ++i) v[i] = (f32x4){0.f, 0.f, 0.f, 0.f};
    }
}
__device__ __forceinline__ void conv_lds_write(LAS float* scr, int lane, const f32x4 (&v)[8]) {
    const int c4 = lane & 7, r8 = lane >> 3;
#pragma unroll
    for (int i = 0; i < 8; ++i) { LAS float* d = scr + (i * 8 + r8) * 33 + c4 * 4; d[0] = v[i].x; d[1] = v[i].y; d[2] = v[i].z; d[3] = v[i].w; }
}
__device__ __forceinline__ void conv_store(const ConvJob& j, LAS float* scr, int lane) {
    int kb, nb; conv_item_kn(j, kb, nb); const int k0 = 64 * kb, n0 = 32 * nb, c = lane & 7;
#pragma unroll
    for (int jj = 0; jj < 4; ++jj) { const int n = (lane >> 3) + 8 * jj; const LAS float* s = scr + (8 * c) * 33 + n;
        v4u o; o.x = pk2(s[0 * 33], s[1 * 33]); o.y = pk2(s[2 * 33], s[3 * 33]); o.z = pk2(s[4 * 33], s[5 * 33]); o.w = pk2(s[6 * 33], s[7 * 33]);
        *(GAS v4u*)(j.WT + (size_t)(n0 + n) * j.K + k0 + 8 * c) = o; }
}
template <int MODE>
__device__ __forceinline__ ConvJob conv_resolve(int r, const float* w0, const float* w1, const float* w2, const float* w3, unsigned char* ws) {
    ConvJob j;
    if (MODE == 0) {
        constexpr int I_IN = (4096 / 64) * (NIN / 32), I_UKV = (512 / 64) * (8192 / 32), I_GLU = (2048 / 64) * (8192 / 32);
        if (r < I_IN) { j.W = w0; j.WT = (bf16*)(ws + WS_WIN); j.K = 4096; j.Nsrc = 11840; j.Ndst = NIN; j.code = 1; j.item = r; }
        else if (r < I_IN + I_UKV) { j.W = w1; j.WT = (bf16*)(ws + WS_WUKV); j.K = 512; j.Nsrc = 8192; j.Ndst = 8192; j.code = 0; j.item = r - I_IN; }
        else if (r < I_IN + I_UKV + I_GLU) { j.W = w2; j.WT = (bf16*)(ws + WS_WGLU); j.K = 2048; j.Nsrc = 8192; j.Ndst = 8192; j.code = 3; j.item = r - I_IN - I_UKV; }
        else { j.W = w3; j.WT = (bf16*)(ws + WS_WOUT); j.K = 4096; j.Nsrc = 4096; j.Ndst = 4096; j.code = 0; j.item = r - I_IN - I_UKV - I_GLU; }
    } else {
        constexpr int I_F1 = (4096 / 64) * (16384 / 32);
        if (r < I_F1) { j.W = w0; j.WT = (bf16*)(ws + WS_WFF1); j.K = 4096; j.Nsrc = 16384; j.Ndst = 16384; j.code = 0; j.item = r; }
        else { j.W = w1; j.WT = (bf16*)(ws + WS_WFF2); j.K = 16384; j.Nsrc = 4096; j.Ndst = 4096; j.code = 0; j.item = r - I_F1; }
    }
    return j;
}
template <int MODE>
__device__ __forceinline__ void conv_run(const float* w0, const float* w1, const float* w2, const float* w3, unsigned char* ws, int total, int gw, int NGW, LAS float* scr, int lane, int first = 0) {
    int it = first + gw; if (it >= total) return;
    ConvJob cur = conv_resolve<MODE>(it, w0, w1, w2, w3, ws); f32x4 v[8]; conv_load(cur, lane, v);
    for (;;) {
        conv_lds_write(scr, lane, v);
        const int nit = it + NGW; const bool more = nit < total;
        if (more) { const ConvJob nxt = conv_resolve<MODE>(nit, w0, w1, w2, w3, ws); conv_load(nxt, lane, v); }
        LDS_WAIT(); asm volatile("" ::: "memory");
        conv_store(cur, scr, lane);
        LDS_WAIT(); asm volatile("" ::: "memory");
        if (!more) break;
        it = nit; cur = conv_resolve<MODE>(it, w0, w1, w2, w3, ws);
    }
}

__device__ __forceinline__ void adaln_unit(Frame& F, int id) {
    const int slab = id >> 5, ks = id & 31, k0 = ks * 128, col0 = slab * 1024;
    LAS float* sl = (LAS float*)(F.lds);
    LAS f32x4* red = (LAS f32x4*)(F.lds + 4096);
    for (int i = F.tid; i < 640; i += 512) { const int j = i >> 7, k = i & 127; const float v = (j == 0) ? inp(6)[k0 + k] : inp(2)[(j - 1) * 4096 + k0 + k];
        sl[i] = v / (1.0f + expf(-v)); }
    __syncthreads();
    const int c4 = F.tid & 255, kh = F.tid >> 8;
    f32x4 acc[5];
#pragma unroll
    for (int j = 0; j < 5; ++j) acc[j] = (f32x4){0.f, 0.f, 0.f, 0.f};
    const float* wp = inp(7) + (size_t)(k0 + kh * 64) * 24576 + col0 + c4 * 4;
#pragma unroll 8
    for (int kk = 0; kk < 64; ++kk) { const f32x4 w = *(const GAS f32x4*)(wp + (size_t)kk * 24576);
#pragma unroll
        for (int j = 0; j < 5; ++j) acc[j] += sl[j * 128 + kh * 64 + kk] * w; }
    if (kh == 1) {
#pragma unroll
        for (int j = 0; j < 5; ++j) red[j * 256 + c4] = acc[j]; }
    __syncthreads();
    if (kh == 0) { float* mp = (float*)(F.ws + WS_MODPART);
#pragma unroll
        for (int j = 0; j < 5; ++j) { const f32x4 v = acc[j] + red[j * 256 + c4]; *(GAS f32x4*)(mp + (size_t)(ks * 5 + j) * 24576 + col0 + c4 * 4) = v; } }
    __syncthreads();
}

__device__ __forceinline__ void s5_task(Frame& F, int g) {
    LAS f32x2* pw = (LAS f32x2*)(F.lds);
    LAS f32x2* coef = (LAS f32x2*)(F.lds + 17408);
    LAS f32x2* Bb = (LAS f32x2*)(F.lds + 18432);
    LAS f32x2* Cc = (LAS f32x2*)(F.lds + 34816);
    LAS float* Kt = (LAS float*)(F.lds + 51200);
    const int tid = F.tid;
    if (tid < 128) { const int dir = tid >> 6, p = tid & 63, idx = (dir * 128 + g) * 64 + p;
        const double lr = (double)inp(15)[idx], li = (double)inp(16)[idx], dt = exp((double)inp(17)[dir * 128 + g]);
        const double zr = lr * dt, zi = li * dt, er = exp(zr), ar = er * cos(zi), ai = er * sin(zi);
        const double nr = ar - 1.0, ni = ai, den = lr * lr + li * li;
        coef[dir * 64 + p] = (f32x2){(float)((nr * lr + ni * li) / den), (float)((ni * lr - nr * li) / den)};
        double pr = 1.0, pi = 0.0;
        for (int d = 0; d <= 16; ++d) { pw[(dir * 17 + d) * 64 + p] = (f32x2){(float)pr, (float)pi}; const double t = pr * ar - pi * ai; pi = pr * ai + pi * ar; pr = t; }
        const f32x2 a16 = pw[(dir * 17 + 16) * 64 + p];
        ((f32x2*)(F.ws + WS_PAR + 512 * 1024))[(dir * 128 + g) * 64 + p] = a16; }
    __syncthreads();
    for (int i = tid; i < 2048; i += 512) { const int dir = i >> 10, p = (i >> 4) & 63, j = i & 15; const size_t gi = ((size_t)(dir * 128 + g) * 64 + p) * 16 + j;
        const float br = inp(18)[gi], bi = inp(19)[gi]; const f32x2 cf = coef[dir * 64 + p];
        Bb[i] = (f32x2){cf.x * br - cf.y * bi, cf.x * bi + cf.y * br}; }
    for (int i = tid; i < 2048; i += 512) { const int dir = i >> 10; const size_t gi = (size_t)(dir * 128 + g) * 1024 + (i & 1023);
        Cc[i] = (f32x2){inp(20)[gi], inp(21)[gi]}; }
    __syncthreads();
    { const int dir = tid >> 8, jj = tid & 255, j = jj >> 4, jp = jj & 15; float acc[16];
#pragma unroll
        for (int d = 0; d < 16; ++d) acc[d] = 0.f;
        for (int p = 0; p < 64; ++p) { const f32x2 c = Cc[(dir * 16 + j) * 64 + p], b = Bb[(dir * 64 + p) * 16 + jp]; const float Pr = c.x * b.x - c.y * b.y, Pi = c.x * b.y + c.y * b.x;
#pragma unroll
            for (int d = 0; d < 16; ++d) { const f32x2 w = pw[(dir * 17 + d) * 64 + p]; acc[d] += Pr * w.x - Pi * w.y; } }
#pragma unroll
        for (int d = 0; d < 16; ++d) Kt[(dir * 16 + d) * 256 + jj] = acc[d]; }
    __syncthreads();
    bf16* Mcat = (bf16*)(F.ws + WS_MCAT) + (size_t)g * 256 * 512; bf16* Mst = (bf16*)(F.ws + WS_MSTATE) + (size_t)g * 256 * 256;
    for (int it = 0; it < 32; ++it) { const int idx = tid + 512 * it, n = idx >> 6, k8 = (idx & 63) * 8, tau = n >> 4, j = n & 15; float v[8];
        if (k8 < 256) { const int sg = k8 >> 4, j0 = k8 & 15;
#pragma unroll
            for (int e = 0; e < 8; ++e) { const int jp = j0 + e; float x = 0.f;
                if (sg <= tau) x += Kt[(0 * 16 + (tau - sg)) * 256 + j * 16 + jp];
                if (sg >= tau) x += Kt[(1 * 16 + (sg - tau)) * 256 + j * 16 + jp];
                if (sg == tau && j == jp) x += inp(22)[g * 16 + j];
                v[e] = x; }
        } else { const int kk = k8 - 256, dir = kk >> 7, part = (kk >> 6) & 1, p0 = kk & 63, ep = dir == 0 ? tau + 1 : 16 - tau;
#pragma unroll
            for (int e = 0; e < 8; ++e) { const f32x2 w = pw[(dir * 17 + ep) * 64 + p0 + e], c = Cc[(dir * 16 + j) * 64 + p0 + e];
                v[e] = part == 0 ? (c.x * w.x - c.y * w.y) : -(c.x * w.y + c.y * w.x); } }
        v4u o; o.x = pk2(v[0], v[1]); o.y = pk2(v[2], v[3]); o.z = pk2(v[4], v[5]); o.w = pk2(v[6], v[7]);
        *(GAS v4u*)(Mcat + (size_t)n * 512 + k8) = o; }
    for (int it = 0; it < 16; ++it) { const int idx = tid + 512 * it, n = idx >> 5, k8 = (idx & 31) * 8, dir = n >> 7, part = (n >> 6) & 1, p = n & 63, sg = k8 >> 4, j0 = k8 & 15, ep = dir == 0 ? 15 - sg : sg;
        const f32x2 w = pw[(dir * 17 + ep) * 64 + p]; float v[8];
#pragma unroll
        for (int e = 0; e < 8; ++e) { const f32x2 b = Bb[(dir * 64 + p) * 16 + j0 + e]; v[e] = part == 0 ? (w.x * b.x - w.y * b.y) : (w.x * b.y + w.y * b.x); }
        v4u o; o.x = pk2(v[0], v[1]); o.y = pk2(v[2], v[3]); o.z = pk2(v[4], v[5]); o.w = pk2(v[6], v[7]);
        *(GAS v4u*)(Mst + (size_t)n * 256 + k8) = o; }
    __syncthreads();
}

__device__ __forceinline__ void p0_prologue(Frame& F) {
    for (int id = F.vcu; id < 768; id += F.G) adaln_unit(F, id);
    for (int g = F.vcu; g < 128; g += F.G) s5_task(F, g);
    { float* tab = (float*)(F.ws + WS_TAB);
      for (int idx = F.vcu * 512 + F.tid; idx < 4096 * 32; idx += F.G * 512) { const int t = idx >> 5, p = idx & 31, pos = p < 16 ? (t >> 6) : (t & 63), f = p & 15;
        const double inv = exp(-(double)f * (9.210340371976184 / 16.0)), ang = (double)pos * inv;
        *(GAS f32x2*)(tab + (size_t)idx * 2) = (f32x2){(float)cos(ang), (float)sin(ang)}; } }
    LAS float* scr = (LAS float*)(F.lds + RING_OFF + F.wave * 16384);
    const int gw = F.vcu * NWAVES + F.wave, NGW = F.G * NWAVES;
    constexpr int I_IN = (4096 / 64) * (NIN / 32), I_UQ = (1024 / 64) * (6144 / 32), I_UKV = (512 / 64) * (8192 / 32), I_GLU = (2048 / 64) * (8192 / 32), I_OUT = (4096 / 64) * (4096 / 32);
    { constexpr int I_ALL = I_IN + I_UKV + I_GLU + I_OUT;
      if (F.G == 256) { constexpr int I_EVEN = (I_ALL * 3 / 4) & ~2047;
          conv_run<0>(inp(10), inp(14), inp(23), inp(24), F.ws, I_EVEN, gw, NGW, scr, F.lane);
          if (F.vcu >= 128) conv_run<0>(inp(10), inp(14), inp(23), inp(24), F.ws, I_ALL, gw - 128 * NWAVES, 128 * NWAVES, scr, F.lane, I_EVEN); }
      else conv_run<0>(inp(10), inp(14), inp(23), inp(24), F.ws, I_ALL, gw, NGW, scr, F.lane); }
    { const float* w_uq = inp(13);
      for (int it = gw; it < I_UQ; it += NGW) transpose_item(w_uq, 1024, 6144, 6144, 2, (bf16*)(F.ws + WS_WUQ), scr, it, F.lane); }
}
__device__ __forceinline__ void p0b_modreduce(Frame& F) {
    const float* mp = (const float*)(F.ws + WS_MODPART); float* par = (float*)(F.ws + WS_PAR);
    for (int idx = F.vcu * 512 + F.tid; idx < 5 * 4096; idx += F.G * 512) { const int j = idx >> 12, k = idx & 4095; float m[6];
#pragma unroll
        for (int i = 0; i < 6; ++i) { const int n = i * 4096 + k; float s = inp(8)[n];
            for (int ks = 0; ks < 32; ++ks) s += mp[(size_t)(ks * 5 + j) * 24576 + n];
            m[i] = s; }
        par[0 * 20480 + idx] = inp(9)[k] * (1.0f + m[1]); par[1 * 20480 + idx] = m[0]; par[2 * 20480 + idx] = m[2] * inp(25)[k];
        par[3 * 20480 + idx] = inp(26)[k] * (1.0f + m[4]); par[4 * 20480 + idx] = m[3]; par[5 * 20480 + idx] = m[5] * inp(29)[k]; }
}
__device__ __forceinline__ int cond_of_row(int m) { return m < NPR ? 0 : 1 + ((m - NPR) >> 12); }
__device__ __forceinline__ const float* xrow_of(const Frame& F, int m) { return m < NPR ? inp(0) + (size_t)m * DM : inp(1) + (size_t)(m - NPR) * DM; }
__device__ __forceinline__ void p1_modnorm(Frame& F) {
    const int gw = F.vcu * NWAVES + F.wave, NGW = F.G * NWAVES; const float* par = (const float*)(F.ws + WS_PAR); bf16* H = (bf16*)(F.ws + WS_A);
    for (int m = gw; m < NROW; m += NGW) { const int cd = cond_of_row(m); const GAS f32x4* xr = (const GAS f32x4*)xrow_of(F, m) + F.lane;
        const GAS f32x4* A = (const GAS f32x4*)(par + 0 * 20480 + cd * 4096) + F.lane; const GAS f32x4* B = (const GAS f32x4*)(par + 1 * 20480 + cd * 4096) + F.lane;
        f32x4 v[16]; float s = 0.f;
#pragma unroll
        for (int j = 0; j < 16; ++j) { v[j] = xr[64 * j]; s += (v[j].x * v[j].x + v[j].y * v[j].y) + (v[j].z * v[j].z + v[j].w * v[j].w); }
        const float rinv = 1.0f / sqrtf(wave_sum(s) * (1.0f / DM) + EPSN);
        GAS u32x2* o8 = (GAS u32x2*)(H + (size_t)m * DM) + F.lane;
#pragma unroll
        for (int j = 0; j < 16; ++j) { const f32x4 a = A[64 * j], b = B[64 * j]; const f32x4 y = v[j] * rinv * a + b; o8[64 * j] = (u32x2){pk2(y.x, y.y), pk2(y.z, y.w)}; } }
}
__device__ __forceinline__ void p3_rowpass(Frame& F) {
    const int gw = F.vcu * NWAVES + F.wave, NGW = F.G * NWAVES, lane = F.lane;
    const bf16* qraw = (const bf16*)(F.ws + WS_QRAW); const float* ckvraw = (const float*)(F.ws + WS_CKVRAW); const float* krraw = (const float*)(F.ws + WS_KRRAW);
    const float* qstat = (const float*)(F.ws + WS_QSTAT); const float* kvstat = (const float*)(F.ws + WS_KVSTAT); const float* tab = (const float*)(F.ws + WS_TAB);
    bf16* qn = (bf16*)(F.ws + WS_QN); bf16* ckvn = (bf16*)(F.ws + WS_CKVN); bf16* Kr = (bf16*)(F.ws + WS_KR);
    for (int m = gw; m < NROW + 2048; m += NGW) {
        if (m < NROW) {
            const int keyrow = m < NPR ? m : NPR + ((m - NPR) >> 12) * 4608 + 512 + ((m - NPR) & 4095);
            const float qs = wave_sum(lane < 16 ? qstat[m * 16 + lane] : 0.f), ks = wave_sum(lane < 8 ? kvstat[m * 8 + lane] : 0.f);
            const float rq = 1.0f / sqrtf(qs * (1.0f / 1024.f) + EPSN), rk = 1.0f / sqrtf(ks * (1.0f / 512.f) + EPSN);
#pragma unroll
            for (int hh = 0; hh < 2; ++hh) { const int k0 = hh * 512 + lane * 8; const v4u w = *(const GAS v4u*)(qraw + (size_t)m * 1024 + k0);
                const f32x4 g0 = *(const GAS f32x4*)(inp(11) + k0), g1 = *(const GAS f32x4*)(inp(11) + k0 + 4); v4u o;
                o.x = pk2(__uint_as_float(w.x << 16) * rq * g0.x, __uint_as_float(w.x & 0xffff0000u) * rq * g0.y); o.y = pk2(__uint_as_float(w.y << 16) * rq * g0.z, __uint_as_float(w.y & 0xffff0000u) * rq * g0.w);
                o.z = pk2(__uint_as_float(w.z << 16) * rq * g1.x, __uint_as_float(w.z & 0xffff0000u) * rq * g1.y); o.w = pk2(__uint_as_float(w.w << 16) * rq * g1.z, __uint_as_float(w.w & 0xffff0000u) * rq * g1.w);
                *(GAS v4u*)(qn + (size_t)m * 1024 + k0) = o; }
            { const int k0 = lane * 8; const f32x4 a = *(const GAS f32x4*)(ckvraw + (size_t)m * 512 + k0), b = *(const GAS f32x4*)(ckvraw + (size_t)m * 512 + k0 + 4);
              const f32x4 g0 = *(const GAS f32x4*)(inp(12) + k0), g1 = *(const GAS f32x4*)(inp(12) + k0 + 4); const f32x4 ya = a * rk * g0, yb = b * rk * g1;
              v4u o; o.x = pk2(ya.x, ya.y); o.y = pk2(ya.z, ya.w); o.z = pk2(yb.x, yb.y); o.w = pk2(yb.z, yb.w);
              *(GAS v4u*)(ckvn + (size_t)keyrow * 512 + k0) = o;
              if (m < NPR) { float* oc = F.out + O_CKV + (size_t)m * 512 + k0; *(GAS f32x4*)oc = ya; *(GAS f32x4*)(oc + 4) = yb; } }
            if (lane < 32) { float lo = krraw[(size_t)m * 64 + lane], hi = krraw[(size_t)m * 64 + lane + 32];
                if (m < NPR) { F.out[O_KR + (size_t)m * 64 + lane] = lo; F.out[O_KR + (size_t)m * 64 + lane + 32] = hi; }
                else { const int t = (m - NPR) & 4095; const f32x2 cs = *(const GAS f32x2*)(tab + ((size_t)t * 32 + lane) * 2); const float l2 = lo * cs.x - hi * cs.y, h2 = hi * cs.x + lo * cs.y; lo = l2; hi = h2; }
                *(GAS unsigned*)(Kr + (size_t)keyrow * 64 + 2 * lane) = pk2(lo, hi); }
        } else {
            const int idx = m - NROW, b = idx >> 9, s = idx & 511, keyrow = NPR + b * 4608 + s, k0 = lane * 8;
            const f32x4 a = *(const GAS f32x4*)(inp(3) + (size_t)idx * 512 + k0), bb = *(const GAS f32x4*)(inp(3) + (size_t)idx * 512 + k0 + 4);
            v4u o; o.x = pk2(a.x, a.y); o.y = pk2(a.z, a.w); o.z = pk2(bb.x, bb.y); o.w = pk2(bb.z, bb.w);
            *(GAS v4u*)(ckvn + (size_t)keyrow * 512 + k0) = o;
            if (lane < 32) *(GAS unsigned*)(Kr + (size_t)keyrow * 64 + 2 * lane) = pk2(inp(4)[(size_t)idx * 64 + lane], inp(4)[(size_t)idx * 64 + lane + 32]);
        }
    }
}
__device__ __forceinline__ void scan_task(Frame& F, int seq, int g, int dir) {
    const int lane = F.lane; const bool prompt = seq < 32; const int nc = prompt ? 16 : 256, cbase = prompt ? seq * 16 : 512 + (seq - 32) * 256;
    const f32x2 aT = ((const f32x2*)(F.ws + WS_PAR + 512 * 1024))[(dir * 128 + g) * 64 + lane];
    float hr = 0.f, hi = 0.f;
    if (!prompt) { const size_t si = ((size_t)((seq - 32) * 2 + dir) * 2) * 8192 + g * 64 + lane; hr = inp(5)[si]; hi = inp(5)[si + 8192]; }
    const float* S = (const float*)(F.ws + WS_A) + ((size_t)g * NCHUNK + cbase) * 256 + dir * 128 + lane;
    bf16* Hb = (bf16*)(F.ws + WS_UH) + ((size_t)g * NCHUNK + cbase) * 512 + 256 + dir * 128 + lane;
    for (int c0 = 0; c0 < nc; c0 += 8) { float sr[8], si[8];
#pragma unroll
        for (int e = 0; e < 8; ++e) { const int c = dir == 0 ? c0 + e : nc - 1 - (c0 + e); sr[e] = S[(size_t)c * 256]; si[e] = S[(size_t)c * 256 + 64]; }
#pragma unroll
        for (int e = 0; e < 8; ++e) { const int c = dir == 0 ? c0 + e : nc - 1 - (c0 + e);
            Hb[(size_t)c * 512] = (bf16)f2bf(hr); Hb[(size_t)c * 512 + 64] = (bf16)f2bf(hi);
            const float nr = aT.x * hr - aT.y * hi + sr[e], ni = aT.x * hi + aT.y * hr + si[e]; hr = nr; hi = ni; } }
    if (prompt) { float* o = F.out + O_S5 + ((size_t)(seq * 2 + dir) * 2) * 8192 + g * 64 + lane; o[0] = hr; o[8192] = hi; }
}
__device__ __forceinline__ void p4b_scan(Frame& F) {
    const int gw = F.vcu * NWAVES + F.wave, NGW = F.G * NWAVES;
    for (int t = gw; t < 2048; t += NGW) {
        if (t < 1024) scan_task(F, 32 + (t >> 8), (t >> 1) & 127, t & 1);
        else { const int base = (t - 1024) * 8; for (int e = 0; e < 8; ++e) { const int q = base + e; scan_task(F, q >> 8, (q >> 1) & 127, q & 1); } }
    }
}
__device__ __forceinline__ void p9_rowpass(Frame& F) {
    const int gw = F.vcu * NWAVES + F.wave, NGW = F.G * NWAVES, lane = F.lane; const float* par = (const float*)(F.ws + WS_PAR);
    const bf16* ob = (const bf16*)(F.ws + WS_OUTB); const float* ostat = (const float*)(F.ws + WS_OSTAT); bf16* H2 = (bf16*)(F.ws + WS_A);
    for (int m = gw; m < NROW; m += NGW) { const int cd = cond_of_row(m); const GAS f32x4* xr = (const GAS f32x4*)xrow_of(F, m) + lane;
        const float r1 = 1.0f / sqrtf(wave_sum(ostat[(size_t)m * 64 + lane]) * (1.0f / DM) + EPSN);
        const GAS f32x4* P2 = (const GAS f32x4*)(par + 2 * 20480 + cd * 4096) + lane; const GAS u32x2* o2 = (const GAS u32x2*)(ob + (size_t)m * DM) + lane;
        GAS u32x2* xo = (GAS u32x2*)(F.out + O_Y + (size_t)m * DM + DM / 2) + lane;
        f32x4 v[16]; float s = 0.f;
#pragma unroll
        for (int j = 0; j < 16; ++j) { const u32x2 w = o2[64 * j]; const f32x4 o = (f32x4){__uint_as_float(w.x << 16), __uint_as_float(w.x & 0xffff0000u), __uint_as_float(w.y << 16), __uint_as_float(w.y & 0xffff0000u)};
            v[j] = xr[64 * j] + P2[64 * j] * o * r1; xo[64 * j] = (u32x2){pk2(v[j].x, v[j].y), pk2(v[j].z, v[j].w)}; s += (v[j].x * v[j].x + v[j].y * v[j].y) + (v[j].z * v[j].z + v[j].w * v[j].w); }
        const float r2 = 1.0f / sqrtf(wave_sum(s) * (1.0f / DM) + EPSN);
        const GAS f32x4* A = (const GAS f32x4*)(par + 3 * 20480 + cd * 4096) + lane; const GAS f32x4* B = (const GAS f32x4*)(par + 4 * 20480 + cd * 4096) + lane;
        GAS u32x2* o8 = (GAS u32x2*)(H2 + (size_t)m * DM) + lane;
#pragma unroll
        for (int j = 0; j < 16; ++j) { const f32x4 y = v[j] * r2 * A[64 * j] + B[64 * j]; o8[64 * j] = (u32x2){pk2(y.x, y.y), pk2(y.z, y.w)}; } }
    LAS float* scr = (LAS float*)(F.lds + RING_OFF + F.wave * 16384);
    constexpr int I_F1 = (4096 / 64) * (16384 / 32), I_F2 = (16384 / 64) * (4096 / 32);
    conv_run<1>(inp(27), inp(28), nullptr, nullptr, F.ws, I_F1 + I_F2, gw, NGW, scr, lane);
}
__device__ __forceinline__ void p12_rowpass(Frame& F) {
    const int gw = F.vcu * NWAVES + F.wave, NGW = F.G * NWAVES, lane = F.lane; const float* par = (const float*)(F.ws + WS_PAR);
    const bf16* ab = (const bf16*)(F.ws + WS_A); const float* ostat = (const float*)(F.ws + WS_OSTAT);
    for (int m = gw; m < NROW; m += NGW) { const int cd = cond_of_row(m);
        const float r1 = 1.0f / sqrtf(wave_sum(ostat[(size_t)m * 64 + lane]) * (1.0f / DM) + EPSN);
        const GAS f32x4* P5 = (const GAS f32x4*)(par + 5 * 20480 + cd * 4096) + lane; const GAS u32x2* o2 = (const GAS u32x2*)(ab + (size_t)m * DM) + lane;
        GAS f32x4* yo = (GAS f32x4*)(F.out + O_Y + (size_t)m * DM) + lane; const GAS u32x2* xo = (const GAS u32x2*)(F.out + O_Y + (size_t)m * DM + DM / 2) + lane;
        u32x2 xw[16], aw[16];
#pragma unroll
        for (int j = 0; j < 16; ++j) { xw[j] = xo[64 * j]; aw[j] = o2[64 * j]; }
        asm volatile("s_waitcnt vmcnt(0)" ::: "memory");
#pragma unroll
        for (int j = 0; j < 16; ++j) { const u32x2 w = aw[j], x = xw[j];
            const f32x4 o = (f32x4){__uint_as_float(w.x << 16), __uint_as_float(w.x & 0xffff0000u), __uint_as_float(w.y << 16), __uint_as_float(w.y & 0xffff0000u)};
            const f32x4 x1 = (f32x4){__uint_as_float(x.x << 16), __uint_as_float(x.x & 0xffff0000u), __uint_as_float(x.y << 16), __uint_as_float(x.y & 0xffff0000u)};
            yo[64 * j] = x1 + P5[64 * j] * o * r1; } }
}

struct Args { const float* in[30]; float* out; unsigned char* ws; };
__global__ void __launch_bounds__(NWAVES * 64, 2) mk_fwd(Args args) {
    extern __shared__ __attribute__((aligned(16))) unsigned char lds[];
    Frame F;
    F.lds = (LAS unsigned char*)lds;
    F.MISC = (volatile LAS unsigned*)(F.lds + MISC_OFF);
    F.tid = threadIdx.x; F.lane = F.tid & 63; F.wave = __builtin_amdgcn_readfirstlane(F.tid >> 6);
    F.G = gridDim.x; { const int bx = blockIdx.x; F.vcu = (F.G % 8 == 0) ? (bx % 8) * (F.G / 8) + bx / 8 : bx; }
    F.out = args.out; F.ws = args.ws;
    unsigned char* ws = args.ws;
    F.ctl = (gu32*)(ws + WS_CTL);
    for (int u = F.tid; u < (LDS_BYTES - LDSCTL_OFF) / 4; u += NWAVES * 64) ((LAS unsigned*)(F.lds + LDSCTL_OFF))[u] = 0u;
    __syncthreads();
    XcdBarrier bar = xcd_barrier_post((unsigned*)(F.ctl + CW_BAR), F.MISC + 8);
#define REFRESH() do { int t_ = threadIdx.x; asm volatile("" : "+v"(t_)); F.tid = t_; F.lane = t_ & 63; } while (0)
#define GRID_BAR() do { xcd_barrier(bar); REFRESH(); } while (0)
    typedef pg8::bf16_t bt;
    const int bx = (int)blockIdx.x;

    p0_prologue(F); GRID_BAR();
    p0b_modreduce(F); GRID_BAR();
    p1_modnorm(F); GRID_BAR();
    { pg8::Gemm g{(const bt*)(ws + WS_A), (const bt*)(ws + WS_WIN), 4096, 4096, 4096}; pg8::StaticOrder S; S.init(NROW, NIN, F.G, bx);
      pg8::EpiIn E{(bt*)(ws + WS_QRAW), (float*)(ws + WS_CKVRAW), (float*)(ws + WS_KRRAW), (bt*)(ws + WS_UH), (bt*)(ws + WS_GA), (bt*)(ws + WS_GB), (float*)(ws + WS_QSTAT), (float*)(ws + WS_KVSTAT)};
      pg8::gemm_phase<pg8::EpiIn, pg8::StaticOrder, true, true>(F.lds + RING_OFF, g, S, E); }
    GRID_BAR();
    p3_rowpass(F); __syncthreads(); REFRESH();
    { pg8::Gemm g{(const bt*)(ws + WS_UH), (const bt*)(ws + WS_MSTATE), 512, 256, 256}; pg8::GroupOrder S{768, 6, F.G, bx};
      pg8::EpiS E{(float*)(ws + WS_A)};
      pg8::gemm_phase<pg8::EpiS, pg8::GroupOrder, true, true>(F.lds + RING_OFF, g, S, E); }
    GRID_BAR();
    p4b_scan(F); GRID_BAR();
    { pg8::Gemm g{(const bt*)(ws + WS_UH), (const bt*)(ws + WS_MCAT), 512, 512, 512}; pg8::GroupOrder S{768, 6, F.G, bx};
      pg8::EpiY E{(bt*)(ws + WS_YG)};
      pg8::gemm_phase<pg8::EpiY, pg8::GroupOrder, true, true>(F.lds + RING_OFF, g, S, E); }
    GRID_BAR();
    { pg8::Gemm g{(const bt*)(ws + WS_QN), (const bt*)(ws + WS_WUQ), 1024, 1024, 1024}; pg8::StaticOrder S; S.init(NROW, 6144, F.G, bx);
      pg8::EpiQ E{(bt*)(ws + WS_Q), (const float*)(ws + WS_TAB), QSCALE};
      pg8::gemm_phase<pg8::EpiQ, pg8::StaticOrder, true, true>(F.lds + RING_OFF, g, S, E); }
    { pg8::Gemm g{(const bt*)(ws + WS_CKVN), (const bt*)(ws + WS_WUKV), 512, 512, 512}; pg8::StaticOrder S; S.init(NKEY, 8192, F.G, bx);
      pg8::EpiBf E{(bt*)(ws + WS_KV), 8192};
      pg8::gemm_phase<pg8::EpiBf, pg8::StaticOrder, true, true>(F.lds + RING_OFF, g, S, E); }
    GRID_BAR();
    { const att::bf16* Q = (const att::bf16*)(ws + WS_Q); const att::bf16* KV = (const att::bf16*)(ws + WS_KV); const att::bf16* KR = (const att::bf16*)(ws + WS_KR);
      const att::bf16* GA = (const att::bf16*)(ws + WS_GA); att::bf16* MO = (att::bf16*)(ws + WS_A);
      for (int u = F.vcu; u < 3072; u += F.G) {
          int h, qrow0, krow0, seq;
          if (u < 2048) { const int bh = u >> 4, qb = u & 15, b = bh >> 5; h = bh & 31; qrow0 = NPR + b * 4096 + qb * 256; krow0 = NPR + b * 4608; seq = 4608; }
          else { const int v = u - 2048, b = v >> 5; h = v & 31; qrow0 = b * 256; krow0 = b * 256; seq = 256; }
          att::attn_unit(Q + (size_t)qrow0 * 6144 + h * 128, Q + (size_t)qrow0 * 6144 + 4096 + h * 64, KV + (size_t)krow0 * 8192 + h * 256, KV + (size_t)krow0 * 8192 + h * 256 + 128,
                         KR + (size_t)krow0 * 64, GA + (size_t)qrow0 * 4096 + h * 128, MO + (size_t)qrow0 * 4096 + h * 128, seq, (char*)lds + RING_OFF);
      }
      }
    GRID_BAR();
    { pg8::Gemm g{(const bt*)(ws + WS_YG), (const bt*)(ws + WS_WGLU), 2048, 2048, 2048}; pg8::StaticOrder S; S.init(NROW, 8192, F.G, bx);
      pg8::EpiGlu E{(bt*)(ws + WS_A), (const bt*)(ws + WS_GB)};
      if (F.G == 256) { pg8::ShareOrder P{NROW / 256, bx, 4}; pg8::gemm_phase<pg8::EpiGlu, pg8::ShareOrder, true, true>(F.lds + RING_OFF, g, P, E); }
      else pg8::gemm_phase<pg8::EpiGlu, pg8::StaticOrder, true, true>(F.lds + RING_OFF, g, S, E); }
    GRID_BAR();
    { pg8::Gemm g{(const bt*)(ws + WS_A), (const bt*)(ws + WS_WOUT), 4096, 4096, 4096}; pg8::StaticOrder S; S.init(NROW, 4096, F.G, bx);
      pg8::EpiStat E{(bt*)(ws + WS_OUTB), (float*)(ws + WS_OSTAT)};
      if (F.G == 256) { pg8::ShareOrder P{NROW / 256, bx, 2}; pg8::gemm_phase<pg8::EpiStat, pg8::ShareOrder, true, true>(F.lds + RING_OFF, g, P, E); }
      else pg8::gemm_phase<pg8::EpiStat, pg8::StaticOrder, true, true>(F.lds + RING_OFF, g, S, E); }
    GRID_BAR();
    p9_rowpass(F); GRID_BAR();
    { pg8::Gemm g{(const bt*)(ws + WS_A), (const bt*)(ws + WS_WFF1), 4096, 4096, 4096}; pg8::StaticOrder S; S.init(NROW, 16384, F.G, bx);
      pg8::EpiRelu2 E{(bt*)(ws + WS_A1)};
      if (F.G == 256) { pg8::ShareOrder P{NROW / 256, bx, 8}; pg8::gemm_phase<pg8::EpiRelu2, pg8::ShareOrder, true, true>(F.lds + RING_OFF, g, P, E); }
      else pg8::gemm_phase<pg8::EpiRelu2, pg8::StaticOrder, true, true>(F.lds + RING_OFF, g, S, E);
    }
    GRID_BAR();
    { pg8::Gemm g{(const bt*)(ws + WS_A1), (const bt*)(ws + WS_WFF2), 16384, 16384, 16384}; pg8::StaticOrder S; S.init(NROW, 4096, F.G, bx);
      pg8::EpiStat E{(bt*)(ws + WS_A), (float*)(ws + WS_OSTAT)};
      if (F.G == 256) { pg8::ShareOrder P{NROW / 256, bx, 2}; pg8::gemm_phase<pg8::EpiStat, pg8::ShareOrder, true, true>(F.lds + RING_OFF, g, P, E); }
      else pg8::gemm_phase<pg8::EpiStat, pg8::StaticOrder, true, true>(F.lds + RING_OFF, g, S, E); }
    GRID_BAR();
    p12_rowpass(F);
#undef GRID_BAR
#undef REFRESH
}

extern "C" void kernel_launch(void* const* d_in, const int* in_sizes, int n_in, void* d_out, int out_size, void* d_ws, size_t ws_size, hipStream_t stream) {
    static int grid = 0;
    if (grid == 0) {
        if (n_in != 30 || in_sizes[0] != NPR * DM || out_size != (int)O_END || ws_size < WS_END) { fprintf(stderr, "kernel_launch: shape mismatch (n_in %d, in0 %d, out %d, ws %zu; need ws >= %zu); nothing launched\n", n_in, n_in > 0 ? in_sizes[0] : -1, out_size, ws_size, (size_t)WS_END); grid = -1; return; }
        int dev = 0, cus = 0, per_cu = 0;
        if (hipGetDevice(&dev) != hipSuccess || hipDeviceGetAttribute(&cus, hipDeviceAttributeMultiprocessorCount, dev) != hipSuccess) { grid = -1; return; }
        if (hipFuncSetAttribute((const void*)mk_fwd, hipFuncAttributeMaxDynamicSharedMemorySize, LDS_BYTES) != hipSuccess) { fprintf(stderr, "kernel_launch: hipFuncSetAttribute failed\n"); grid = -1; return; }
        if (hipOccupancyMaxActiveBlocksPerMultiprocessor(&per_cu, (const void*)mk_fwd, NWAVES * 64, LDS_BYTES) != hipSuccess || per_cu < 1) { fprintf(stderr, "kernel_launch: occupancy query reports %d workgroups per CU\n", per_cu); }
        (void)hipGetLastError();
        grid = cus;
    }
    if (grid < 0) return;
    if (hipMemsetAsync((char*)d_ws + WS_CTL, 0, CTL_ZERO_BYTES, stream) != hipSuccess) return;
    Args a{};
    for (int i = 0; i < 30; ++i) a.in[i] = (const float*)d_in[i];
    a.out = (float*)d_out; a.ws = (unsigned char*)d_ws;
    hipLaunchKernelGGL(mk_fwd, dim3(grid), dim3(NWAVES * 64), LDS_BYTES, stream, a);
    const hipError_t le = hipPeekAtLastError();
    if (le != hipSuccess) fprintf(stderr, "kernel_launch: launch failed: %s\n", hipGetErrorName(le));
}
```

```cpp
#include <hip/hip_runtime.h>
#include <cstdio>
#include <cstdint>
namespace pg8 {
#define PG8_LAS __attribute__((address_space(3)))
typedef unsigned short bf16_t;
typedef short bf16x8 __attribute__((ext_vector_type(8)));
typedef float f32x4 __attribute__((ext_vector_type(4)));
typedef unsigned u32x4 __attribute__((ext_vector_type(4)));
constexpr int BM = 256, BK = 64, HALF = 128, HTB = HALF * BK * 2  , STAGE_BYTES = 8 * HTB, NXCD = 8, WGM = 4;

__host__ __device__ __forceinline__ int lds_byte(int r, int c) { const int st = (r >> 4) * 2 + (c >> 5), rr = r & 15, cc = c & 31, ob = rr * 64 + cc * 2; return st * 1024 + (ob ^ (((ob >> 9) & 1) << 5)); }
__host__ __device__ __forceinline__ void stage_rc(int b, int& R, int& C) { const int st = b / 1024, sb = b % 1024, swz = sb ^ (((sb >> 9) & 1) << 5); R = (st >> 1) * 16 + swz / 64; C = (st & 1) * 32 + (swz % 64) / 2; }
__host__ __device__ __forceinline__ int perm32(int rho) { const int n = rho >> 4, i = rho & 15; return 8 * (i >> 2) + 4 * n + (i & 3); }

struct Unit { int pm, pn; };
struct Gemm { const bf16_t* A; const bf16_t* Bt; int lda, ldb, K; };

struct StaticOrder {
    int nM, nN, nwg, G, c;
    __host__ __device__ void init(int M, int N, int G_, int c_) { nM = M / BM; nN = N / BM; nwg = nM * nN; G = G_; c = c_; }
    __host__ __device__ bool next(int i, Unit& u) const {
        const long L = (long)i * G + c; if (L >= nwg) return false;
        int wgid = (int)L; { const int q = nwg / NXCD, r = nwg % NXCD, xcd = wgid % NXCD, off = wgid / NXCD; wgid = (xcd < r ? xcd * (q + 1) : r * (q + 1) + (xcd - r) * q) + off; }
        const int nig = WGM * nN, gid = wgid / nig, fm = gid * WGM, gsz = (nM - fm) < WGM ? (nM - fm) : WGM;
        u.pm = fm + ((wgid % nig) % gsz); u.pn = (wgid % nig) / gsz; return true;
    }
    __device__ __forceinline__ void a_ready(const Unit&) const {}
    __device__ __forceinline__ void done(const Unit&) const {}
};
struct GroupOrder {
    int nunits, per, G, c;
    __device__ bool next(int i, Unit& u) const { const int L = i * G + c; if (L >= nunits) return false; u.pm = L; u.pn = L / per; return true; }
    __device__ __forceinline__ void a_ready(const Unit&) const {}
    __device__ __forceinline__ void done(const Unit&) const {}
};

struct ShareOrder {
    int nM, c, share, rev;
    __device__ bool next(int i, Unit& u) const { const int rpr = 32 / share; if (i * rpr >= nM) return false;
        const int xcd = c & 7, j = c >> 3, r0 = rev ? nM - rpr * (i + 1) : rpr * i; u.pm = r0 + 4 * (xcd / share) + (j & 3); u.pn = (xcd % share) * 8 + (j >> 2); return true; }
    __device__ __forceinline__ void a_ready(const Unit&) const {}
    __device__ __forceinline__ void done(const Unit&) const {}
};

struct ShareOrder2 {
    static constexpr bool MALL_PF = false;
    int nM, nN, c, share, rx;
    __device__ bool next(int i, Unit& u) const { const int cx = 32 / rx, cpp = share * cx, phases = nN / cpp, rpr = (8 / share) * rx, ib = i / phases, ph = i - ib * phases;
        if (ib * rpr >= nM) return false;
        const int xcd = c & 7, j = c >> 3; u.pm = rpr * ib + rx * (xcd / share) + (j % rx); u.pn = ph * cpp + (xcd % share) * cx + (j / rx); return true; }
    __device__ __forceinline__ void a_ready(const Unit&) const {}
    __device__ __forceinline__ void done(const Unit&) const {}
};

__device__ __forceinline__ unsigned cvt_pk_bf16(float lo, float hi) { unsigned r; asm volatile("v_cvt_pk_bf16_f32 %0, %1, %2" : "=v"(r) : "v"(lo), "v"(hi)); return r; }
__device__ __forceinline__ u32x4 pack8(const f32x4 a, const f32x4 b) { u32x4 w; w.x = cvt_pk_bf16(a[0], a[1]); w.y = cvt_pk_bf16(a[2], a[3]); w.z = cvt_pk_bf16(b[0], b[1]); w.w = cvt_pk_bf16(b[2], b[3]); return w; }
__device__ __forceinline__ float bflo(unsigned w) { return __uint_as_float(w << 16); }
__device__ __forceinline__ float bfhi(unsigned w) { return __uint_as_float(w & 0xffff0000u); }
__device__ __forceinline__ float sigm(float x) { return __builtin_amdgcn_rcpf(1.0f + __builtin_amdgcn_exp2f(-1.4426950408889634f * x)); }
__device__ __forceinline__ float gelu_tanh(float y) { return y * sigm(1.5957691216057308f * (y + 0.044715f * y * y * y)); }
__device__ __forceinline__ float sumsq8(const f32x4 a, const f32x4 b) { return (a[0] * a[0] + a[1] * a[1]) + (a[2] * a[2] + a[3] * a[3]) + (b[0] * b[0] + b[1] * b[1]) + (b[2] * b[2] + b[3] * b[3]); }

struct EpiIn {
    static constexpr bool PERM = true, AFTER_DRAIN = false;
    bf16_t* qraw; float* ckvraw; float* krraw; bf16_t* UH; bf16_t* ga; bf16_t* gb; float* qstat; float* kvstat;
    __device__ __forceinline__ void operator()(const f32x4 (&acc)[2][2][4][2], const Unit& u, int wr, int wc, int fr, int fq) const {
        asm volatile("" : "+v"(fr), "+v"(fq));
        const int row0 = u.pm * BM + wr * 64 + fr, colL = wc * 32 + 8 * fq, pn = u.pn;
        if (pn < 4) {
#pragma unroll
            for (int ai = 0; ai < 2; ++ai)
#pragma unroll
                for (int m = 0; m < 4; ++m) { const int row = row0 + ai * HALF + m * 16; float ss = 0.f;
#pragma unroll
                    for (int bj = 0; bj < 2; ++bj) { const f32x4 a = acc[ai][bj][m][0], b = acc[ai][bj][m][1]; ss += sumsq8(a, b);
                        *(u32x4*)(qraw + (size_t)row * 1024 + pn * 256 + bj * HALF + colL) = pack8(a, b); }
                    ss += __shfl_xor(ss, 16); ss += __shfl_xor(ss, 32);
                    if (fq == 0) qstat[row * 16 + pn * 4 + wc] = ss; }
        } else if (pn < 6) {
            const int t = pn - 4;
#pragma unroll
            for (int ai = 0; ai < 2; ++ai)
#pragma unroll
                for (int m = 0; m < 4; ++m) { const int row = row0 + ai * HALF + m * 16; float ss = 0.f;
#pragma unroll
                    for (int bj = 0; bj < 2; ++bj) { const f32x4 a = acc[ai][bj][m][0], b = acc[ai][bj][m][1]; ss += sumsq8(a, b);
                        float* p = ckvraw + (size_t)row * 512 + t * 256 + bj * HALF + colL; *(f32x4*)p = a; *(f32x4*)(p + 4) = b; }
                    ss += __shfl_xor(ss, 16); ss += __shfl_xor(ss, 32);
                    if (fq == 0) kvstat[row * 8 + t * 4 + wc] = ss; }
        } else if (pn < 14) {
            const int t = pn - 6;
#pragma unroll
            for (int ai = 0; ai < 2; ++ai)
#pragma unroll
                for (int m = 0; m < 4; ++m) { const int row = row0 + ai * HALF + m * 16;
#pragma unroll
                    for (int bj = 0; bj < 2; ++bj) { const int col = t * 256 + bj * HALF + colL, g = col >> 4, j0 = col & 15;
                        *(u32x4*)(UH + ((size_t)g * 1536 + (row >> 4)) * 512 + (row & 15) * 16 + j0) = pack8(acc[ai][bj][m][0], acc[ai][bj][m][1]); } }
        } else if (pn < 46) {
            bf16_t* dst = pn < 30 ? ga + (pn - 14) * 256 : gb + (pn - 30) * 256;
#pragma unroll
            for (int ai = 0; ai < 2; ++ai)
#pragma unroll
                for (int m = 0; m < 4; ++m) { const int row = row0 + ai * HALF + m * 16;
#pragma unroll
                    for (int bj = 0; bj < 2; ++bj) *(u32x4*)(dst + (size_t)row * 4096 + bj * HALF + colL) = pack8(acc[ai][bj][m][0], acc[ai][bj][m][1]); }
        } else {
            if (wc < 2) {
#pragma unroll
                for (int ai = 0; ai < 2; ++ai)
#pragma unroll
                    for (int m = 0; m < 4; ++m) { const int row = row0 + ai * HALF + m * 16; float* p = krraw + (size_t)row * 64 + colL;
                        *(f32x4*)p = acc[ai][0][m][0]; *(f32x4*)(p + 4) = acc[ai][0][m][1]; }
            }
        }
    }
};
struct EpiBf {
    static constexpr bool PERM = true, AFTER_DRAIN = false;
    bf16_t* O; int ldc;
    __device__ __forceinline__ void operator()(const f32x4 (&acc)[2][2][4][2], const Unit& u, int wr, int wc, int fr, int fq) const {
        asm volatile("" : "+v"(fr), "+v"(fq));
        const int row0 = u.pm * BM + wr * 64 + fr, col0 = u.pn * BM + wc * 32 + 8 * fq;
#pragma unroll
        for (int ai = 0; ai < 2; ++ai)
#pragma unroll
            for (int m = 0; m < 4; ++m) { bf16_t* rowp = O + (size_t)(row0 + ai * HALF + m * 16) * ldc + col0;
#pragma unroll
                for (int bj = 0; bj < 2; ++bj) *(u32x4*)(rowp + bj * HALF) = pack8(acc[ai][bj][m][0], acc[ai][bj][m][1]); }
    }
};
struct EpiQ {
    static constexpr bool PERM = true, AFTER_DRAIN = false;
    bf16_t* Q; const float* tab; float c2;
    __device__ __forceinline__ void operator()(const f32x4 (&acc)[2][2][4][2], const Unit& u, int wr, int wc, int fr, int fq) const {
        asm volatile("" : "+v"(fr), "+v"(fq));
        const int row0 = u.pm * BM + wr * 64 + fr, col0 = u.pn * BM + wc * 32 + 8 * fq;
        const bool rope = (u.pn >= 16) && (u.pm >= 32);
#pragma unroll
        for (int ai = 0; ai < 2; ++ai)
#pragma unroll
            for (int m = 0; m < 4; ++m) { const int row = row0 + ai * HALF + m * 16; bf16_t* rowp = Q + (size_t)row * 6144 + col0;
#pragma unroll
                for (int bj = 0; bj < 2; ++bj) { f32x4 a = acc[ai][bj][m][0], b = acc[ai][bj][m][1];
                    if (rope) { const int t = (row - 8192) & 4095, p0 = ((col0 + bj * HALF - 4096) & 63) >> 1;
                        const f32x4 cs0 = *(const f32x4*)(tab + ((size_t)t * 32 + p0) * 2), cs1 = *(const f32x4*)(tab + ((size_t)t * 32 + p0 + 2) * 2);
                        f32x4 ra, rb;
                        ra[0] = a[0] * cs0[0] - a[1] * cs0[1]; ra[1] = a[1] * cs0[0] + a[0] * cs0[1]; ra[2] = a[2] * cs0[2] - a[3] * cs0[3]; ra[3] = a[3] * cs0[2] + a[2] * cs0[3];
                        rb[0] = b[0] * cs1[0] - b[1] * cs1[1]; rb[1] = b[1] * cs1[0] + b[0] * cs1[1]; rb[2] = b[2] * cs1[2] - b[3] * cs1[3]; rb[3] = b[3] * cs1[2] + b[2] * cs1[3];
                        a = ra; b = rb; }
                    *(u32x4*)(rowp + bj * HALF) = pack8(a * c2, b * c2); } }
    }
};
struct EpiS {
    static constexpr bool PERM = false, AFTER_DRAIN = false;
    float* S;
    __device__ __forceinline__ void operator()(const f32x4 (&acc)[2][2][4][2], const Unit& u, int wr, int wc, int fr, int fq) const {
        asm volatile("" : "+v"(fr), "+v"(fq));
        const int row0 = u.pm * BM + wr * 64 + fr, col0 = wc * 32 + 4 * fq;
#pragma unroll
        for (int ai = 0; ai < 2; ++ai)
#pragma unroll
            for (int m = 0; m < 4; ++m) { float* rowp = S + (size_t)(row0 + ai * HALF + m * 16) * 256 + col0;
#pragma unroll
                for (int bj = 0; bj < 2; ++bj)
#pragma unroll
                    for (int n = 0; n < 2; ++n) *(f32x4*)(rowp + bj * HALF + n * 16) = acc[ai][bj][m][n]; }
    }
};
struct EpiY {
    static constexpr bool PERM = true, AFTER_DRAIN = false;
    bf16_t* Yg;
    __device__ __forceinline__ void operator()(const f32x4 (&acc)[2][2][4][2], const Unit& u, int wr, int wc, int fr, int fq) const {
        asm volatile("" : "+v"(fr), "+v"(fq));
        const int g = u.pn, c0 = (u.pm - 6 * g) * BM + wr * 64 + fr, n0 = wc * 32 + 8 * fq;
#pragma unroll
        for (int ai = 0; ai < 2; ++ai)
#pragma unroll
            for (int m = 0; m < 4; ++m) { const int c = c0 + ai * HALF + m * 16;
#pragma unroll
                for (int bj = 0; bj < 2; ++bj) { const int nn = bj * HALF + n0, tau = nn >> 4, j0 = nn & 15; f32x4 a = acc[ai][bj][m][0], b = acc[ai][bj][m][1];
#pragma unroll
                    for (int e = 0; e < 4; ++e) { a[e] = gelu_tanh(a[e]); b[e] = gelu_tanh(b[e]); }
                    *(u32x4*)(Yg + (size_t)(c * 16 + tau) * 2048 + g * 16 + j0) = pack8(a, b); } }
    }
};
struct EpiGlu {
    static constexpr bool PERM = true, AFTER_DRAIN = false;
    bf16_t* M; const bf16_t* gb;
    __device__ __forceinline__ void operator()(const f32x4 (&acc)[2][2][4][2], const Unit& u, int wr, int wc, int fr, int fq) const {
        asm volatile("" : "+v"(fr), "+v"(fq));
        const int row0 = u.pm * BM + wr * 64 + fr, col0 = u.pn * HALF + wc * 32 + 8 * fq;
#pragma unroll
        for (int ai = 0; ai < 2; ++ai)
#pragma unroll
            for (int m = 0; m < 4; ++m) { const size_t off = (size_t)(row0 + ai * HALF + m * 16) * 4096 + col0;
                const u32x4 gv = *(const u32x4*)(gb + off), mv = *(const u32x4*)(M + off); f32x4 o0, o1;
#pragma unroll
                for (int e = 0; e < 4; ++e) { const unsigned gw = gv[e >> 1], mw = mv[e >> 1];
                    const float g = (e & 1) ? bfhi(gw) : bflo(gw), ma = (e & 1) ? bfhi(mw) : bflo(mw);
                    o0[e] = sigm(g) * (acc[ai][0][m][0][e] * sigm(acc[ai][1][m][0][e])) + ma; }
#pragma unroll
                for (int e = 0; e < 4; ++e) { const unsigned gw = gv[2 + (e >> 1)], mw = mv[2 + (e >> 1)];
                    const float g = (e & 1) ? bfhi(gw) : bflo(gw), ma = (e & 1) ? bfhi(mw) : bflo(mw);
                    o1[e] = sigm(g) * (acc[ai][0][m][1][e] * sigm(acc[ai][1][m][1][e])) + ma; }
                *(u32x4*)(M + off) = pack8(o0, o1); }
    }
};
struct EpiStat {
    static constexpr bool PERM = true, AFTER_DRAIN = false;
    bf16_t* O; float* stat;
    __device__ __forceinline__ void operator()(const f32x4 (&acc)[2][2][4][2], const Unit& u, int wr, int wc, int fr, int fq) const {
        asm volatile("" : "+v"(fr), "+v"(fq));
        const int row0 = u.pm * BM + wr * 64 + fr, col0 = u.pn * BM + wc * 32 + 8 * fq;
#pragma unroll
        for (int ai = 0; ai < 2; ++ai)
#pragma unroll
            for (int m = 0; m < 4; ++m) { const int row = row0 + ai * HALF + m * 16; float ss = 0.f;
#pragma unroll
                for (int bj = 0; bj < 2; ++bj) { const f32x4 a = acc[ai][bj][m][0], b = acc[ai][bj][m][1]; ss += sumsq8(a, b);
                    *(u32x4*)(O + (size_t)row * 4096 + col0 + bj * HALF) = pack8(a, b); }
                ss += __shfl_xor(ss, 16); ss += __shfl_xor(ss, 32);
                if (fq == 0) stat[row * 64 + u.pn * 4 + wc] = ss; }
    }
};
struct EpiRelu2 {
    static constexpr bool PERM = true, AFTER_DRAIN = false;
    bf16_t* O;
    __device__ __forceinline__ void operator()(const f32x4 (&acc)[2][2][4][2], const Unit& u, int wr, int wc, int fr, int fq) const {
        asm volatile("" : "+v"(fr), "+v"(fq));
        const int row0 = u.pm * BM + wr * 64 + fr, col0 = u.pn * BM + wc * 32 + 8 * fq;
#pragma unroll
        for (int ai = 0; ai < 2; ++ai)
#pragma unroll
            for (int m = 0; m < 4; ++m) { bf16_t* rowp = O + (size_t)(row0 + ai * HALF + m * 16) * 16384 + col0;
#pragma unroll
                for (int bj = 0; bj < 2; ++bj) { f32x4 a = acc[ai][bj][m][0], b = acc[ai][bj][m][1];
#pragma unroll
                    for (int e = 0; e < 4; ++e) { const float x = fmaxf(a[e], 0.f), y = fmaxf(b[e], 0.f); a[e] = x * x; b[e] = y * y; }
                    *(u32x4*)(rowp + bj * HALF) = pack8(a, b); } }
    }
};

template <class Epi, class Sched, bool ALIGN_EPI = false, bool SP2 = false>
__device__ __forceinline__ void gemm_phase(PG8_LAS unsigned char* lds, const Gemm g, const Sched& S, const Epi& E) {
    int tid_ = threadIdx.x; asm volatile("" : "+v"(tid_));
    const int tid = tid_, wid = __builtin_amdgcn_readfirstlane(tid >> 6), lane = tid & 63, wr = wid >> 2, wc = wid & 3, fr = lane & 15, fq = lane >> 4;
    const int K = g.K, nt = K / BK, lda = g.lda, ldb = g.ldb;
    unsigned voffA[2], voffB[2];
#pragma unroll
    for (int i = 0; i < 2; ++i) { int R, C; stage_rc(tid * 16 + i * 8192, R, C); const int Rb = Epi::PERM ? ((R & ~31) + perm32(R & 31)) : R;
        voffA[i] = (unsigned)(R * lda + C) * 2u; voffB[i] = (unsigned)(Rb * ldb + C) * 2u; }
    const size_t kstep = (size_t)(BK * 2);
    const size_t hstepA = (size_t)HALF * lda * 2, hstepB = (size_t)HALF * ldb * 2;
    const size_t tstepA = 2 * hstepA, tstepB = 2 * hstepB;
    const unsigned ldsw = (unsigned)wid * 1024u;
    const int aoff = lds_byte(wr * 64 + fr, fq * 8), boff = lds_byte(wc * 32 + fr, fq * 8);
#define PG8_SA(b, h) (((b) * 2 + (h)) * HTB)
#define PG8_SB(b, h) ((4 + (b) * 2 + (h)) * HTB)
#define PG8_STAGE(bufoff, gbase, voff) do { _Pragma("unroll") for (int _i = 0; _i < 2; ++_i) \
        __builtin_amdgcn_global_load_lds((const unsigned*)((const char*)(gbase) + (voff)[_i]), (PG8_LAS unsigned*)(lds + (bufoff) + ldsw + _i * 8192), 16, 0, 0); } while (0)
#define PG8_LDA(dst, b, h) do { _Pragma("unroll") for (int m = 0; m < 4; ++m) _Pragma("unroll") for (int k = 0; k < 2; ++k) dst[m][k] = *(const PG8_LAS bf16x8*)(lds + PG8_SA(b, h) + aoff + m * 2048 + k * 1024); } while (0)
#define PG8_LDB(dst, b, h) do { _Pragma("unroll") for (int n = 0; n < 2; ++n) _Pragma("unroll") for (int k = 0; k < 2; ++k) dst[n][k] = *(const PG8_LAS bf16x8*)(lds + PG8_SB(b, h) + boff + n * 2048 + k * 1024); } while (0)
#define PG8_MMA(ai, bj, At, Bt) do { __builtin_amdgcn_s_setprio(1); _Pragma("unroll") for (int m = 0; m < 4; ++m) _Pragma("unroll") for (int n = 0; n < 2; ++n) _Pragma("unroll") for (int k = 0; k < 2; ++k) \
        acc[ai][bj][m][n] = __builtin_amdgcn_mfma_f32_16x16x32_bf16(Bt[n][k], At[m][k], acc[ai][bj][m][n], 0, 0, 0); __builtin_amdgcn_s_setprio(0); } while (0)
#define PG8_WAIT_V(n) asm volatile("s_waitcnt vmcnt(" #n ")" ::: "memory")
#define PG8_WAIT_L(n) asm volatile("s_waitcnt lgkmcnt(" #n ")" ::: "memory")
#define PG8_BAR __builtin_amdgcn_s_barrier()
#define PG8_SCHED __builtin_amdgcn_sched_barrier(0)
    Unit cur, nxt; int ui = 0;
    if (!S.next(0, cur)) return;
    f32x4 acc[2][2][4][2];
#pragma unroll
    for (int a = 0; a < 2; ++a)
#pragma unroll
        for (int b = 0; b < 2; ++b)
#pragma unroll
            for (int m = 0; m < 4; ++m)
#pragma unroll
                for (int n = 0; n < 2; ++n) acc[a][b][m][n] = (f32x4){0.f, 0.f, 0.f, 0.f};
    bf16x8 At[4][2], B0[2][2], B1[2][2];
    const char* cA = (const char*)g.A + (size_t)cur.pm * tstepA; const char* cB = (const char*)g.Bt + (size_t)cur.pn * tstepB;
    S.a_ready(cur);
    if constexpr (SP2) {
        PG8_STAGE(PG8_SB(0, 0), cB, voffB); PG8_STAGE(PG8_SB(0, 1), cB + hstepB, voffB); PG8_STAGE(PG8_SA(0, 0), cA, voffA); PG8_STAGE(PG8_SA(0, 1), cA + hstepA, voffA);
        if (wr == 1) PG8_BAR;
        PG8_WAIT_V(2); PG8_BAR;
        PG8_STAGE(PG8_SB(1, 0), cB + kstep, voffB); PG8_STAGE(PG8_SA(1, 0), cA + kstep, voffA); PG8_STAGE(PG8_SB(1, 1), cB + hstepB + kstep, voffB);
        PG8_WAIT_V(6); PG8_BAR;
    } else {
        PG8_STAGE(PG8_SB(0, 0), cB, voffB); PG8_STAGE(PG8_SA(0, 0), cA, voffA); PG8_STAGE(PG8_SB(0, 1), cB + hstepB, voffB); PG8_STAGE(PG8_SA(0, 1), cA + hstepA, voffA);
        if (wr == 1) PG8_BAR;
        PG8_WAIT_V(4); PG8_BAR;
        PG8_STAGE(PG8_SB(1, 0), cB + kstep, voffB); PG8_STAGE(PG8_SA(1, 0), cA + kstep, voffA); PG8_STAGE(PG8_SB(1, 1), cB + hstepB + kstep, voffB);
        PG8_WAIT_V(6); PG8_BAR;
    }
    for (;;) {
        const bool has_next = S.next(ui + 1, nxt);
        const char* nA = has_next ? (const char*)g.A + (size_t)nxt.pm * tstepA : cA; const char* nB = has_next ? (const char*)g.Bt + (size_t)nxt.pn * tstepB : cB;
        for (int t = 0; t < nt; t += 2) {
            const bool last = (t == nt - 2);
            const char* a1 = cA + (size_t)(t + 1) * kstep;
            const char* a2 = last ? nA : cA + (size_t)(t + 2) * kstep; const char* b2 = last ? nB : cB + (size_t)(t + 2) * kstep;
            const char* a3 = a2 + kstep; const char* b3 = b2 + kstep;
            if (last && has_next) S.a_ready(nxt);
            if constexpr (SP2) {
            PG8_LDB(B0, 0, 0); PG8_LDB(B1, 0, 1); PG8_SCHED; PG8_LDA(At, 0, 0); PG8_STAGE(PG8_SA(1, 1), a1 + hstepA, voffA);
            PG8_WAIT_V(8); PG8_WAIT_L(0); PG8_BAR; PG8_MMA(0, 0, At, B0); PG8_MMA(0, 1, At, B1); PG8_BAR; PG8_SCHED;
            PG8_LDA(At, 0, 1); PG8_STAGE(PG8_SB(0, 0), b2, voffB); PG8_STAGE(PG8_SB(0, 1), b2 + hstepB, voffB); PG8_STAGE(PG8_SA(0, 0), a2, voffA);
            PG8_WAIT_V(8); PG8_WAIT_L(0); PG8_BAR; PG8_MMA(1, 0, At, B0); PG8_MMA(1, 1, At, B1); PG8_BAR; PG8_SCHED;
            PG8_LDB(B0, 1, 0); PG8_LDB(B1, 1, 1); PG8_SCHED; PG8_LDA(At, 1, 0); PG8_STAGE(PG8_SA(0, 1), a2 + hstepA, voffA);
            PG8_WAIT_V(8); PG8_WAIT_L(0); PG8_BAR; PG8_MMA(0, 0, At, B0); PG8_MMA(0, 1, At, B1); PG8_BAR; PG8_SCHED;
            PG8_LDA(At, 1, 1); PG8_STAGE(PG8_SB(1, 0), b3, voffB); PG8_STAGE(PG8_SB(1, 1), b3 + hstepB, voffB); PG8_STAGE(PG8_SA(1, 0), a3, voffA);
            PG8_WAIT_V(8); PG8_WAIT_L(0); PG8_BAR; PG8_MMA(1, 0, At, B0); PG8_MMA(1, 1, At, B1); PG8_BAR; PG8_SCHED;
            } else {
            PG8_LDB(B0, 0, 0); PG8_SCHED; PG8_LDA(At, 0, 0); PG8_STAGE(PG8_SA(1, 1), a1 + hstepA, voffA);
            PG8_WAIT_L(8); PG8_BAR; PG8_WAIT_L(0); PG8_MMA(0, 0, At, B0); PG8_BAR; PG8_SCHED;
            PG8_LDB(B1, 0, 1); PG8_STAGE(PG8_SB(0, 0), b2, voffB);
            PG8_BAR; PG8_WAIT_L(0); PG8_MMA(0, 1, At, B1); PG8_BAR;
            PG8_LDA(At, 0, 1); PG8_STAGE(PG8_SA(0, 0), a2, voffA);
            PG8_BAR; PG8_WAIT_L(0); PG8_MMA(1, 0, At, B0); PG8_BAR; PG8_SCHED;
            PG8_STAGE(PG8_SB(0, 1), b2 + hstepB, voffB);
            PG8_WAIT_V(6); PG8_BAR; PG8_MMA(1, 1, At, B1); PG8_BAR;
            PG8_LDB(B0, 1, 0); PG8_SCHED; PG8_LDA(At, 1, 0); PG8_STAGE(PG8_SA(0, 1), a2 + hstepA, voffA);
            PG8_WAIT_L(8); PG8_BAR; PG8_WAIT_L(0); PG8_MMA(0, 0, At, B0); PG8_BAR; PG8_SCHED;
            PG8_LDB(B1, 1, 1); PG8_STAGE(PG8_SB(1, 0), b3, voffB);
            PG8_BAR; PG8_WAIT_L(0); PG8_MMA(0, 1, At, B1); PG8_BAR;
            PG8_LDA(At, 1, 1); PG8_STAGE(PG8_SA(1, 0), a3, voffA);
            PG8_BAR; PG8_WAIT_L(0); PG8_MMA(1, 0, At, B0); PG8_BAR; PG8_SCHED;
            PG8_STAGE(PG8_SB(1, 1), b3 + hstepB, voffB);
            PG8_WAIT_V(6); PG8_BAR; PG8_MMA(1, 1, At, B1); PG8_BAR;
            }
        }
        if constexpr (ALIGN_EPI) { if (wr == 0) PG8_BAR; }
        if constexpr (!Epi::AFTER_DRAIN) { E(acc, cur, wr, wc, fr, fq); S.done(cur); }
        if (!has_next) break;
#pragma unroll
        for (int a = 0; a < 2; ++a)
#pragma unroll
            for (int b = 0; b < 2; ++b)
#pragma unroll
                for (int m = 0; m < 4; ++m)
#pragma unroll
                    for (int n = 0; n < 2; ++n) acc[a][b][m][n] = (f32x4){0.f, 0.f, 0.f, 0.f};
        cur = nxt; cA = nA; cB = nB; ++ui;
        if constexpr (ALIGN_EPI) { if (wr == 1) PG8_BAR; }
    }
    PG8_WAIT_V(0);
    if constexpr (!ALIGN_EPI) { if (wr == 0) PG8_BAR; }
    PG8_BAR;
    if constexpr (Epi::AFTER_DRAIN) { E.fused(acc, cur, wr, wc, fr, fq, lds, wid, lane); S.done(cur); }
#undef PG8_SA
#undef PG8_SB
#undef PG8_STAGE
#undef PG8_LDA
#undef PG8_LDB
#undef PG8_MMA
#undef PG8_WAIT_V
#undef PG8_WAIT_L
#undef PG8_BAR
#undef PG8_SCHED
}
}

namespace att {
using bf16x8 = __attribute__((ext_vector_type(8))) short;
using s16x4  = __attribute__((ext_vector_type(4))) short;
using f32x16 = __attribute__((ext_vector_type(16))) float;
using u32x4  = __attribute__((ext_vector_type(4))) unsigned;
typedef unsigned short bf16;
#ifndef ATT_SDEPTH
#define ATT_SDEPTH 1
#endif
constexpr int NW = 8, QBLK = 32, KVBLK = 64;
constexpr int SHM_V = 16384, SHM_K = 16384, SHM_R = 8192;
constexpr int OFF_V = 0, OFF_K = 2 * SHM_V, OFF_R = OFF_K + 2 * SHM_K, OFF_WS = OFF_R + 2 * SHM_R, ATT_LDS = OFF_WS + NW * 256;
constexpr int LDQ = 6144, LDK = 8192, LDR = 64, LDO = 4096;
constexpr float THR_L2 = 11.5415603f;
#define KSWZ(row, colB) ((row) * 256 + ((colB) ^ (((row) & 15) << 4)))
#define RSWZ(row, colB) ((row) * 128 + ((colB) ^ ((((row) >> 1) & 7) << 4)))
#define SBAR() __builtin_amdgcn_sched_barrier(0)
__device__ __forceinline__ int crow(int r, int hi) { return (r & 3) + 8 * (r >> 2) + 4 * hi; }
__device__ __forceinline__ unsigned cvtpk(float lo, float hi) { unsigned r; asm volatile("v_cvt_pk_bf16_f32 %0, %1, %2" : "=v"(r) : "v"(lo), "v"(hi)); return r; }
__device__ __forceinline__ bf16x8 ld8(const bf16* p) { return *reinterpret_cast<const bf16x8*>(p); }

__device__ __forceinline__ void partialSM(f32x16& p0, f32x16& p1, float& m_reg, float& mn, float& alpha) {
  float pmax = p0[0];
#pragma unroll
  for (int r = 1; r < 16; ++r) pmax = fmaxf(pmax, p0[r]);
#pragma unroll
  for (int r = 0; r < 16; ++r) pmax = fmaxf(pmax, p1[r]);
  { auto rr = __builtin_amdgcn_permlane32_swap(__float_as_uint(pmax), __float_as_uint(pmax), false, false);
    pmax = fmaxf(__uint_as_float(rr[0]), __uint_as_float(rr[1])); }
  if (__builtin_expect(__all(pmax - m_reg <= THR_L2), 1)) { mn = m_reg; alpha = 1.f; }
  else { mn = fmaxf(m_reg, pmax); alpha = __builtin_amdgcn_exp2f(m_reg - mn); m_reg = mn; }
#pragma unroll
  for (int r = 0; r < 16; ++r) p0[r] = p0[r] - mn;
#pragma unroll
  for (int r = 0; r < 16; ++r) p1[r] = p1[r] - mn;
#pragma unroll
  for (int r = 0; r < 16; ++r) p0[r] = __builtin_amdgcn_exp2f(p0[r]);
}
__device__ __forceinline__ void finishSM(f32x16& p0, f32x16& p1, float alpha, float& l_reg, bf16x8& pa0, bf16x8& pa1, bf16x8& pa2, bf16x8& pa3) {
#pragma unroll
  for (int r = 0; r < 16; ++r) p1[r] = __builtin_amdgcn_exp2f(p1[r]);
  float ps = 0;
#pragma unroll
  for (int r = 0; r < 16; ++r) ps += p0[r];
#pragma unroll
  for (int r = 0; r < 16; ++r) ps += p1[r];
  { auto rr = __builtin_amdgcn_permlane32_swap(__float_as_uint(ps), __float_as_uint(ps), false, false);
    ps = __uint_as_float(rr[0]) + __uint_as_float(rr[1]); }
  l_reg = l_reg * alpha + ps;
#define PK4(P, BASE, OUT) do { u32x4 w = {cvtpk(P[BASE + 0], P[BASE + 1]), cvtpk(P[BASE + 2], P[BASE + 3]), cvtpk(P[BASE + 4], P[BASE + 5]), cvtpk(P[BASE + 6], P[BASE + 7])}; OUT = *reinterpret_cast<bf16x8*>(&w); } while (0)
  PK4(p0, 0, pa0); PK4(p0, 8, pa1); PK4(p1, 0, pa2); PK4(p1, 8, pa3);
#undef PK4
}
__device__ __forceinline__ void qkt(f32x16& p0, f32x16& p1, const char* Ks, const char* Rs, const bf16x8* qn, const bf16x8* qr, int r32, int hi) {
  p0 = f32x16{}; p1 = f32x16{};
#pragma unroll
  for (int d0 = 0; d0 < 8; ++d0) { const int cb = (d0 * 16 + hi * 8) * 2;
    bf16x8 b0 = *reinterpret_cast<const bf16x8*>(Ks + KSWZ(r32, cb));
    bf16x8 b1 = *reinterpret_cast<const bf16x8*>(Ks + KSWZ(32 + r32, cb));
    p0 = __builtin_amdgcn_mfma_f32_32x32x16_bf16(b0, qn[d0], p0, 0, 0, 0);
    p1 = __builtin_amdgcn_mfma_f32_32x32x16_bf16(b1, qn[d0], p1, 0, 0, 0); }
#pragma unroll
  for (int d0 = 0; d0 < 4; ++d0) { const int cb = (d0 * 16 + hi * 8) * 2;
    bf16x8 b0 = *reinterpret_cast<const bf16x8*>(Rs + RSWZ(r32, cb));
    bf16x8 b1 = *reinterpret_cast<const bf16x8*>(Rs + RSWZ(32 + r32, cb));
    p0 = __builtin_amdgcn_mfma_f32_32x32x16_bf16(b0, qr[d0], p0, 0, 0, 0);
    p1 = __builtin_amdgcn_mfma_f32_32x32x16_bf16(b1, qr[d0], p1, 0, 0, 0); }
}
__device__ __forceinline__ int v_st(int k, int c) { const int kk = (k & ~0xC) | ((k & 4) << 1) | ((k & 8) >> 1); return ((kk >> 3) * 4 + (c >> 5)) * 512 + ((kk & 7) * 32 + (c & 31)) * 2; }
__device__ __forceinline__ int v_rd_base(int lane) { return ((lane & 3) << 3) | (((lane >> 2) & 3) << 6) | (((lane >> 4) & 1) << 5) | (((lane >> 5) & 1) << 8); }
constexpr int v_rd_off(int d0, int ks, int half) { return d0 * 512 + ks * 4096 + half * 2048; }
template <int OFF> __device__ __forceinline__ s16x4 tr_read(int vb) {
  s16x4 r; asm volatile("ds_read_b64_tr_b16 %0, %1 offset:%2" : "=&v"(r) : "v"(vb), "i"(OFF) : "memory"); return r;
}
template <int D0> __device__ __forceinline__ void pv_one(f32x16& od, int vb, bf16x8 pa0, bf16x8 pa1, bf16x8 pa2, bf16x8 pa3) {
  const s16x4 l0 = tr_read<v_rd_off(D0, 0, 0)>(vb), h0 = tr_read<v_rd_off(D0, 0, 1)>(vb), l1 = tr_read<v_rd_off(D0, 1, 0)>(vb), h1 = tr_read<v_rd_off(D0, 1, 1)>(vb);
  const s16x4 l2 = tr_read<v_rd_off(D0, 2, 0)>(vb), h2 = tr_read<v_rd_off(D0, 2, 1)>(vb), l3 = tr_read<v_rd_off(D0, 3, 0)>(vb), h3 = tr_read<v_rd_off(D0, 3, 1)>(vb);
  asm volatile("s_waitcnt lgkmcnt(0)" ::: "memory"); SBAR();
#define PK(L, H) (bf16x8){L[0], L[1], L[2], L[3], H[0], H[1], H[2], H[3]}
  od = __builtin_amdgcn_mfma_f32_32x32x16_bf16(pa0, PK(l0, h0), od, 0, 0, 0);
  od = __builtin_amdgcn_mfma_f32_32x32x16_bf16(pa1, PK(l1, h1), od, 0, 0, 0);
  od = __builtin_amdgcn_mfma_f32_32x32x16_bf16(pa2, PK(l2, h2), od, 0, 0, 0);
  od = __builtin_amdgcn_mfma_f32_32x32x16_bf16(pa3, PK(l3, h3), od, 0, 0, 0);
#undef PK
}
__device__ __forceinline__ void pv_d0(f32x16* o, int vb, bf16x8 pa0, bf16x8 pa1, bf16x8 pa2, bf16x8 pa3) {
  pv_one<0>(o[0], vb, pa0, pa1, pa2, pa3); pv_one<1>(o[1], vb, pa0, pa1, pa2, pa3); pv_one<2>(o[2], vb, pa0, pa1, pa2, pa3); pv_one<3>(o[3], vb, pa0, pa1, pa2, pa3);
}
__device__ __forceinline__ float sigm(float x) { return __builtin_amdgcn_rcpf(1.0f + __builtin_amdgcn_exp2f(-1.4426950408889634f * x)); }
__device__ __forceinline__ unsigned short f2bf(float f) { unsigned u = __float_as_uint(f); return (unsigned short)((u + 0x7fffu + ((u >> 16) & 1u)) >> 16); }

typedef __attribute__((address_space(3))) const char* lds_cptr;
typedef short v4i16_t __attribute__((ext_vector_type(4)));
typedef float f32x2_t __attribute__((ext_vector_type(2))); typedef __bf16 bf16x2_t __attribute__((ext_vector_type(2)));
__device__ __forceinline__ unsigned cvtpk_s(float lo, float hi) { f32x2_t v = {lo, hi}; bf16x2_t b = __builtin_convertvector(v, bf16x2_t); return __builtin_bit_cast(unsigned, b); }
__device__ __forceinline__ s16x4 vtr(lds_cptr p) { return __builtin_bit_cast(s16x4, __builtin_amdgcn_ds_read_tr16_b64_v4i16((__attribute__((address_space(3))) v4i16_t*)p)); }
#define EX2(x) __builtin_amdgcn_exp2f(x)
#define MFMA32(a, b, c) __builtin_amdgcn_mfma_f32_32x32x16_bf16(a, b, c, 0, 0, 0)
__device__ __forceinline__ void phaseA(f32x16& n0, f32x16& n1, const f32x16& q0, f32x16& q1, float alpha, float& l_reg, bf16x8& pa0, bf16x8& pa1, bf16x8& pa2, bf16x8& pa3,
                                       const char* Ks, const char* Rs, const bf16x8* qn, const bf16x8* qr, int kpre, int rpre, float ones_k0, float neg_m) {
  asm volatile("" : "+v"(kpre), "+v"(rpre));
  n0 = __builtin_amdgcn_mfma_f32_32x32x2f32(ones_k0, neg_m, f32x16{}, 0, 0, 0); n1 = __builtin_amdgcn_mfma_f32_32x32x2f32(ones_k0, neg_m, f32x16{}, 0, 0, 0);
  float s0 = 0.f, s1 = 0.f; unsigned ca0 = 0, ca1 = 0, cb0 = 0, cb1 = 0; float ps = 0.f;
#define PKA(P, B) do { ca0 = cvtpk_s(P[B + 0], P[B + 1]); ca1 = cvtpk_s(P[B + 2], P[B + 3]); } while (0)
#define PKB(P, B) do { cb0 = cvtpk_s(P[B + 4], P[B + 5]); cb1 = cvtpk_s(P[B + 6], P[B + 7]); } while (0)
#define PKS(OUT) do { u32x4 w_ = {ca0, ca1, cb0, cb1}; OUT = *reinterpret_cast<bf16x8*>(&w_); } while (0)
  constexpr int KPF = 2;
  bf16x8 kq0[KPF + 1], kq1[KPF + 1];
#define KFRAG(st) do { if ((st) < 8) { const int ad_ = kpre ^ ((st) * 32); kq0[(st) % (KPF + 1)] = *reinterpret_cast<const bf16x8*>(Ks + ad_); kq1[(st) % (KPF + 1)] = *reinterpret_cast<const bf16x8*>(Ks + ad_ + 8192); } \
    else { const int ad_ = rpre ^ (((st) - 8) * 32); kq0[(st) % (KPF + 1)] = *reinterpret_cast<const bf16x8*>(Rs + ad_); kq1[(st) % (KPF + 1)] = *reinterpret_cast<const bf16x8*>(Rs + ad_ + 4096); } } while (0)
#pragma unroll
  for (int s = 0; s < KPF; ++s) KFRAG(s);
#pragma unroll
  for (int s = 0; s < 12; ++s) {
    if (s + KPF < 12) KFRAG(s + KPF);
    const bf16x8 kb0 = kq0[s % (KPF + 1)], kb1 = kq1[s % (KPF + 1)];
    const bf16x8 qf = s < 8 ? qn[s < 8 ? s : 0] : qr[s >= 8 ? s - 8 : 0];
    n0 = MFMA32(kb0, qf, n0);
    if (s < 8) { q1[2 * s] = EX2(q1[2 * s]); s0 += q0[2 * s]; s0 += q0[2 * s + 1]; }
    if (s == 0) PKA(q0, 0); if (s == 1) PKS(pa0); if (s == 2) PKA(q0, 8); if (s == 3) PKS(pa1);
    if (s == 4) PKA(q1, 0); if (s == 5) PKS(pa2); if (s == 8) PKA(q1, 8); if (s == 9) PKS(pa3);
    if (s == 10) { ps = s0 + s1; auto rr = __builtin_amdgcn_permlane32_swap(__float_as_uint(ps), __float_as_uint(ps), false, false); ps = __uint_as_float(rr[0]) + __uint_as_float(rr[1]); }
    SBAR();
    n1 = MFMA32(kb1, qf, n1);
    if (s < 8) { q1[2 * s + 1] = EX2(q1[2 * s + 1]); }
    if (s >= 2 && s < 10) { s1 += q1[2 * (s - 2)]; s1 += q1[2 * (s - 2) + 1]; }
    if (s == 0) PKB(q0, 0); if (s == 2) PKB(q0, 8); if (s == 4) PKB(q1, 0); if (s == 8) PKB(q1, 8);
    if (s == 11) l_reg = l_reg * alpha + ps;
    SBAR();
  }
#undef KFRAG
#undef PKA
#undef PKB
#undef PKS
}
__device__ __forceinline__ void decide_rel(f32x16& p0, f32x16& p1, float& m_reg, float& alpha) {
  float a = fmaxf(fmaxf(p0[0], p0[1]), p1[0]), b = fmaxf(fmaxf(p0[2], p0[3]), p1[1]); a = fmaxf(fmaxf(a, p1[2]), p1[3]);
#pragma unroll
  for (int r = 4; r < 16; r += 4) { a = fmaxf(fmaxf(a, p0[r]), p0[r + 1]); b = fmaxf(fmaxf(b, p0[r + 2]), p0[r + 3]); a = fmaxf(fmaxf(a, p1[r]), p1[r + 1]); b = fmaxf(fmaxf(b, p1[r + 2]), p1[r + 3]); }
  float pmax = fmaxf(a, b);
  { auto rr = __builtin_amdgcn_permlane32_swap(__float_as_uint(pmax), __float_as_uint(pmax), false, false); pmax = fmaxf(__uint_as_float(rr[0]), __uint_as_float(rr[1])); }
  if (__builtin_expect(__all(pmax <= THR_L2), 1)) { alpha = 1.f; }
  else { const float d = fmaxf(pmax, 0.f); alpha = __builtin_amdgcn_exp2f(-d); m_reg += d;
#pragma unroll
    for (int r = 0; r < 16; ++r) { p0[r] -= d; p1[r] -= d; } }
}
__device__ __forceinline__ void decide(const f32x16& p0, const f32x16& p1, float& m_reg, float& mn, float& alpha) {
  float a = fmaxf(fmaxf(p0[0], p0[1]), p1[0]), b = fmaxf(fmaxf(p0[2], p0[3]), p1[1]); a = fmaxf(fmaxf(a, p1[2]), p1[3]);
#pragma unroll
  for (int r = 4; r < 16; r += 4) { a = fmaxf(fmaxf(a, p0[r]), p0[r + 1]); b = fmaxf(fmaxf(b, p0[r + 2]), p0[r + 3]); a = fmaxf(fmaxf(a, p1[r]), p1[r + 1]); b = fmaxf(fmaxf(b, p1[r + 2]), p1[r + 3]); }
  float pmax = fmaxf(a, b);
  { auto rr = __builtin_amdgcn_permlane32_swap(__float_as_uint(pmax), __float_as_uint(pmax), false, false); pmax = fmaxf(__uint_as_float(rr[0]), __uint_as_float(rr[1])); }
  mn = fmaxf(m_reg, pmax); alpha = __builtin_amdgcn_exp2f(m_reg - mn); m_reg = mn;
}
typedef __attribute__((address_space(3))) char* lds_ptr;
struct DmaArgs { const bf16* kt; const bf16* rt; const bf16* vt; int koff0, koff1, roff, voff0, voff1; int dk, dr, dv; lds_ptr l3; };
#define GLDS(src, dstoff) __builtin_amdgcn_global_load_lds((const unsigned*)(src), (__attribute__((address_space(3))) unsigned*)(D.l3 + (dstoff)), 16, 0, 0)
constexpr int VPF = 3;
__device__ __forceinline__ void phaseB_pre(s16x4 (&l)[VPF + 1], s16x4 (&h)[VPF + 1], lds_cptr vp) {
#pragma unroll
  for (int i = 0; i < VPF; ++i) { l[i] = vtr(vp + v_rd_off(i >> 2, i & 3, 0)); h[i] = vtr(vp + v_rd_off(i >> 2, i & 3, 1)); }
}
template <bool DOK, bool DOV> __device__ __forceinline__ void phaseB(f32x16* o, f32x16& n0, f32x16& n1, bf16x8 pa0, bf16x8 pa1, bf16x8 pa2, bf16x8 pa3, lds_cptr vp,
                                                                          s16x4 (&l)[VPF + 1], s16x4 (&h)[VPF + 1], const DmaArgs& D) {
  constexpr int PF = VPF;
#pragma unroll
  for (int i = 0; i < 16; ++i) { const int d0 = i >> 2, ks = i & 3;
    if (i + PF < 16) { l[(i + PF) % (PF + 1)] = vtr(vp + v_rd_off((i + PF) >> 2, (i + PF) & 3, 0)); h[(i + PF) % (PF + 1)] = vtr(vp + v_rd_off((i + PF) >> 2, (i + PF) & 3, 1)); }
    const s16x4 lc = l[i % (PF + 1)], hc = h[i % (PF + 1)];
    const bf16x8 vf = (bf16x8){lc[0], lc[1], lc[2], lc[3], hc[0], hc[1], hc[2], hc[3]};
    o[d0] = MFMA32(ks == 0 ? pa0 : ks == 1 ? pa1 : ks == 2 ? pa2 : pa3, vf, o[d0]);
    n0[i] = EX2(n0[i]);
    {
      if (DOV && i == 0) GLDS(D.vt + D.voff0, D.dv);
      if (DOV && i == 1) GLDS(D.vt + D.voff1, D.dv + 1024);
      if (DOK && i == 2) GLDS(D.kt + D.koff0, D.dk);
      if (DOK && i == 3) GLDS(D.kt + D.koff1, D.dk + 1024);
      if (DOK && i == 4) GLDS(D.rt + D.roff, D.dr); }
    SBAR(); }
}
#undef GLDS

__device__ __forceinline__ void attn_unit(const bf16* __restrict__ Qn, const bf16* __restrict__ Qr, const bf16* __restrict__ Kh, const bf16* __restrict__ Vh,
                                          const bf16* __restrict__ Kr, const bf16* __restrict__ Ga, bf16* __restrict__ Mo, int seq, char* lds) {
  int tid_ = threadIdx.x; asm volatile("" : "+v"(tid_));
  const int tid = tid_, lane = tid & 63, r32 = lane & 31, hi = lane >> 5; const int wid = __builtin_amdgcn_readfirstlane(tid >> 6);
  char* V_lds = lds + OFF_V; char* K_lds = lds + OFF_K; char* R_lds = lds + OFF_R;
  const lds_ptr l3 = (lds_ptr)lds;
  float* ws = (float*)(lds + OFF_WS) + wid * 64; float* li_l = ws; float* al_l = ws + 32;
  float m_reg = -1e30f, l_reg = 0; f32x16 o[4] = {}; bf16x8 qn[8], qr[4];
  int koff[2], voff[2], roff;
#pragma unroll
  for (int i = 0; i < 2; ++i) { const int bi = wid * 2 + i;
    { const int row = 4 * bi + (lane >> 4), lc = (lane & 15) ^ (row & 15); koff[i] = row * LDK + lc * 8; }
    { const int k = (bi >> 1) * 8 + ((lane & 31) >> 2), cc = (2 * (bi & 1) + (lane >> 5)) * 32 + (lane & 3) * 8; voff[i] = k * LDK + cc; } }
  { const int row = 8 * wid + (lane >> 3), lc = (lane & 7) ^ ((row >> 1) & 7); roff = row * LDR + lc * 8; }
#define GLDS(src, dstoff) __builtin_amdgcn_global_load_lds((const unsigned*)(src), (__attribute__((address_space(3))) unsigned*)(l3 + (dstoff)), 16, 0, 0)
#define DMA_K(t, b) do { const bf16* ks_ = Kh + (long)(t) * KVBLK * LDK; GLDS(ks_ + koff[0], OFF_K + (b) * SHM_K + (wid * 2) * 1024); GLDS(ks_ + koff[1], OFF_K + (b) * SHM_K + (wid * 2 + 1) * 1024); \
    GLDS(Kr + (long)(t) * KVBLK * LDR + roff, OFF_R + (b) * SHM_R + wid * 1024); } while (0)
#define DMA_V(t, b) do { const bf16* vs_ = Vh + (long)(t) * KVBLK * LDK; GLDS(vs_ + voff[0], OFF_V + (b) * SHM_V + (wid * 2) * 1024); GLDS(vs_ + voff[1], OFF_V + (b) * SHM_V + (wid * 2 + 1) * 1024); } while (0)
#define RESC(a) do { if (__any((a) < 1.f)) { if (hi == 0) al_l[r32] = (a); asm volatile("s_waitcnt lgkmcnt(0)" ::: "memory"); \
    _Pragma("unroll") for (int d = 0; d < 4; ++d) _Pragma("unroll") for (int r = 0; r < 16; ++r) o[d][r] *= al_l[crow(r, hi)]; } } while (0)
  const int NT = seq / KVBLK;
  DMA_K(0, 0);
  { const bf16* Qw = Qn + (long)(wid * QBLK + r32) * LDQ + hi * 8;
#pragma unroll
    for (int d0 = 0; d0 < 8; ++d0) qn[d0] = ld8(Qw + d0 * 16);
    const bf16* Rw = Qr + (long)(wid * QBLK + r32) * LDQ + hi * 8;
#pragma unroll
    for (int d0 = 0; d0 < 4; ++d0) qr[d0] = ld8(Rw + d0 * 16); }
  const lds_cptr vp0 = (lds_cptr)V_lds + v_rd_base(lane);
  const int kpre = (r32 * 256 + ((r32 & 15) << 4)) ^ (hi * 16), rpre = (r32 * 128 + (((r32 >> 1) & 7) << 4)) ^ (hi * 16);
  f32x16 pA0, pA1, pB0, pB1; float mnA, alA, alB; bf16x8 pa0, pa1, pa2, pa3;
  const float ones_k0 = hi ? 0.f : 1.f;
  __syncthreads();
  DMA_K(1, 1); DMA_V(0, 0);
  qkt(pA0, pA1, K_lds, R_lds, qn, qr, r32, hi); decide(pA0, pA1, m_reg, mnA, alA);
#pragma unroll
  for (int r = 0; r < 16; ++r) { pA0[r] = EX2(pA0[r] - mnA); pA1[r] = pA1[r] - mnA; }
  __syncthreads();
  s16x4 vl[VPF + 1], vh[VPF + 1];
  DmaArgs D; D.koff0 = koff[0]; D.koff1 = koff[1]; D.roff = roff; D.voff0 = voff[0]; D.voff1 = voff[1]; D.l3 = l3;
#define DSET(tk, bk, tv, bv) do { D.kt = Kh + (long)(tk) * KVBLK * LDK; D.rt = Kr + (long)(tk) * KVBLK * LDR; D.vt = Vh + (long)(tv) * KVBLK * LDK; \
    D.dk = OFF_K + (bk) * SHM_K + (wid * 2) * 1024; D.dr = OFF_R + (bk) * SHM_R + wid * 1024; D.dv = OFF_V + (bv) * SHM_V + (wid * 2) * 1024; } while (0)
  for (int j = 1; j + 1 < NT; j += 2) {
    DSET(j + 1, 0, j, 1);
    SBAR(); phaseA(pB0, pB1, pA0, pA1, alA, l_reg, pa0, pa1, pa2, pa3, K_lds + SHM_K, R_lds + SHM_R, qn, qr, kpre, rpre, ones_k0, -m_reg);
    phaseB_pre(vl, vh, vp0);
    decide_rel(pB0, pB1, m_reg, alB); SBAR();
    phaseB<true, true>(o, pB0, pB1, pa0, pa1, pa2, pa3, vp0, vl, vh, D);
    RESC(alB); __syncthreads();
    DSET(j + 2, 1, j + 1, 0);
    SBAR(); phaseA(pA0, pA1, pB0, pB1, alB, l_reg, pa0, pa1, pa2, pa3, K_lds, R_lds, qn, qr, kpre, rpre, ones_k0, -m_reg);
    phaseB_pre(vl, vh, vp0 + SHM_V);
    decide_rel(pA0, pA1, m_reg, alA); SBAR();
    phaseB<true, true>(o, pA0, pA1, pa0, pa1, pa2, pa3, vp0 + SHM_V, vl, vh, D);
    RESC(alA); __syncthreads();
  }
  DSET(NT - 1, 0, NT - 1, 1);
  SBAR(); phaseA(pB0, pB1, pA0, pA1, alA, l_reg, pa0, pa1, pa2, pa3, K_lds + SHM_K, R_lds + SHM_R, qn, qr, kpre, rpre, ones_k0, -m_reg);
  phaseB_pre(vl, vh, vp0);
  decide_rel(pB0, pB1, m_reg, alB); SBAR();
  phaseB<false, true>(o, pB0, pB1, pa0, pa1, pa2, pa3, vp0, vl, vh, D);
  RESC(alB); __syncthreads();
#undef DSET
  finishSM(pB0, pB1, alB, l_reg, pa0, pa1, pa2, pa3); SBAR();
  pv_d0(o, (int)(unsigned)(uintptr_t)V_lds + v_rd_base(lane) + SHM_V, pa0, pa1, pa2, pa3);
  if (hi == 0) li_l[r32] = l_reg; asm volatile("s_waitcnt lgkmcnt(0)" ::: "memory");
  float rli[16];
#pragma unroll
  for (int r = 0; r < 16; ++r) rli[r] = __builtin_amdgcn_rcpf(li_l[crow(r, hi)]);
  bf16* Ow = Mo + (long)(wid * QBLK) * LDO; const bf16* Gw = Ga + (long)(wid * QBLK) * LDO;
#pragma unroll
  for (int r = 0; r < 16; ++r) { const int orow = crow(r, hi);
#pragma unroll
    for (int d0 = 0; d0 < 4; ++d0) { const long off = (long)orow * LDO + d0 * 32 + r32;
      const float g = __uint_as_float((unsigned)Gw[off] << 16);
      Ow[off] = f2bf(o[d0][r] * rli[r] * sigm(g)); } }
  __syncthreads();
#undef GLDS
#undef DMA_K
#undef DMA_V
#undef RESC
}
#undef KSWZ
#undef RSWZ
#undef SBAR
}

constexpr int NWAVES = 8;
constexpr int DM = 4096, NPR = 8192, NROW = 24576;
constexpr int NKEY = 8192 + 4 * 4608;
constexpr int NIN = 12032;
constexpr int NCHUNK = NROW / 16;
constexpr float EPSN = 1e-6f;
constexpr float QSCALE = 0.07216878364870322f * 1.4426950408889634f;
constexpr size_t O_Y = 0, O_CKV = 100663296, O_KR = 104857600, O_S5 = 105381888, O_END = 106430464;

constexpr size_t MiB = 1u << 20;
constexpr size_t WS_CTL = 0, CTL_ZERO_BYTES = 1 * MiB;
constexpr size_t WS_PAR = 1 * MiB;
constexpr size_t WS_TAB = 2 * MiB;
constexpr size_t WS_QSTAT = 3 * MiB;
constexpr size_t WS_KVSTAT = 5 * MiB;
constexpr size_t WS_OSTAT = 6 * MiB;
constexpr size_t WS_MODPART = 12 * MiB;
constexpr size_t WS_WGLU = 28 * MiB, WS_WOUT = 60 * MiB, WS_WUQ = 92 * MiB, WS_WUKV = 104 * MiB;
constexpr size_t WS_GA = 112 * MiB, WS_GB = 304 * MiB;
constexpr size_t WS_WFF1 = 112 * MiB, WS_WFF2 = 240 * MiB;
constexpr size_t WS_A = 496 * MiB;
constexpr size_t WS_X = 688 * MiB;
constexpr size_t WS_WIN = WS_X, WS_MSTATE = WS_X + 94 * MiB, WS_MCAT = WS_X + 110 * MiB, WS_QRAW = WS_X + 142 * MiB, WS_CKVRAW = WS_X + 190 * MiB,
                 WS_KRRAW = WS_X + 238 * MiB, WS_UH = WS_X + 244 * MiB;
constexpr size_t WS_Q = WS_X, WS_KV = WS_X + 288 * MiB;
constexpr size_t WS_OUTB = WS_X;
constexpr size_t WS_A1 = WS_X;
constexpr size_t WS_QN = 1392 * MiB, WS_CKVN = 1440 * MiB, WS_KR = 1466 * MiB, WS_YG = 1470 * MiB, WS_END = 1566 * MiB;
static_assert(WS_WIN + (size_t)NIN * 4096 * 2 <= WS_MSTATE && WS_UH + (size_t)128 * 1536 * 512 * 2 <= WS_QN && WS_KV + (size_t)NKEY * 8192 * 2 <= WS_QN, "arena");
static_assert(WS_KR + (size_t)NKEY * 64 * 2 <= WS_YG && WS_CKVN + (size_t)NKEY * 512 * 2 <= WS_KR && WS_A1 + (size_t)NROW * 16384 * 2 <= WS_END, "arena 2");
constexpr int CW_TMO = 0, CW_CODE = 1, CW_BAR = 4096;

constexpr int RING_OFF = 0, RING_BYTES = 131072;
constexpr int LDSCTL_OFF = RING_BYTES, MISC_OFF = LDSCTL_OFF + 320;
constexpr int LDS_BYTES = 147456;
static_assert(att::ATT_LDS <= RING_BYTES, "attention LDS");

#define GAS __attribute__((address_space(1)))
#define LAS __attribute__((address_space(3)))
typedef unsigned short bf16;
typedef unsigned v4u __attribute__((ext_vector_type(4)));
typedef float f32x4 __attribute__((ext_vector_type(4)));
typedef short bf16x8 __attribute__((ext_vector_type(8)));
typedef GAS unsigned gu32;
typedef GAS unsigned long long gu64;
#define RLX_AGENT __ATOMIC_RELAXED, __HIP_MEMORY_SCOPE_AGENT
#define LDS_WAIT() asm volatile("s_waitcnt lgkmcnt(0)" ::: "memory")
#define VM_WAIT() asm volatile("s_waitcnt vmcnt(0)" ::: "memory")
__device__ __forceinline__ unsigned long long rt() { return __builtin_amdgcn_s_memrealtime(); }
__device__ __forceinline__ unsigned f2bf(float f) { unsigned u = __builtin_bit_cast(unsigned, f); return (u + 0x7fffu + ((u >> 16) & 1u)) >> 16; }
__device__ __forceinline__ unsigned pk2(float lo, float hi) { return f2bf(lo) | (f2bf(hi) << 16); }

#define XB_TMO      128
#define XB_XCNT(j)  (256  + 64 * (j))
#define XB_XSUB(j)  (1280 + 64 * (j))
#define XB_XGEN(j)  (2304 + 64 * (j))
#define XB_TOP      3328
#define XB_TOPGEN   3392
#define XCD_BAR_WORDS 3456
#define XB_SPIN_CAP (1u << 18)

__device__ __forceinline__ unsigned xb_ld(unsigned* p)              { return __hip_atomic_load(p, __ATOMIC_RELAXED, __HIP_MEMORY_SCOPE_AGENT); }
__device__ __forceinline__ unsigned xb_add(unsigned* p, unsigned v) { return __hip_atomic_fetch_add(p, v, __ATOMIC_RELAXED, __HIP_MEMORY_SCOPE_AGENT); }
__device__ __forceinline__ unsigned xb_xcc_id() { return (unsigned)__builtin_amdgcn_s_getreg((3 << 11) | 20) & 0xFu; }
#define XB_SPIN(cond, bar) do { unsigned _sp = 0; while (cond) { __builtin_amdgcn_s_sleep(1); \
    if ((++_sp & 255u) == 0u) { if (xb_ld(&(bar)[XB_TMO])) break; if (_sp > XB_SPIN_CAP) { atomicAdd(&(bar)[XB_TMO], 1u); break; } } } } while (0)

struct XcdBarrier {
    unsigned* bar; unsigned x;
    volatile LAS unsigned* st;
};

__device__ __forceinline__ XcdBarrier xcd_barrier_post(unsigned* bar, volatile LAS unsigned* st) {
    XcdBarrier b; b.bar = bar; b.x = xb_xcc_id(); b.st = st;
    if (threadIdx.x == 0) (void)xb_add(&bar[XB_XCNT(b.x)], 1u);
    return b;
}
__device__ __forceinline__ void xcd_barrier_complete(unsigned* bar, unsigned x, unsigned& nloc, unsigned& nx) {
    const unsigned G = gridDim.x * gridDim.y * gridDim.z;
    unsigned sum, cnt, mine, sp = 0u;
    for (;;) {
        sum = 0u; cnt = 0u; mine = 0u;
#pragma unroll
        for (unsigned j = 0; j < 16; ++j) { const unsigned c = xb_ld(&bar[XB_XCNT(j)]); sum += c; cnt += (c > 0u) ? 1u : 0u; mine = (j == x) ? c : mine; }
        if (sum == G) break;
        __builtin_amdgcn_s_sleep(1);
        if ((++sp & 255u) == 0u) { if (xb_ld(&bar[XB_TMO])) break; if (sp > XB_SPIN_CAP) { atomicAdd(&bar[XB_TMO], 1u); break; } }
    }
    nloc = mine > 0u ? mine : 1u; nx = cnt > 0u ? cnt : 1u;
}

__device__ __forceinline__ void xcd_barrier(const XcdBarrier& b) {
    asm volatile("s_waitcnt vmcnt(0)" ::: "memory");
    __syncthreads();
    if (threadIdx.x == 0) {
        unsigned* bar = b.bar;
        __builtin_amdgcn_s_waitcnt(0);
        unsigned nloc = b.st[0], nx = b.st[1];
        if (nloc == 0u) { xcd_barrier_complete(bar, b.x, nloc, nx); b.st[0] = nloc; b.st[1] = nx; }
        const unsigned old = xb_add(&bar[XB_XSUB(b.x)], 1u);
        const unsigned gen = old / nloc;
        if (old + 1u == (gen + 1u) * nloc) {
            __builtin_amdgcn_fence(__ATOMIC_RELEASE, "agent");
            asm volatile("s_waitcnt vmcnt(0)" ::: "memory");
            const unsigned og = xb_add(&bar[XB_TOP], 1u);
            const unsigned tg = og / nx;
            if (og + 1u == (tg + 1u) * nx) xb_add(&bar[XB_TOPGEN], 1u);
            else XB_SPIN(xb_ld(&bar[XB_TOPGEN]) == tg, bar);
            __builtin_amdgcn_fence(__ATOMIC_ACQUIRE, "agent");
            xb_add(&bar[XB_XGEN(b.x)], 1u);
            asm volatile("s_waitcnt vmcnt(0)" ::: "memory");
        } else {
            XB_SPIN(xb_ld(&bar[XB_XGEN(b.x)]) == gen, bar);
            __builtin_amdgcn_fence(__ATOMIC_ACQUIRE, "agent");
            asm volatile("s_waitcnt vmcnt(0)" ::: "memory");
        }
    }
    __syncthreads();
}


typedef float f32x2 __attribute__((ext_vector_type(2)));
typedef unsigned u32x2 __attribute__((ext_vector_type(2)));
struct Frame {
    LAS unsigned char* lds;
    volatile LAS unsigned* MISC;
    gu32* ctl;
    int tid, lane, wave;
    int vcu, G;
    float* out; unsigned char* ws;
};
typedef const float* cfp_t;
typedef __attribute__((address_space(4))) const cfp_t* kargp_t;
__device__ __forceinline__ const float* inp(int k) { kargp_t p = (kargp_t)__builtin_amdgcn_kernarg_segment_ptr(); asm volatile("" : "+s"(p)); return p[k]; }
__device__ __forceinline__ float wave_sum(float v) {
#pragma unroll
    for (int o = 1; o < 64; o <<= 1) v += __shfl_xor(v, o);
    return v;
}
__device__ __forceinline__ float bf2f(unsigned short h) { return __uint_as_float((unsigned)h << 16); }
__device__ __forceinline__ float sigmf(float x) { return __builtin_amdgcn_rcpf(1.0f + __builtin_amdgcn_exp2f(-1.4426950408889634f * x)); }

__device__ __forceinline__ int mapcol(int code, int n) {
    if (code == 1) return n < 1536 ? n : (n < 11776 ? n + 64 : (n < 11840 ? n - 11776 + 1536 : -1));
    if (code == 2) { if (n < 4096) return (n >> 7) * 192 + (n & 127); const int m = n - 4096, h = m >> 6, i = m & 63; return h * 192 + 128 + (i >> 1) + 32 * (i & 1); }
    if (code == 3) { const int t = n >> 8, r = n & 255; return r < 128 ? t * 128 + r : 4096 + t * 128 + (r - 128); }
    return n;
}
__device__ __forceinline__ void transpose_item(const float* W, int K, int Nsrc, int Ndst, int code, bf16* WT, LAS float* scr, int item, int lane) {
    const int nblk = Ndst / 32, kb = item / nblk, nb = item - kb * nblk, k0 = 64 * kb, n0 = 32 * nb;
    const int sc = mapcol(code, n0 + (lane & 31));
#pragma unroll 8
    for (int i = 0; i < 32; ++i) { const int kk = 2 * i + (lane >> 5); scr[kk * 33 + (lane & 31)] = sc >= 0 ? W[(size_t)(k0 + kk) * Nsrc + sc] : 0.f; }
    LDS_WAIT(); asm volatile("" ::: "memory");
    const int c = lane & 7;
#pragma unroll
    for (int j = 0; j < 4; ++j) { const int n = (lane >> 3) + 8 * j; const LAS float* s = scr + (8 * c) * 33 + n;
        v4u o; o.x = pk2(s[0 * 33], s[1 * 33]); o.y = pk2(s[2 * 33], s[3 * 33]); o.z = pk2(s[4 * 33], s[5 * 33]); o.w = pk2(s[6 * 33], s[7 * 33]);
        *(GAS v4u*)(WT + (size_t)(n0 + n) * K + k0 + 8 * c) = o; }
    LDS_WAIT(); asm volatile("" ::: "memory");
}

struct ConvJob { const float* W; bf16* WT; int K, Nsrc, Ndst, code, item; };
__device__ __forceinline__ void conv_item_kn(const ConvJob& j, int& kb, int& nb) {
    const int nblk = j.Ndst / 32;
    if (j.code == 0 && j.K >= 4096 && (nblk & 31) == 0) { const int r = j.item & 2047, q = j.item >> 11, kg = j.K / 4096; kb = (q % kg) * 64 + (r >> 5); nb = (q / kg) * 32 + (r & 31); }
    else { kb = j.item / nblk; nb = j.item - kb * nblk; }
}
__device__ __forceinline__ void conv_load(const ConvJob& j, int lane, f32x4 (&v)[8]) {
    int kb, nb; conv_item_kn(j, kb, nb); const int k0 = 64 * kb, n0 = 32 * nb, c4 = lane & 7, r8 = lane >> 3;
    const int sc = mapcol(j.code, n0 + c4 * 4);
    if (sc >= 0) {
#pragma unroll
        for (int i = 0; i < 8; ++i) v[i] = __builtin_nontemporal_load((const GAS f32x4*)(j.W + (size_t)(k0 + i * 8 + r8) * j.Nsrc + sc));
    } else {
#pragma unroll
        for (int i = 0; i < 8; ++i) v[i] = (f32x4){0.f, 0.f, 0.f, 0.f};
    }
}
__device__ __forceinline__ void conv_lds_write(LAS float* scr, int lane, const f32x4 (&v)[8]) {
    const int c4 = lane & 7, r8 = lane >> 3;
#pragma unroll
    for (int i = 0; i < 8; ++i) { LAS float* d = scr + (i * 8 + r8) * 33 + c4 * 4; d[0] = v[i].x; d[1] = v[i].y; d[2] = v[i].z; d[3] = v[i].w; }
}
__device__ __forceinline__ void conv_store(const ConvJob& j, LAS float* scr, int lane) {
    int kb, nb; conv_item_kn(j, kb, nb); const int k0 = 64 * kb, n0 = 32 * nb, c = lane & 7;
#pragma unroll
    for (int jj = 0; jj < 4; ++jj) { const int n = (lane >> 3) + 8 * jj; const LAS float* s = scr + (8 * c) * 33 + n;
        v4u o; o.x = pk2(s[0 * 33], s[1 * 33]); o.y = pk2(s[2 * 33], s[3 * 33]); o.z = pk2(s[4 * 33], s[5 * 33]); o.w = pk2(s[6 * 33], s[7 * 33]);
        *(GAS v4u*)(j.WT + (size_t)(n0 + n) * j.K + k0 + 8 * c) = o; }
}
template <int MODE>
__device__ __forceinline__ ConvJob conv_resolve(int r, const float* w0, const float* w1, const float* w2, const float* w3, unsigned char* ws) {
    ConvJob j;
    if (MODE == 0) {
        constexpr int I_IN = (4096 / 64) * (NIN / 32), I_UKV = (512 / 64) * (8192 / 32), I_GLU = (2048 / 64) * (8192 / 32);
        if (r < I_IN) { j.W = w0; j.WT = (bf16*)(ws + WS_WIN); j.K = 4096; j.Nsrc = 11840; j.Ndst = NIN; j.code = 1; j.item = r; }
        else if (r < I_IN + I_UKV) { j.W = w1; j.WT = (bf16*)(ws + WS_WUKV); j.K = 512; j.Nsrc = 8192; j.Ndst = 8192; j.code = 0; j.item = r - I_IN; }
        else if (r < I_IN + I_UKV + I_GLU) { j.W = w2; j.WT = (bf16*)(ws + WS_WGLU); j.K = 2048; j.Nsrc = 8192; j.Ndst = 8192; j.code = 3; j.item = r - I_IN - I_UKV; }
        else { j.W = w3; j.WT = (bf16*)(ws + WS_WOUT); j.K = 4096; j.Nsrc = 4096; j.Ndst = 4096; j.code = 0; j.item = r - I_IN - I_UKV - I_GLU; }
    } else {
        constexpr int I_F1 = (4096 / 64) * (16384 / 32);
        if (r >= I_F1) { j.W = w0; j.WT = (bf16*)(ws + WS_WFF1); j.K = 4096; j.Nsrc = 16384; j.Ndst = 16384; j.code = 0; j.item = r - I_F1; }
        else { j.W = w1; j.WT = (bf16*)(ws + WS_WFF2); j.K = 16384; j.Nsrc = 4096; j.Ndst = 4096; j.code = 0; j.item = r; }
    }
    return j;
}
template <int MODE>
__device__ __forceinline__ void conv_run(const float* w0, const float* w1, const float* w2, const float* w3, unsigned char* ws, int total, int gw, int NGW, LAS float* scr, int lane, int first = 0) {
    int it = first + gw; if (it >= total) return;
    ConvJob cur = conv_resolve<MODE>(it, w0, w1, w2, w3, ws); f32x4 v[8]; conv_load(cur, lane, v);
    for (;;) {
        conv_lds_write(scr, lane, v);
        const int nit = it + NGW; const bool more = nit < total;
        if (more) { const ConvJob nxt = conv_resolve<MODE>(nit, w0, w1, w2, w3, ws); conv_load(nxt, lane, v); }
        LDS_WAIT(); asm volatile("" ::: "memory");
        conv_store(cur, scr, lane);
        LDS_WAIT(); asm volatile("" ::: "memory");
        if (!more) break;
        it = nit; cur = conv_resolve<MODE>(it, w0, w1, w2, w3, ws);
    }
}

__device__ __forceinline__ void adaln_unit(Frame& F, int id) {
    const int slab = id >> 5, ks = id & 31, k0 = ks * 128, col0 = slab * 1024;
    LAS float* sl = (LAS float*)(F.lds);
    LAS f32x4* red = (LAS f32x4*)(F.lds + 4096);
    for (int i = F.tid; i < 640; i += 512) { const int j = i >> 7, k = i & 127; const float v = (j == 0) ? inp(6)[k0 + k] : inp(2)[(j - 1) * 4096 + k0 + k];
        sl[i] = v / (1.0f + expf(-v)); }
    __syncthreads();
    const int c4 = F.tid & 255, kh = F.tid >> 8;
    f32x4 acc[5];
#pragma unroll
    for (int j = 0; j < 5; ++j) acc[j] = (f32x4){0.f, 0.f, 0.f, 0.f};
    const float* wp = inp(7) + (size_t)(k0 + kh * 64) * 24576 + col0 + c4 * 4;
#pragma unroll 8
    for (int kk = 0; kk < 64; ++kk) { const f32x4 w = *(const GAS f32x4*)(wp + (size_t)kk * 24576);
#pragma unroll
        for (int j = 0; j < 5; ++j) acc[j] += sl[j * 128 + kh * 64 + kk] * w; }
    if (kh == 1) {
#pragma unroll
        for (int j = 0; j < 5; ++j) red[j * 256 + c4] = acc[j]; }
    __syncthreads();
    if (kh == 0) { float* mp = (float*)(F.ws + WS_MODPART);
#pragma unroll
        for (int j = 0; j < 5; ++j) { const f32x4 v = acc[j] + red[j * 256 + c4]; *(GAS f32x4*)(mp + (size_t)(ks * 5 + j) * 24576 + col0 + c4 * 4) = v; } }
    __syncthreads();
}

__device__ __forceinline__ void s5_task(Frame& F, int g) {
    LAS f32x2* pw = (LAS f32x2*)(F.lds);
    LAS f32x2* coef = (LAS f32x2*)(F.lds + 17408);
    LAS f32x2* Bb = (LAS f32x2*)(F.lds + 18432);
    LAS f32x2* Cc = (LAS f32x2*)(F.lds + 34816);
    LAS float* Kt = (LAS float*)(F.lds + 51200);
    const int tid = F.tid;
    if (tid < 128) { const int dir = tid >> 6, p = tid & 63, idx = (dir * 128 + g) * 64 + p;
        const double lr = (double)inp(15)[idx], li = (double)inp(16)[idx], dt = exp((double)inp(17)[dir * 128 + g]);
        const double zr = lr * dt, zi = li * dt, er = exp(zr), ar = er * cos(zi), ai = er * sin(zi);
        const double nr = ar - 1.0, ni = ai, den = lr * lr + li * li;
        coef[dir * 64 + p] = (f32x2){(float)((nr * lr + ni * li) / den), (float)((ni * lr - nr * li) / den)};
        double pr = 1.0, pi = 0.0;
        for (int d = 0; d <= 16; ++d) { pw[(dir * 17 + d) * 64 + p] = (f32x2){(float)pr, (float)pi}; const double t = pr * ar - pi * ai; pi = pr * ai + pi * ar; pr = t; }
        const f32x2 a16 = pw[(dir * 17 + 16) * 64 + p];
        ((f32x2*)(F.ws + WS_PAR + 512 * 1024))[(dir * 128 + g) * 64 + p] = a16; }
    __syncthreads();
    for (int i = tid; i < 2048; i += 512) { const int dir = i >> 10, p = (i >> 4) & 63, j = i & 15; const size_t gi = ((size_t)(dir * 128 + g) * 64 + p) * 16 + j;
        const float br = inp(18)[gi], bi = inp(19)[gi]; const f32x2 cf = coef[dir * 64 + p];
        Bb[i] = (f32x2){cf.x * br - cf.y * bi, cf.x * bi + cf.y * br}; }
    for (int i = tid; i < 2048; i += 512) { const int dir = i >> 10; const size_t gi = (size_t)(dir * 128 + g) * 1024 + (i & 1023);
        Cc[i] = (f32x2){inp(20)[gi], inp(21)[gi]}; }
    __syncthreads();
    { const int dir = tid >> 8, jj = tid & 255, j = jj >> 4, jp = jj & 15; float acc[16];
#pragma unroll
        for (int d = 0; d < 16; ++d) acc[d] = 0.f;
        for (int p = 0; p < 64; ++p) { const f32x2 c = Cc[(dir * 16 + j) * 64 + p], b = Bb[(dir * 64 + p) * 16 + jp]; const float Pr = c.x * b.x - c.y * b.y, Pi = c.x * b.y + c.y * b.x;
#pragma unroll
            for (int d = 0; d < 16; ++d) { const f32x2 w = pw[(dir * 17 + d) * 64 + p]; acc[d] += Pr * w.x - Pi * w.y; } }
#pragma unroll
        for (int d = 0; d < 16; ++d) Kt[(dir * 16 + d) * 256 + jj] = acc[d]; }
    __syncthreads();
    bf16* Mcat = (bf16*)(F.ws + WS_MCAT) + (size_t)g * 256 * 512; bf16* Mst = (bf16*)(F.ws + WS_MSTATE) + (size_t)g * 256 * 256;
    for (int it = 0; it < 32; ++it) { const int idx = tid + 512 * it, n = idx >> 6, k8 = (idx & 63) * 8, tau = n >> 4, j = n & 15; float v[8];
        if (k8 < 256) { const int sg = k8 >> 4, j0 = k8 & 15;
#pragma unroll
            for (int e = 0; e < 8; ++e) { const int jp = j0 + e; float x = 0.f;
                if (sg <= tau) x += Kt[(0 * 16 + (tau - sg)) * 256 + j * 16 + jp];
                if (sg >= tau) x += Kt[(1 * 16 + (sg - tau)) * 256 + j * 16 + jp];
                if (sg == tau && j == jp) x += inp(22)[g * 16 + j];
                v[e] = x; }
        } else { const int kk = k8 - 256, dir = kk >> 7, part = (kk >> 6) & 1, p0 = kk & 63, ep = dir == 0 ? tau + 1 : 16 - tau;
#pragma unroll
            for (int e = 0; e < 8; ++e) { const f32x2 w = pw[(dir * 17 + ep) * 64 + p0 + e], c = Cc[(dir * 16 + j) * 64 + p0 + e];
                v[e] = part == 0 ? (c.x * w.x - c.y * w.y) : -(c.x * w.y + c.y * w.x); } }
        v4u o; o.x = pk2(v[0], v[1]); o.y = pk2(v[2], v[3]); o.z = pk2(v[4], v[5]); o.w = pk2(v[6], v[7]);
        *(GAS v4u*)(Mcat + (size_t)n * 512 + k8) = o; }
    for (int it = 0; it < 16; ++it) { const int idx = tid + 512 * it, n = idx >> 5, k8 = (idx & 31) * 8, dir = n >> 7, part = (n >> 6) & 1, p = n & 63, sg = k8 >> 4, j0 = k8 & 15, ep = dir == 0 ? 15 - sg : sg;
        const f32x2 w = pw[(dir * 17 + ep) * 64 + p]; float v[8];
#pragma unroll
        for (int e = 0; e < 8; ++e) { const f32x2 b = Bb[(dir * 64 + p) * 16 + j0 + e]; v[e] = part == 0 ? (w.x * b.x - w.y * b.y) : (w.x * b.y + w.y * b.x); }
        v4u o; o.x = pk2(v[0], v[1]); o.y = pk2(v[2], v[3]); o.z = pk2(v[4], v[5]); o.w = pk2(v[6], v[7]);
        *(GAS v4u*)(Mst + (size_t)n * 256 + k8) = o; }
    __syncthreads();
}

__device__ __forceinline__ void p0_prologue(Frame& F) {
    for (int id = F.vcu; id < 768; id += F.G) adaln_unit(F, id);
    for (int g = F.vcu; g < 128; g += F.G) s5_task(F, g);
    { float* tab = (float*)(F.ws + WS_TAB);
      for (int idx = F.vcu * 512 + F.tid; idx < 4096 * 32; idx += F.G * 512) { const int t = idx >> 5, p = idx & 31, pos = p < 16 ? (t >> 6) : (t & 63), f = p & 15;
        const double inv = exp(-(double)f * (9.210340371976184 / 16.0)), ang = (double)pos * inv;
        *(GAS f32x2*)(tab + (size_t)idx * 2) = (f32x2){(float)cos(ang), (float)sin(ang)}; } }
    LAS float* scr = (LAS float*)(F.lds + RING_OFF + F.wave * 16384);
    const int gw = F.vcu * NWAVES + F.wave, NGW = F.G * NWAVES;
    constexpr int I_IN = (4096 / 64) * (NIN / 32), I_UQ = (1024 / 64) * (6144 / 32), I_UKV = (512 / 64) * (8192 / 32), I_GLU = (2048 / 64) * (8192 / 32), I_OUT = (4096 / 64) * (4096 / 32);
    { constexpr int I_ALL = I_IN + I_UKV + I_GLU + I_OUT;
      if (F.G == 256) { constexpr int I_EVEN = (I_ALL * 3 / 4) & ~2047;
          conv_run<0>(inp(10), inp(14), inp(23), inp(24), F.ws, I_EVEN, gw, NGW, scr, F.lane);
          if (F.vcu >= 128) conv_run<0>(inp(10), inp(14), inp(23), inp(24), F.ws, I_ALL, gw - 128 * NWAVES, 128 * NWAVES, scr, F.lane, I_EVEN); }
      else conv_run<0>(inp(10), inp(14), inp(23), inp(24), F.ws, I_ALL, gw, NGW, scr, F.lane); }
    { const float* w_uq = inp(13);
      for (int it = gw; it < I_UQ; it += NGW) transpose_item(w_uq, 1024, 6144, 6144, 2, (bf16*)(F.ws + WS_WUQ), scr, it, F.lane); }
}
__device__ __forceinline__ void p0b_modreduce(Frame& F) {
    const float* mp = (const float*)(F.ws + WS_MODPART); float* par = (float*)(F.ws + WS_PAR);
    for (int idx = F.vcu * 512 + F.tid; idx < 5 * 4096; idx += F.G * 512) { const int j = idx >> 12, k = idx & 4095; float m[6];
#pragma unroll
        for (int i = 0; i < 6; ++i) { const int n = i * 4096 + k; float s = inp(8)[n];
            for (int ks = 0; ks < 32; ++ks) s += mp[(size_t)(ks * 5 + j) * 24576 + n];
            m[i] = s; }
        par[0 * 20480 + idx] = inp(9)[k] * (1.0f + m[1]); par[1 * 20480 + idx] = m[0]; par[2 * 20480 + idx] = m[2] * inp(25)[k];
        par[3 * 20480 + idx] = inp(26)[k] * (1.0f + m[4]); par[4 * 20480 + idx] = m[3]; par[5 * 20480 + idx] = m[5] * inp(29)[k]; }
}
__device__ __forceinline__ int cond_of_row(int m) { return m < NPR ? 0 : 1 + ((m - NPR) >> 12); }
__device__ __forceinline__ const float* xrow_of(const Frame& F, int m) { return m < NPR ? inp(0) + (size_t)m * DM : inp(1) + (size_t)(m - NPR) * DM; }
__device__ __forceinline__ void p1_modnorm(Frame& F) {
    const int gw = F.vcu * NWAVES + F.wave, NGW = F.G * NWAVES; const float* par = (const float*)(F.ws + WS_PAR); bf16* H = (bf16*)(F.ws + WS_A);
    for (int m = gw; m < NROW; m += NGW) { const int cd = cond_of_row(m); const GAS f32x4* xr = (const GAS f32x4*)xrow_of(F, m) + F.lane;
        const GAS f32x4* A = (const GAS f32x4*)(par + 0 * 20480 + cd * 4096) + F.lane; const GAS f32x4* B = (const GAS f32x4*)(par + 1 * 20480 + cd * 4096) + F.lane;
        f32x4 v[16]; float s = 0.f;
#pragma unroll
        for (int j = 0; j < 16; ++j) { v[j] = xr[64 * j]; s += (v[j].x * v[j].x + v[j].y * v[j].y) + (v[j].z * v[j].z + v[j].w * v[j].w); }
        const float rinv = 1.0f / sqrtf(wave_sum(s) * (1.0f / DM) + EPSN);
        GAS u32x2* o8 = (GAS u32x2*)(H + (size_t)m * DM) + F.lane;
#pragma unroll
        for (int j = 0; j < 16; ++j) { const f32x4 a = A[64 * j], b = B[64 * j]; const f32x4 y = v[j] * rinv * a + b; o8[64 * j] = (u32x2){pk2(y.x, y.y), pk2(y.z, y.w)}; } }
}
__device__ __forceinline__ void p3_rowpass(Frame& F) {
    const int gw = F.vcu * NWAVES + F.wave, NGW = F.G * NWAVES, lane = F.lane;
    const bf16* qraw = (const bf16*)(F.ws + WS_QRAW); const float* ckvraw = (const float*)(F.ws + WS_CKVRAW); const float* krraw = (const float*)(F.ws + WS_KRRAW);
    const float* qstat = (const float*)(F.ws + WS_QSTAT); const float* kvstat = (const float*)(F.ws + WS_KVSTAT); const float* tab = (const float*)(F.ws + WS_TAB);
    bf16* qn = (bf16*)(F.ws + WS_QN); bf16* ckvn = (bf16*)(F.ws + WS_CKVN); bf16* Kr = (bf16*)(F.ws + WS_KR);
    for (int m = gw; m < NROW + 2048; m += NGW) {
        if (m < NROW) {
            const int keyrow = m < NPR ? m : NPR + ((m - NPR) >> 12) * 4608 + 512 + ((m - NPR) & 4095);
            const float qs = wave_sum(lane < 16 ? qstat[m * 16 + lane] : 0.f), ks = wave_sum(lane < 8 ? kvstat[m * 8 + lane] : 0.f);
            const float rq = 1.0f / sqrtf(qs * (1.0f / 1024.f) + EPSN), rk = 1.0f / sqrtf(ks * (1.0f / 512.f) + EPSN);
#pragma unroll
            for (int hh = 0; hh < 2; ++hh) { const int k0 = hh * 512 + lane * 8; const v4u w = *(const GAS v4u*)(qraw + (size_t)m * 1024 + k0);
                const f32x4 g0 = *(const GAS f32x4*)(inp(11) + k0), g1 = *(const GAS f32x4*)(inp(11) + k0 + 4); v4u o;
                o.x = pk2(__uint_as_float(w.x << 16) * rq * g0.x, __uint_as_float(w.x & 0xffff0000u) * rq * g0.y); o.y = pk2(__uint_as_float(w.y << 16) * rq * g0.z, __uint_as_float(w.y & 0xffff0000u) * rq * g0.w);
                o.z = pk2(__uint_as_float(w.z << 16) * rq * g1.x, __uint_as_float(w.z & 0xffff0000u) * rq * g1.y); o.w = pk2(__uint_as_float(w.w << 16) * rq * g1.z, __uint_as_float(w.w & 0xffff0000u) * rq * g1.w);
                *(GAS v4u*)(qn + (size_t)m * 1024 + k0) = o; }
            { const int k0 = lane * 8; const f32x4 a = *(const GAS f32x4*)(ckvraw + (size_t)m * 512 + k0), b = *(const GAS f32x4*)(ckvraw + (size_t)m * 512 + k0 + 4);
              const f32x4 g0 = *(const GAS f32x4*)(inp(12) + k0), g1 = *(const GAS f32x4*)(inp(12) + k0 + 4); const f32x4 ya = a * rk * g0, yb = b * rk * g1;
              v4u o; o.x = pk2(ya.x, ya.y); o.y = pk2(ya.z, ya.w); o.z = pk2(yb.x, yb.y); o.w = pk2(yb.z, yb.w);
              *(GAS v4u*)(ckvn + (size_t)keyrow * 512 + k0) = o;
              if (m < NPR) { float* oc = F.out + O_CKV + (size_t)m * 512 + k0; *(GAS f32x4*)oc = ya; *(GAS f32x4*)(oc + 4) = yb; } }
            if (lane < 32) { float lo = krraw[(size_t)m * 64 + lane], hi = krraw[(size_t)m * 64 + lane + 32];
                if (m < NPR) { F.out[O_KR + (size_t)m * 64 + lane] = lo; F.out[O_KR + (size_t)m * 64 + lane + 32] = hi; }
                else { const int t = (m - NPR) & 4095; const f32x2 cs = *(const GAS f32x2*)(tab + ((size_t)t * 32 + lane) * 2); const float l2 = lo * cs.x - hi * cs.y, h2 = hi * cs.x + lo * cs.y; lo = l2; hi = h2; }
                *(GAS unsigned*)(Kr + (size_t)keyrow * 64 + 2 * lane) = pk2(lo, hi); }
        } else {
            const int idx = m - NROW, b = idx >> 9, s = idx & 511, keyrow = NPR + b * 4608 + s, k0 = lane * 8;
            const f32x4 a = *(const GAS f32x4*)(inp(3) + (size_t)idx * 512 + k0), bb = *(const GAS f32x4*)(inp(3) + (size_t)idx * 512 + k0 + 4);
            v4u o; o.x = pk2(a.x, a.y); o.y = pk2(a.z, a.w); o.z = pk2(bb.x, bb.y); o.w = pk2(bb.z, bb.w);
            *(GAS v4u*)(ckvn + (size_t)keyrow * 512 + k0) = o;
            if (lane < 32) *(GAS unsigned*)(Kr + (size_t)keyrow * 64 + 2 * lane) = pk2(inp(4)[(size_t)idx * 64 + lane], inp(4)[(size_t)idx * 64 + lane + 32]);
        }
    }
}
__device__ __forceinline__ void scan_task(Frame& F, int seq, int g, int dir) {
    const int lane = F.lane; const bool prompt = seq < 32; const int nc = prompt ? 16 : 256, cbase = prompt ? seq * 16 : 512 + (seq - 32) * 256;
    const f32x2 aT = ((const f32x2*)(F.ws + WS_PAR + 512 * 1024))[(dir * 128 + g) * 64 + lane];
    float hr = 0.f, hi = 0.f;
    if (!prompt) { const size_t si = ((size_t)((seq - 32) * 2 + dir) * 2) * 8192 + g * 64 + lane; hr = inp(5)[si]; hi = inp(5)[si + 8192]; }
    const float* S = (const float*)(F.ws + WS_A) + ((size_t)g * NCHUNK + cbase) * 256 + dir * 128 + lane;
    bf16* Hb = (bf16*)(F.ws + WS_UH) + ((size_t)g * NCHUNK + cbase) * 512 + 256 + dir * 128 + lane;
    for (int c0 = 0; c0 < nc; c0 += 8) { float sr[8], si[8];
#pragma unroll
        for (int e = 0; e < 8; ++e) { const int c = dir == 0 ? c0 + e : nc - 1 - (c0 + e); sr[e] = S[(size_t)c * 256]; si[e] = S[(size_t)c * 256 + 64]; }
#pragma unroll
        for (int e = 0; e < 8; ++e) { const int c = dir == 0 ? c0 + e : nc - 1 - (c0 + e);
            Hb[(size_t)c * 512] = (bf16)f2bf(hr); Hb[(size_t)c * 512 + 64] = (bf16)f2bf(hi);
            const float nr = aT.x * hr - aT.y * hi + sr[e], ni = aT.x * hi + aT.y * hr + si[e]; hr = nr; hi = ni; } }
    if (prompt) { float* o = F.out + O_S5 + ((size_t)(seq * 2 + dir) * 2) * 8192 + g * 64 + lane; o[0] = hr; o[8192] = hi; }
}
__device__ __forceinline__ void p4b_scan(Frame& F) {
    const int gw = F.vcu * NWAVES + F.wave, NGW = F.G * NWAVES;
    for (int t = gw; t < 2048; t += NGW) {
        if (t < 1024) scan_task(F, 32 + (t >> 8), (t >> 1) & 127, t & 1);
        else { const int base = (t - 1024) * 8; for (int e = 0; e < 8; ++e) { const int q = base + e; scan_task(F, q >> 8, (q >> 1) & 127, q & 1); } }
    }
}
__device__ __forceinline__ void p9_rowpass(Frame& F) {
    const int gw = F.vcu * NWAVES + F.wave, NGW = F.G * NWAVES, lane = F.lane; const float* par = (const float*)(F.ws + WS_PAR);
    const bf16* ob = (const bf16*)(F.ws + WS_OUTB); const float* ostat = (const float*)(F.ws + WS_OSTAT); bf16* H2 = (bf16*)(F.ws + WS_A);
    for (int m = gw; m < NROW; m += NGW) { const int cd = cond_of_row(m); const GAS f32x4* xr = (const GAS f32x4*)xrow_of(F, m) + lane;
        const float r1 = 1.0f / sqrtf(wave_sum(ostat[(size_t)m * 64 + lane]) * (1.0f / DM) + EPSN);
        const GAS f32x4* P2 = (const GAS f32x4*)(par + 2 * 20480 + cd * 4096) + lane; const GAS u32x2* o2 = (const GAS u32x2*)(ob + (size_t)m * DM) + lane;
        GAS u32x2* xo = (GAS u32x2*)(F.out + O_Y + (size_t)m * DM + DM / 2) + lane;
        f32x4 v[16]; float s = 0.f;
#pragma unroll
        for (int j = 0; j < 16; ++j) { const u32x2 w = o2[64 * j]; const f32x4 o = (f32x4){__uint_as_float(w.x << 16), __uint_as_float(w.x & 0xffff0000u), __uint_as_float(w.y << 16), __uint_as_float(w.y & 0xffff0000u)};
            v[j] = xr[64 * j] + P2[64 * j] * o * r1; xo[64 * j] = (u32x2){pk2(v[j].x, v[j].y), pk2(v[j].z, v[j].w)}; s += (v[j].x * v[j].x + v[j].y * v[j].y) + (v[j].z * v[j].z + v[j].w * v[j].w); }
        const float r2 = 1.0f / sqrtf(wave_sum(s) * (1.0f / DM) + EPSN);
        const GAS f32x4* A = (const GAS f32x4*)(par + 3 * 20480 + cd * 4096) + lane; const GAS f32x4* B = (const GAS f32x4*)(par + 4 * 20480 + cd * 4096) + lane;
        GAS u32x2* o8 = (GAS u32x2*)(H2 + (size_t)m * DM) + lane;
#pragma unroll
        for (int j = 0; j < 16; ++j) { const f32x4 y = v[j] * r2 * A[64 * j] + B[64 * j]; o8[64 * j] = (u32x2){pk2(y.x, y.y), pk2(y.z, y.w)}; } }
    LAS float* scr = (LAS float*)(F.lds + RING_OFF + F.wave * 16384);
    constexpr int I_F1 = (4096 / 64) * (16384 / 32), I_F2 = (16384 / 64) * (4096 / 32);
    conv_run<1>(inp(27), inp(28), nullptr, nullptr, F.ws, I_F1 + I_F2, gw, NGW, scr, lane);
}
__device__ __forceinline__ void p12_rowpass(Frame& F) {
    const int gw = F.vcu * NWAVES + F.wave, NGW = F.G * NWAVES, lane = F.lane; const float* par = (const float*)(F.ws + WS_PAR);
    const bf16* ab = (const bf16*)(F.ws + WS_A); const float* ostat = (const float*)(F.ws + WS_OSTAT);
    for (int m = gw; m < NROW; m += NGW) { const int cd = cond_of_row(m);
        const float r1 = 1.0f / sqrtf(wave_sum(ostat[(size_t)m * 64 + lane]) * (1.0f / DM) + EPSN);
        const GAS f32x4* P5 = (const GAS f32x4*)(par + 5 * 20480 + cd * 4096) + lane; const GAS u32x2* o2 = (const GAS u32x2*)(ab + (size_t)m * DM) + lane;
        GAS f32x4* yo = (GAS f32x4*)(F.out + O_Y + (size_t)m * DM) + lane; const GAS u32x2* xo = (const GAS u32x2*)(F.out + O_Y + (size_t)m * DM + DM / 2) + lane;
        u32x2 xw[16], aw[16];
#pragma unroll
        for (int j = 0; j < 16; ++j) { xw[j] = xo[64 * j]; aw[j] = o2[64 * j]; }
        asm volatile("s_waitcnt vmcnt(0)" ::: "memory");
#pragma unroll
        for (int j = 0; j < 16; ++j) { const u32x2 w = aw[j], x = xw[j];
            const f32x4 o = (f32x4){__uint_as_float(w.x << 16), __uint_as_float(w.x & 0xffff0000u), __uint_as_float(w.y << 16), __uint_as_float(w.y & 0xffff0000u)};
            const f32x4 x1 = (f32x4){__uint_as_float(x.x << 16), __uint_as_float(x.x & 0xffff0000u), __uint_as_float(x.y << 16), __uint_as_float(x.y & 0xffff0000u)};
            yo[64 * j] = x1 + P5[64 * j] * o * r1; } }
}

struct Args { const float* in[30]; float* out; unsigned char* ws; };
__global__ void __launch_bounds__(NWAVES * 64, 2) mk_fwd(Args args) {
    extern __shared__ __attribute__((aligned(16))) unsigned char lds[];
    Frame F;
    F.lds = (LAS unsigned char*)lds;
    F.MISC = (volatile LAS unsigned*)(F.lds + MISC_OFF);
    F.tid = threadIdx.x; F.lane = F.tid & 63; F.wave = __builtin_amdgcn_readfirstlane(F.tid >> 6);
    F.G = gridDim.x; { const int bx = blockIdx.x; F.vcu = (F.G % 8 == 0) ? (bx % 8) * (F.G / 8) + bx / 8 : bx; }
    F.out = args.out; F.ws = args.ws;
    unsigned char* ws = args.ws;
    F.ctl = (gu32*)(ws + WS_CTL);
    for (int u = F.tid; u < (LDS_BYTES - LDSCTL_OFF) / 4; u += NWAVES * 64) ((LAS unsigned*)(F.lds + LDSCTL_OFF))[u] = 0u;
    __syncthreads();
    XcdBarrier bar = xcd_barrier_post((unsigned*)(F.ctl + CW_BAR), F.MISC + 8);
#define REFRESH() do { int t_ = threadIdx.x; asm volatile("" : "+v"(t_)); F.tid = t_; F.lane = t_ & 63; } while (0)
#define GRID_BAR() do { xcd_barrier(bar); REFRESH(); } while (0)
    typedef pg8::bf16_t bt;
    const int bx = (int)blockIdx.x;

    p0_prologue(F); GRID_BAR();
    p0b_modreduce(F); GRID_BAR();
    p1_modnorm(F); GRID_BAR();
    { pg8::Gemm g{(const bt*)(ws + WS_A), (const bt*)(ws + WS_WIN), 4096, 4096, 4096}; pg8::StaticOrder S; S.init(NROW, NIN, F.G, bx);
      pg8::EpiIn E{(bt*)(ws + WS_QRAW), (float*)(ws + WS_CKVRAW), (float*)(ws + WS_KRRAW), (bt*)(ws + WS_UH), (bt*)(ws + WS_GA), (bt*)(ws + WS_GB), (float*)(ws + WS_QSTAT), (float*)(ws + WS_KVSTAT)};
      pg8::gemm_phase<pg8::EpiIn, pg8::StaticOrder, true, true>(F.lds + RING_OFF, g, S, E); }
    GRID_BAR();
    p3_rowpass(F); __syncthreads(); REFRESH();
    { pg8::Gemm g{(const bt*)(ws + WS_UH), (const bt*)(ws + WS_MSTATE), 512, 256, 256}; pg8::GroupOrder S{768, 6, F.G, bx};
      pg8::EpiS E{(float*)(ws + WS_A)};
      pg8::gemm_phase<pg8::EpiS, pg8::GroupOrder, true, true>(F.lds + RING_OFF, g, S, E); }
    GRID_BAR();
    p4b_scan(F); GRID_BAR();
    { pg8::Gemm g{(const bt*)(ws + WS_UH), (const bt*)(ws + WS_MCAT), 512, 512, 512}; pg8::GroupOrder S{768, 6, F.G, bx};
      pg8::EpiY E{(bt*)(ws + WS_YG)};
      pg8::gemm_phase<pg8::EpiY, pg8::GroupOrder, true, true>(F.lds + RING_OFF, g, S, E); }
    GRID_BAR();
    { pg8::Gemm g{(const bt*)(ws + WS_CKVN), (const bt*)(ws + WS_WUKV), 512, 512, 512}; pg8::StaticOrder S; S.init(NKEY, 8192, F.G, bx);
      pg8::EpiBf E{(bt*)(ws + WS_KV), 8192};
      pg8::gemm_phase<pg8::EpiBf, pg8::StaticOrder, true, true>(F.lds + RING_OFF, g, S, E); }
    { pg8::Gemm g{(const bt*)(ws + WS_QN), (const bt*)(ws + WS_WUQ), 1024, 1024, 1024}; pg8::StaticOrder S; S.init(NROW, 6144, F.G, bx);
      pg8::EpiQ E{(bt*)(ws + WS_Q), (const float*)(ws + WS_TAB), QSCALE};
      pg8::gemm_phase<pg8::EpiQ, pg8::StaticOrder, true, true>(F.lds + RING_OFF, g, S, E); }
    GRID_BAR();
    { const att::bf16* Q = (const att::bf16*)(ws + WS_Q); const att::bf16* KV = (const att::bf16*)(ws + WS_KV); const att::bf16* KR = (const att::bf16*)(ws + WS_KR);
      const att::bf16* GA = (const att::bf16*)(ws + WS_GA); att::bf16* MO = (att::bf16*)(ws + WS_A);
      for (int u = F.vcu; u < 3072; u += F.G) {
          int h, qrow0, krow0, seq;
          if (u < 2048) { const int bh = u >> 4, qb = u & 15, b = bh >> 5; h = bh & 31; qrow0 = NPR + b * 4096 + qb * 256; krow0 = NPR + b * 4608; seq = 4608; }
          else { const int v = u - 2048, b = v >> 5; h = v & 31; qrow0 = b * 256; krow0 = b * 256; seq = 256; }
          att::attn_unit(Q + (size_t)qrow0 * 6144 + h * 128, Q + (size_t)qrow0 * 6144 + 4096 + h * 64, KV + (size_t)krow0 * 8192 + h * 256, KV + (size_t)krow0 * 8192 + h * 256 + 128,
                         KR + (size_t)krow0 * 64, GA + (size_t)qrow0 * 4096 + h * 128, MO + (size_t)qrow0 * 4096 + h * 128, seq, (char*)lds + RING_OFF);
      }
      }
    GRID_BAR();
    { pg8::Gemm g{(const bt*)(ws + WS_YG), (const bt*)(ws + WS_WGLU), 2048, 2048, 2048}; pg8::StaticOrder S; S.init(NROW, 8192, F.G, bx);
      pg8::EpiGlu E{(bt*)(ws + WS_A), (const bt*)(ws + WS_GB)};
      if (F.G == 256) { pg8::ShareOrder2 P{NROW / 256, 32, bx, 2, 4}; pg8::gemm_phase<pg8::EpiGlu, pg8::ShareOrder2, true, true>(F.lds + RING_OFF, g, P, E); }
      else pg8::gemm_phase<pg8::EpiGlu, pg8::StaticOrder, true, true>(F.lds + RING_OFF, g, S, E); }
    GRID_BAR();
    { pg8::Gemm g{(const bt*)(ws + WS_A), (const bt*)(ws + WS_WOUT), 4096, 4096, 4096}; pg8::StaticOrder S; S.init(NROW, 4096, F.G, bx);
      pg8::EpiStat E{(bt*)(ws + WS_OUTB), (float*)(ws + WS_OSTAT)};
      if (F.G == 256) { pg8::ShareOrder P{NROW / 256, bx, 2, 1}; pg8::gemm_phase<pg8::EpiStat, pg8::ShareOrder, true, true>(F.lds + RING_OFF, g, P, E); }
      else pg8::gemm_phase<pg8::EpiStat, pg8::StaticOrder, true, true>(F.lds + RING_OFF, g, S, E); }
    GRID_BAR();
    p9_rowpass(F); GRID_BAR();
    { pg8::Gemm g{(const bt*)(ws + WS_A), (const bt*)(ws + WS_WFF1), 4096, 4096, 4096}; pg8::StaticOrder S; S.init(NROW, 16384, F.G, bx);
      pg8::EpiRelu2 E{(bt*)(ws + WS_A1)};
      if (F.G == 256) { pg8::ShareOrder2 P{NROW / 256, 64, bx, 4, 4}; pg8::gemm_phase<pg8::EpiRelu2, pg8::ShareOrder2, true, true>(F.lds + RING_OFF, g, P, E); }
      else pg8::gemm_phase<pg8::EpiRelu2, pg8::StaticOrder, true, true>(F.lds + RING_OFF, g, S, E);
    }
    GRID_BAR();
    { pg8::Gemm g{(const bt*)(ws + WS_A1), (const bt*)(ws + WS_WFF2), 16384, 16384, 16384}; pg8::StaticOrder S; S.init(NROW, 4096, F.G, bx);
      pg8::EpiStat E{(bt*)(ws + WS_A), (float*)(ws + WS_OSTAT)};
      if (F.G == 256) { pg8::ShareOrder P{NROW / 256, bx, 2, 1}; pg8::gemm_phase<pg8::EpiStat, pg8::ShareOrder, true, true>(F.lds + RING_OFF, g, P, E); }
      else pg8::gemm_phase<pg8::EpiStat, pg8::StaticOrder, true, true>(F.lds + RING_OFF, g, S, E); }
    GRID_BAR();
    p12_rowpass(F);
#undef GRID_BAR
#undef REFRESH
}

extern "C" void kernel_launch(void* const* d_in, const int* in_sizes, int n_in, void* d_out, int out_size, void* d_ws, size_t ws_size, hipStream_t stream) {
    static int grid = 0;
    if (grid == 0) {
        if (n_in != 30 || in_sizes[0] != NPR * DM || out_size != (int)O_END || ws_size < WS_END) { fprintf(stderr, "kernel_launch: shape mismatch (n_in %d, in0 %d, out %d, ws %zu; need ws >= %zu); nothing launched\n", n_in, n_in > 0 ? in_sizes[0] : -1, out_size, ws_size, (size_t)WS_END); grid = -1; return; }
        int dev = 0, cus = 0, per_cu = 0;
        if (hipGetDevice(&dev) != hipSuccess || hipDeviceGetAttribute(&cus, hipDeviceAttributeMultiprocessorCount, dev) != hipSuccess) { grid = -1; return; }
        if (hipFuncSetAttribute((const void*)mk_fwd, hipFuncAttributeMaxDynamicSharedMemorySize, LDS_BYTES) != hipSuccess) { fprintf(stderr, "kernel_launch: hipFuncSetAttribute failed\n"); grid = -1; return; }
        if (hipOccupancyMaxActiveBlocksPerMultiprocessor(&per_cu, (const void*)mk_fwd, NWAVES * 64, LDS_BYTES) != hipSuccess || per_cu < 1) { fprintf(stderr, "kernel_launch: occupancy query reports %d workgroups per CU\n", per_cu); }
        (void)hipGetLastError();
        grid = cus;
    }
    if (grid < 0) return;
    if (hipMemsetAsync((char*)d_ws + WS_CTL, 0, CTL_ZERO_BYTES, stream) != hipSuccess) return;
    Args a{};
    for (int i = 0; i < 30; ++i) a.in[i] = (const float*)d_in[i];
    a.out = (float*)d_out; a.ws = (unsigned char*)d_ws;
    hipLaunchKernelGGL(mk_fwd, dim3(grid), dim3(NWAVES * 64), LDS_BYTES, stream, a);
    const hipError_t le = hipPeekAtLastError();
    if (le != hipSuccess) fprintf(stderr, "kernel_launch: launch failed: %s\n", hipGetErrorName(le));
}
```
